# Optimizing an MI355X kernel written in HIP

```python
import jax, jax.numpy as jnp
from jax import lax
import numpy as np

D_MODEL = 2048
BATCH = 8
SEQ = 2048
DEPTH = 2

D_MIX = D_MODEL
D_GMLP = D_MIX // 2
D_HGRN = D_MIX - D_GMLP
GMLP_HEAD = 128
N_GMLP_HEADS = D_GMLP // GMLP_HEAD
GMLP_CHUNK = 128
HGRN_HEAD = 128
N_HGRN_HEADS = D_HGRN // HGRN_HEAD
HGRN_CHUNK = 64
D_IN = 2 * D_GMLP + 4 * D_HGRN
D_FF = 5632
N_EXPERTS = 8
TOP_K = 2
N_DENSE = (DEPTH + 1) // 2
N_MOE = DEPTH // 2
EPS = 1e-6
F_MIN = 1e-6

kernel_name = 'hybrid_gmlp_hgrn2_moe_trunk'


def rmsnorm(x, w):
    xf = x.astype(jnp.float32)
    y = xf * lax.rsqrt(jnp.mean(xf * xf, axis=-1, keepdims=True) + EPS)
    return (y * w.astype(jnp.float32)).astype(x.dtype)


def head_rmsnorm(y, w):
    h, hd = y.shape[-2], y.shape[-1]
    y = y * lax.rsqrt(jnp.mean(y * y, axis=-1, keepdims=True) + EPS)
    return y * w.astype(jnp.float32).reshape(h, hd)


def gmlp_mixer(z_u, z_v, w_s, b_s, ln_w, ln_b, out_w):
    b, s, _ = z_u.shape
    n = s // GMLP_CHUNK
    shp = (b, n, GMLP_CHUNK, N_GMLP_HEADS, GMLP_HEAD)
    u = jax.nn.gelu(z_u.astype(jnp.float32)).reshape(shp)
    v = jax.nn.gelu(z_v.astype(jnp.float32)).reshape(shp)
    mu = jnp.mean(v, axis=-1, keepdims=True)
    var = jnp.mean(jnp.square(v - mu), axis=-1, keepdims=True)
    v = (v - mu) * lax.rsqrt(var + EPS) * ln_w.astype(jnp.float32).reshape(N_GMLP_HEADS, GMLP_HEAD) \
        + ln_b.astype(jnp.float32).reshape(N_GMLP_HEADS, GMLP_HEAD)
    causal = jnp.tril(jnp.ones((GMLP_CHUNK, GMLP_CHUNK), dtype=bool))
    w_c = jnp.where(causal[None], w_s.astype(jnp.float32), 0.0)
    sv = jnp.einsum('hts,bnshc->bnthc', w_c, v) \
        + b_s.astype(jnp.float32).T[None, None, :, :, None]
    y = (u * sv).reshape(b, s, N_GMLP_HEADS, GMLP_HEAD)
    y = head_rmsnorm(y, out_w)
    return y.reshape(b, s, D_GMLP).astype(z_u.dtype)


def hgrn2_mixer(z_q, z_f, z_i, z_g, lb, out_w):
    b, s, _ = z_q.shape
    n = s // HGRN_CHUNK
    h, d = N_HGRN_HEADS, HGRN_HEAD
    shp = (b, s, h, d)
    lb = lb.astype(jnp.float32).reshape(h, d)
    zf = z_f.astype(jnp.float32).reshape(shp)
    q = jax.nn.silu(z_q.astype(jnp.float32)).reshape(shp)
    sig = jax.nn.sigmoid(zf)
    f = lb + (1.0 - lb) * sig
    logf = jnp.log(jnp.clip(f, F_MIN, 1.0))
    k = (1.0 - lb) * (1.0 - sig)
    i = z_i.astype(jnp.float32).reshape(shp)

    def to_chunks(t):
        return t.reshape(b, n, HGRN_CHUNK, h, d).transpose(1, 0, 3, 2, 4)

    causal = jnp.tril(jnp.ones((HGRN_CHUNK, HGRN_CHUNK), dtype=bool))[:, :, None]

    def step(state, inp):
        qc, kc, ic, gc = inp
        a = jnp.cumsum(gc, axis=2)
        a_last = a[:, :, -1, :]
        diff = a[:, :, :, None, :] - a[:, :, None, :, :]
        decay = jnp.where(causal, jnp.exp(jnp.where(causal, diff, 0.0)), 0.0)
        scores = jnp.sum(qc[:, :, :, None, :] * kc[:, :, None, :, :] * decay, axis=-1)
        o = jnp.einsum('bhts,bhsv->bhtv', scores, ic) \
            + jnp.einsum('bhtd,bhdv->bhtv', qc * jnp.exp(a), state)
        state = jnp.exp(a_last)[..., None] * state \
            + jnp.einsum('bhsd,bhsv->bhdv', kc * jnp.exp(a_last[:, :, None, :] - a), ic)
        return state, o

    s0 = jnp.zeros((b, h, d, d), jnp.float32)
    _, o = lax.scan(step, s0, (to_chunks(q), to_chunks(k), to_chunks(i), to_chunks(logf)))
    o = o.transpose(1, 0, 3, 2, 4).reshape(shp)
    o = head_rmsnorm(o, out_w) * jax.nn.silu(z_g.astype(jnp.float32)).reshape(shp)
    return o.reshape(b, s, D_HGRN).astype(z_q.dtype)


def swiglu(h, w_gate, w_up, w_down):
    return (jax.nn.silu(h @ w_gate) * (h @ w_up)) @ w_down


def moe_ffn(h, router_w, w_gate, w_up, w_down):
    b, s, dm = h.shape
    ht = h.reshape(b * s, dm)
    logits = (ht @ router_w).astype(jnp.float32)
    top_v, top_i = lax.top_k(logits, TOP_K)
    top_w = jax.nn.softmax(top_v, axis=-1)
    gates = jnp.sum(jax.nn.one_hot(top_i, N_EXPERTS, dtype=jnp.float32) * top_w[..., None], axis=1)
    y = jnp.zeros((b * s, dm), jnp.float32)
    for e in range(N_EXPERTS):
        y = y + gates[:, e:e + 1] * swiglu(ht, w_gate[e], w_up[e], w_down[e]).astype(jnp.float32)
    return y.reshape(b, s, dm).astype(h.dtype)


def setup_inputs(seed: int = 0) -> dict:
    key = jax.random.key(seed)
    ks = jax.random.split(key, 24)
    f32 = jnp.float32

    def nrm(k, shape, scale):
        return jax.random.normal(k, shape, f32) * scale

    def gain(k, shape):
        return 1.0 + 0.02 * jax.random.normal(k, shape, f32)

    return {
        'x': jax.random.normal(ks[0], (BATCH, SEQ, D_MODEL), f32),
        'mix_norm_w': gain(ks[1], (DEPTH, D_MODEL)),
        'w_in': nrm(ks[2], (DEPTH, D_MODEL, D_IN), D_MODEL ** -0.5),
        'gmlp_w_s': nrm(ks[3], (DEPTH, N_GMLP_HEADS, GMLP_CHUNK, GMLP_CHUNK), GMLP_CHUNK ** -0.5),
        'gmlp_b_s': gain(ks[4], (DEPTH, N_GMLP_HEADS, GMLP_CHUNK)),
        'gmlp_ln_w': gain(ks[5], (DEPTH, D_GMLP)),
        'gmlp_ln_b': nrm(ks[6], (DEPTH, D_GMLP), 0.02),
        'gmlp_out_w': gain(ks[7], (DEPTH, D_GMLP)),
        'hgrn_lb_logits': nrm(ks[8], (DEPTH, D_HGRN), 0.5),
        'hgrn_out_w': gain(ks[9], (DEPTH, D_HGRN)),
        'w_o': nrm(ks[10], (DEPTH, D_MIX, D_MODEL), D_MIX ** -0.5),
        'ffn_norm_w': gain(ks[11], (DEPTH, D_MODEL)),
        'dense_w_gate': nrm(ks[12], (N_DENSE, D_MODEL, D_FF), D_MODEL ** -0.5),
        'dense_w_up': nrm(ks[13], (N_DENSE, D_MODEL, D_FF), D_MODEL ** -0.5),
        'dense_w_down': nrm(ks[14], (N_DENSE, D_FF, D_MODEL), D_FF ** -0.5),
        'router_w': nrm(ks[15], (N_MOE, D_MODEL, N_EXPERTS), D_MODEL ** -0.5),
        'expert_w_gate': nrm(ks[16], (N_MOE, N_EXPERTS, D_MODEL, D_FF), D_MODEL ** -0.5),
        'expert_w_up': nrm(ks[17], (N_MOE, N_EXPERTS, D_MODEL, D_FF), D_MODEL ** -0.5),
        'expert_w_down': nrm(ks[18], (N_MOE, N_EXPERTS, D_FF, D_MODEL), D_FF ** -0.5),
        'final_norm_w': gain(ks[19], (D_MODEL,)),
    }


def reference(x, mix_norm_w, w_in, gmlp_w_s, gmlp_b_s, gmlp_ln_w, gmlp_ln_b, gmlp_out_w,
              hgrn_lb_logits, hgrn_out_w, w_o, ffn_norm_w, dense_w_gate, dense_w_up, dense_w_down,
              router_w, expert_w_gate, expert_w_up, expert_w_down, final_norm_w):
    lbs = jax.nn.softmax(hgrn_lb_logits.astype(jnp.float32), axis=0)
    lbs = jnp.cumsum(lbs, axis=0) - lbs[0:1]
    o1 = D_GMLP
    o2 = 2 * D_GMLP
    for l in range(DEPTH):
        h = rmsnorm(x, mix_norm_w[l])
        z = h @ w_in[l]
        z_u, z_v = z[..., :o1], z[..., o1:o2]
        z_q = z[..., o2:o2 + D_HGRN]
        z_f = z[..., o2 + D_HGRN:o2 + 2 * D_HGRN]
        z_i = z[..., o2 + 2 * D_HGRN:o2 + 3 * D_HGRN]
        z_g = z[..., o2 + 3 * D_HGRN:]
        y_a = gmlp_mixer(z_u, z_v, gmlp_w_s[l], gmlp_b_s[l], gmlp_ln_w[l], gmlp_ln_b[l], gmlp_out_w[l])
        y_b = hgrn2_mixer(z_q, z_f, z_i, z_g, lbs[l], hgrn_out_w[l])
        x = x + jnp.concatenate([y_a, y_b], axis=-1) @ w_o[l]
        h = rmsnorm(x, ffn_norm_w[l])
        if l % 2 == 0:
            j = l // 2
            x = x + swiglu(h, dense_w_gate[j], dense_w_up[j], dense_w_down[j])
        else:
            j = l // 2
            x = x + moe_ffn(h, router_w[j], expert_w_gate[j], expert_w_up[j], expert_w_down[j])
    return rmsnorm(x, final_norm_w)
```

```cpp
#include <hip/hip_runtime.h>
#include <cstdio>
#include <cstdint>

#ifndef REP_CONV
#define REP_CONV 1
#endif
#ifndef REP_MIX
#define REP_MIX 1
#endif
#ifndef REP_G16
#define REP_G16 1
#endif
#ifndef DENSE_F8
#define DENSE_F8 3
#endif
#ifndef MK_ONE_LAUNCH
#define MK_ONE_LAUNCH 1
#endif

namespace pg8 {
#define PG8_LAS __attribute__((address_space(3)))
typedef unsigned short bf16_t;
typedef short bf16x8 __attribute__((ext_vector_type(8)));
typedef float f32x4 __attribute__((ext_vector_type(4)));
typedef unsigned u32x4 __attribute__((ext_vector_type(4)));
constexpr int BM = 256, BK = 64, HALF = 128, HTB = HALF * BK * 2, STAGE_BYTES = 8 * HTB, NXCD = 8, WGM = 8;

__host__ __device__ __forceinline__ int lds_byte(int r, int c) { const int st = (r >> 4) * 2 + (c >> 5), rr = r & 15, cc = c & 31, ob = rr * 64 + cc * 2; return st * 1024 + (ob ^ (((ob >> 9) & 1) << 5)); }
__host__ __device__ __forceinline__ void stage_rc(int b, int& R, int& C) { const int st = b / 1024, sb = b % 1024, swz = sb ^ (((sb >> 9) & 1) << 5); R = (st >> 1) * 16 + swz / 64; C = (st & 1) * 32 + (swz % 64) / 2; }
__host__ __device__ __forceinline__ int perm32(int rho) { const int n = rho >> 4, i = rho & 15; return 8 * (i >> 2) + 4 * n + (i & 3); }

struct Unit { int pm, pn, po; int kt0, knt, part, tix, sp; };
struct Gemm { const void* A; const void* Bt; int Kb; };

struct StaticOrder {
    static constexpr bool SPLITK = false;
    int nM, nN, nwg, G, c;
    __host__ __device__ void init(int M, int N, int G_, int c_) { nM = M / BM; nN = N / BM; nwg = nM * nN; G = G_; c = c_; }
    __host__ __device__ bool next(int i, Unit& u) const {
        const long L = (long)i * G + c; if (L >= nwg) return false;
        int wgid = (int)L; { const int q = nwg / NXCD, r = nwg % NXCD, xcd = wgid % NXCD, off = wgid / NXCD; wgid = (xcd < r ? xcd * (q + 1) : r * (q + 1) + (xcd - r) * q) + off; }
        const int nig = WGM * nN, gid = wgid / nig, fm = gid * WGM, gsz = (nM - fm) < WGM ? (nM - fm) : WGM;
        u.pm = fm + ((wgid % nig) % gsz); u.pn = (wgid % nig) / gsz; u.po = u.pn; return true;
    }
    __device__ __forceinline__ void a_ready(const Unit&) const {}
    __device__ __forceinline__ void done(const Unit&) const {}
};
template <bool SK> struct MoeOrderT {
    static constexpr bool SPLITK = SK;
    int G, c, nN; int ts[9];
    int ntk; float* pbuf; unsigned* pcnt; PG8_LAS unsigned* lflag;
    __device__ __forceinline__ void locate(int L, Unit& u) const {
        int e = 0;
#pragma unroll
        for (int j = 1; j < 8; ++j) e = (L >= ts[j] * nN) ? j : e;
        int tse = ts[0], tsn = ts[1];
#pragma unroll
        for (int j = 1; j < 8; ++j) { tse = (e == j) ? ts[j] : tse; tsn = (e == j) ? ts[j + 1] : tsn; }
        const int l = L - tse * nN, te = tsn - tse;
        const int cg = l / (te * 4), rem = l - cg * (te * 4), pr = rem >> 2;
        u.pm = tse + pr; u.po = cg * 4 + (rem & 3); u.pn = e * nN + u.po;
    }
    __device__ __forceinline__ int unit_index(int i) const { const int per = G >> 3; return ((G & 7) == 0) ? (i * 8 + (c & 7)) * per + (c >> 3) : i * G + c; }
    __device__ __forceinline__ int nsplit(int T) const { int sp = 1; if (SK && T > 0) { sp = G / T; sp = sp > 4 ? 4 : sp; } return sp; }
    __device__ __forceinline__ bool next(int i, Unit& u) const {
        const int total = ts[8] * nN;
        if constexpr (SK) {
            const int R = total / G, T = total - R * G, sp = nsplit(T);
            if (i >= R && sp > 1) {
                if (i > R || c >= T * sp) return false;
                const int part = c / T, tix = c - part * T, pairs = ntk >> 1, base = pairs / sp, extra = pairs - base * sp;
                locate(R * G + tix, u);
                u.part = part; u.tix = tix; u.sp = sp; u.kt0 = 2 * (part * base + (part < extra ? part : extra)); u.knt = 2 * (base + (part < extra ? 1 : 0)); return true;
            }
            u.part = -1; u.tix = 0; u.sp = 1; u.kt0 = 0; u.knt = ntk;
        }
        const int L = unit_index(i); if (L >= total) return false;
        locate(L, u); return true;
    }
    __device__ __forceinline__ void a_ready(const Unit&) const {}
    __device__ __forceinline__ void done(const Unit&) const {}
};
typedef MoeOrderT<false> MoeOrder;


typedef float f32x2c __attribute__((ext_vector_type(2)));
typedef __bf16 bf16x2c __attribute__((ext_vector_type(2)));
__device__ __forceinline__ unsigned cvt_pk_bf16(float lo, float hi) { const f32x2c v = {lo, hi}; return __builtin_bit_cast(unsigned, __builtin_convertvector(v, bf16x2c)); }

struct EpiStoreBf16 {
    static constexpr bool PERM = true, AFTER_DRAIN = false;
    bf16_t* O; int ldc;
    __device__ __forceinline__ void operator()(const f32x4 (&acc)[2][2][4][2], const Unit& u, int wr, int wc, int fr, int fq) const {
        const int row0 = u.pm * BM + wr * 64 + fr, col0 = u.po * BM + wc * 32 + 8 * fq;
#pragma unroll
        for (int ai = 0; ai < 2; ++ai)
#pragma unroll
            for (int m = 0; m < 4; ++m) { bf16_t* rowp = O + (size_t)(row0 + ai * HALF + m * 16) * ldc + col0;
#pragma unroll
                for (int bj = 0; bj < 2; ++bj) { const f32x4 v0 = acc[ai][bj][m][0], v1 = acc[ai][bj][m][1];
                    u32x4 w; w.x = cvt_pk_bf16(v0[0], v0[1]); w.y = cvt_pk_bf16(v0[2], v0[3]); w.z = cvt_pk_bf16(v1[0], v1[1]); w.w = cvt_pk_bf16(v1[2], v1[3]);
                    *(u32x4*)(rowp + bj * HALF) = w; } }
    }
};
struct EpiResid {
    static constexpr bool PERM = false, AFTER_DRAIN = false;
    const float* base; float* out; int ldc; float scale;
    __device__ __forceinline__ void operator()(const f32x4 (&acc)[2][2][4][2], const Unit& u, int wr, int wc, int fr, int fq) const {
        const int row0 = u.pm * BM + wr * 64 + fr, col0 = u.po * BM + wc * 32 + 4 * fq;
#pragma unroll
        for (int ai = 0; ai < 2; ++ai)
#pragma unroll
            for (int m = 0; m < 4; ++m) { const size_t off = (size_t)(row0 + ai * HALF + m * 16) * ldc + col0;
#pragma unroll
                for (int bj = 0; bj < 2; ++bj)
#pragma unroll
                    for (int n = 0; n < 2; ++n) { const f32x4 b = *(const f32x4*)(base + off + bj * HALF + n * 16); *(f32x4*)(out + off + bj * HALF + n * 16) = b + acc[ai][bj][m][n] * scale; }
                asm volatile("" ::: "memory"); }
    }
};
template <bool BASE_F32> struct EpiResidB {
    static constexpr bool PERM = true, AFTER_DRAIN = false;
    const void* base; bf16_t* out; int ldc; float scale;
    __device__ __forceinline__ void operator()(const f32x4 (&acc)[2][2][4][2], const Unit& u, int wr, int wc, int fr, int fq) const {
        const int row0 = u.pm * BM + wr * 64 + fr, col0 = u.po * BM + wc * 32 + 8 * fq;
        if constexpr (!BASE_F32) {
            u32x4 t[2][4][2];
#pragma unroll
            for (int ai = 0; ai < 2; ++ai)
#pragma unroll
                for (int m = 0; m < 4; ++m)
#pragma unroll
                    for (int bj = 0; bj < 2; ++bj) t[ai][m][bj] = *(const u32x4*)((const bf16_t*)base + (size_t)(row0 + ai * HALF + m * 16) * ldc + col0 + bj * HALF);
#pragma unroll
            for (int ai = 0; ai < 2; ++ai)
#pragma unroll
                for (int m = 0; m < 4; ++m)
#pragma unroll
                    for (int bj = 0; bj < 2; ++bj) { const u32x4 q = t[ai][m][bj];
                        const f32x4 b0 = (f32x4){__builtin_bit_cast(float, q.x << 16), __builtin_bit_cast(float, q.x & 0xffff0000u), __builtin_bit_cast(float, q.y << 16), __builtin_bit_cast(float, q.y & 0xffff0000u)};
                        const f32x4 b1 = (f32x4){__builtin_bit_cast(float, q.z << 16), __builtin_bit_cast(float, q.z & 0xffff0000u), __builtin_bit_cast(float, q.w << 16), __builtin_bit_cast(float, q.w & 0xffff0000u)};
                        const f32x4 v0 = b0 + acc[ai][bj][m][0] * scale, v1 = b1 + acc[ai][bj][m][1] * scale;
                        u32x4 w; w.x = cvt_pk_bf16(v0[0], v0[1]); w.y = cvt_pk_bf16(v0[2], v0[3]); w.z = cvt_pk_bf16(v1[0], v1[1]); w.w = cvt_pk_bf16(v1[2], v1[3]);
                        *(u32x4*)(out + (size_t)(row0 + ai * HALF + m * 16) * ldc + col0 + bj * HALF) = w; }
            return;
        }
#pragma unroll
        for (int ai = 0; ai < 2; ++ai) {
            f32x4 b0[4][2], b1[4][2];
            if constexpr (BASE_F32) {
#pragma unroll
                for (int m = 0; m < 4; ++m)
#pragma unroll
                    for (int bj = 0; bj < 2; ++bj) { const float* bp = (const float*)base + (size_t)(row0 + ai * HALF + m * 16) * ldc + col0 + bj * HALF; b0[m][bj] = *(const f32x4*)bp; b1[m][bj] = *(const f32x4*)(bp + 4); }
            } else {
                u32x4 t[4][2];
#pragma unroll
                for (int m = 0; m < 4; ++m)
#pragma unroll
                    for (int bj = 0; bj < 2; ++bj) t[m][bj] = *(const u32x4*)((const bf16_t*)base + (size_t)(row0 + ai * HALF + m * 16) * ldc + col0 + bj * HALF);
#pragma unroll
                for (int m = 0; m < 4; ++m)
#pragma unroll
                    for (int bj = 0; bj < 2; ++bj) { const u32x4 q = t[m][bj];
                        b0[m][bj] = (f32x4){__builtin_bit_cast(float, q.x << 16), __builtin_bit_cast(float, q.x & 0xffff0000u), __builtin_bit_cast(float, q.y << 16), __builtin_bit_cast(float, q.y & 0xffff0000u)};
                        b1[m][bj] = (f32x4){__builtin_bit_cast(float, q.z << 16), __builtin_bit_cast(float, q.z & 0xffff0000u), __builtin_bit_cast(float, q.w << 16), __builtin_bit_cast(float, q.w & 0xffff0000u)}; }
            }
#pragma unroll
            for (int m = 0; m < 4; ++m)
#pragma unroll
                for (int bj = 0; bj < 2; ++bj) { const f32x4 v0 = b0[m][bj] + acc[ai][bj][m][0] * scale, v1 = b1[m][bj] + acc[ai][bj][m][1] * scale;
                    u32x4 w; w.x = cvt_pk_bf16(v0[0], v0[1]); w.y = cvt_pk_bf16(v0[2], v0[3]); w.z = cvt_pk_bf16(v1[0], v1[1]); w.w = cvt_pk_bf16(v1[2], v1[3]);
                    *(u32x4*)(out + (size_t)(row0 + ai * HALF + m * 16) * ldc + col0 + bj * HALF) = w; }
        }
    }
};
__device__ __forceinline__ float silu_f(float x) { return x * __builtin_amdgcn_rcpf(1.0f + __expf(-x)); }
__device__ __forceinline__ f32x2c exp2_2(f32x2c t) { return (f32x2c){__builtin_amdgcn_exp2f(t.x), __builtin_amdgcn_exp2f(t.y)}; }
__device__ __forceinline__ f32x2c rcp_2(f32x2c t) { return (f32x2c){__builtin_amdgcn_rcpf(t.x), __builtin_amdgcn_rcpf(t.y)}; }
__device__ __forceinline__ f32x2c silu_2(f32x2c x) { return x * rcp_2(exp2_2(x * -1.4426950408889634f) + 1.0f); }
__device__ __forceinline__ f32x2c gelu_2(f32x2c x) { const f32x2c t = x * (x * x * -0.10294322f + -2.3022082f); return x * rcp_2(exp2_2(t) + 1.0f); }
__device__ __forceinline__ unsigned cvt_pk_bf16_2(f32x2c v) { return __builtin_bit_cast(unsigned, __builtin_convertvector(v, bf16x2c)); }
struct EpiSwiglu {
    static constexpr bool PERM = true, AFTER_DRAIN = false;
    bf16_t* O; int ldc; float isc;
    __device__ __forceinline__ void operator()(const f32x4 (&acc)[2][2][4][2], const Unit& u, int wr, int wc, int fr, int fq) const {
        const int row0 = u.pm * BM + wr * 64 + fr, col0 = u.po * HALF + wc * 32 + 8 * fq;
        const float kn = -1.4426950408889634f * isc, invC = 1.0f / (isc * isc);
#pragma unroll
        for (int ai = 0; ai < 2; ++ai)
#pragma unroll
            for (int m = 0; m < 4; ++m) { bf16_t* rowp = O + (size_t)(row0 + ai * HALF + m * 16) * ldc + col0;
                const f32x4 g0 = acc[ai][0][m][0], g1 = acc[ai][0][m][1], u0 = acc[ai][1][m][0], u1 = acc[ai][1][m][1];
                const f32x2c ga = {g0[0], g0[1]}, gb = {g0[2], g0[3]}, gc = {g1[0], g1[1]}, gd = {g1[2], g1[3]};
                const f32x2c ua = {u0[0], u0[1]}, ub = {u0[2], u0[3]}, uc = {u1[0], u1[1]}, ud = {u1[2], u1[3]};
                const f32x2c ha = (ga * ua) * rcp_2(exp2_2(ga * kn) * invC + invC), hb = (gb * ub) * rcp_2(exp2_2(gb * kn) * invC + invC);
                const f32x2c hc = (gc * uc) * rcp_2(exp2_2(gc * kn) * invC + invC), hd = (gd * ud) * rcp_2(exp2_2(gd * kn) * invC + invC);
                u32x4 w; w.x = cvt_pk_bf16_2(ha); w.y = cvt_pk_bf16_2(hb); w.z = cvt_pk_bf16_2(hc); w.w = cvt_pk_bf16_2(hd);
                *(u32x4*)rowp = w; }
    }
};


__device__ __forceinline__ float clamp8(float v) { return __builtin_amdgcn_fmed3f(v, -448.0f, 448.0f); }
__device__ __forceinline__ unsigned pk4_fp8(float a, float b, float c, float d) { int p = __builtin_amdgcn_cvt_pk_fp8_f32(clamp8(a), clamp8(b), 0, false); p = __builtin_amdgcn_cvt_pk_fp8_f32(clamp8(c), clamp8(d), p, true); return (unsigned)p; }
constexpr float F8_SX = 8.0f, F8_SW1 = 256.0f, F8_SH = 4.0f, F8_SW2 = 512.0f;
constexpr float F8_INV1 = 1.0f / (F8_SX * F8_SW1), F8_INV2 = 1.0f / (F8_SH * F8_SW2);
typedef unsigned u32x2 __attribute__((ext_vector_type(2)));
struct EpiSwiglu8 {
    static constexpr bool PERM = true, AFTER_DRAIN = false;
    unsigned char* O; int ldc; float isc;
    __device__ __forceinline__ void operator()(const f32x4 (&acc)[2][2][4][2], const Unit& u, int wr, int wc, int fr, int fq) const {
        const int row0 = u.pm * BM + wr * 64 + fr, col0 = u.po * HALF + wc * 32 + 8 * fq;
        const float kn = -1.4426950408889634f * isc, invC = 1.0f / (isc * isc * F8_SH);
#pragma unroll
        for (int ai = 0; ai < 2; ++ai)
#pragma unroll
            for (int m = 0; m < 4; ++m) { unsigned char* rowp = O + (size_t)(row0 + ai * HALF + m * 16) * ldc + col0;
                const f32x4 g0 = acc[ai][0][m][0], g1 = acc[ai][0][m][1], u0 = acc[ai][1][m][0], u1 = acc[ai][1][m][1];
                const f32x2c ga = {g0[0], g0[1]}, gb = {g0[2], g0[3]}, gc = {g1[0], g1[1]}, gd = {g1[2], g1[3]};
                const f32x2c ua = {u0[0], u0[1]}, ub = {u0[2], u0[3]}, uc = {u1[0], u1[1]}, ud = {u1[2], u1[3]};
                const f32x2c ha = (ga * ua) * rcp_2(exp2_2(ga * kn) * invC + invC), hb = (gb * ub) * rcp_2(exp2_2(gb * kn) * invC + invC);
                const f32x2c hc = (gc * uc) * rcp_2(exp2_2(gc * kn) * invC + invC), hd = (gd * ud) * rcp_2(exp2_2(gd * kn) * invC + invC);
                u32x2 w; w.x = pk4_fp8(ha.x, ha.y, hb.x, hb.y); w.y = pk4_fp8(hc.x, hc.y, hd.x, hd.y);
                *(u32x2*)rowp = w; }
    }
};
struct EpiStoreBf16s {
    static constexpr bool PERM = true, AFTER_DRAIN = false;
    bf16_t* O; int ldc; float scale;
    __device__ __forceinline__ void operator()(const f32x4 (&acc)[2][2][4][2], const Unit& u, int wr, int wc, int fr, int fq) const {
        const int row0 = u.pm * BM + wr * 64 + fr, col0 = u.po * BM + wc * 32 + 8 * fq;
#pragma unroll
        for (int ai = 0; ai < 2; ++ai)
#pragma unroll
            for (int m = 0; m < 4; ++m) { bf16_t* rowp = O + (size_t)(row0 + ai * HALF + m * 16) * ldc + col0;
#pragma unroll
                for (int bj = 0; bj < 2; ++bj) { const f32x4 v0 = acc[ai][bj][m][0] * scale, v1 = acc[ai][bj][m][1] * scale;
                    u32x4 w; w.x = cvt_pk_bf16(v0[0], v0[1]); w.y = cvt_pk_bf16(v0[2], v0[3]); w.z = cvt_pk_bf16(v1[0], v1[1]); w.w = cvt_pk_bf16(v1[2], v1[3]);
                    *(u32x4*)(rowp + bj * HALF) = w; } }
    }
};

__device__ __forceinline__ float gelu_f(float x) { const float u = 0.7978845608028654f * (x + 0.044715f * x * x * x); return x * __builtin_amdgcn_rcpf(1.0f + __expf(-2.0f * u)); }
struct EpiZ {
    static constexpr bool PERM = true, AFTER_DRAIN = false;
    bf16_t* O; int ldc; const float* lbl; int layer;
    __device__ __forceinline__ void operator()(const f32x4 (&acc)[2][2][4][2], const Unit& u, int wr, int wc, int fr, int fq) const {
        const int row0 = u.pm * BM + wr * 64 + fr, col0 = u.po * BM + wc * 32 + 8 * fq, blk = u.po >> 2;
#pragma unroll
        for (int bj = 0; bj < 2; ++bj) {
            float lb[8];
#pragma unroll
            for (int j = 0; j < 8; ++j) lb[j] = 0.f;
            if (blk == 3 && layer == 1) { const int cc = col0 + bj * HALF - 3072;
                const f32x4 a0 = *(const f32x4*)(lbl + cc), a1 = *(const f32x4*)(lbl + cc + 4), b0 = *(const f32x4*)(lbl + 1024 + cc), b1 = *(const f32x4*)(lbl + 1024 + cc + 4);
#pragma unroll
                for (int j = 0; j < 4; ++j) { lb[j] = 1.0f / (1.0f + __expf(a0[j] - b0[j])); lb[4 + j] = 1.0f / (1.0f + __expf(a1[j] - b1[j])); } }
#pragma unroll
            for (int ai = 0; ai < 2; ++ai)
#pragma unroll
                for (int m = 0; m < 4; ++m) { bf16_t* rowp = O + (size_t)(row0 + ai * HALF + m * 16) * ldc + col0 + bj * HALF;
                    const f32x4 q0 = acc[ai][bj][m][0], q1 = acc[ai][bj][m][1];
                    f32x2c v[4] = {{q0[0], q0[1]}, {q0[2], q0[3]}, {q1[0], q1[1]}, {q1[2], q1[3]}};
                    if (blk == 2 || blk == 5) {
#pragma unroll
                        for (int j = 0; j < 4; ++j) v[j] = silu_2(v[j]);
                    } else if (blk == 3) {
#pragma unroll
                        for (int j = 0; j < 4; ++j) { const f32x2c sg = rcp_2(exp2_2(v[j] * -1.4426950408889634f) + 1.0f); const f32x2c lbv = {lb[2 * j], lb[2 * j + 1]}; const f32x2c f = lbv + (1.0f - lbv) * sg;
                            v[j] = (f32x2c){__builtin_amdgcn_logf(__builtin_amdgcn_fmed3f(f.x, 1e-6f, 1.0f)), __builtin_amdgcn_logf(__builtin_amdgcn_fmed3f(f.y, 1e-6f, 1.0f))} * 0.6931471805599453f; }
                    }
                    u32x4 w; w.x = cvt_pk_bf16_2(v[0]); w.y = cvt_pk_bf16_2(v[1]); w.z = cvt_pk_bf16_2(v[2]); w.w = cvt_pk_bf16_2(v[3]);
                    *(u32x4*)rowp = w; }
        }
    }
};

typedef int v8i __attribute__((ext_vector_type(8)));
typedef int v4i __attribute__((ext_vector_type(4)));
template <class Epi, class Sched, bool ALIGN_EPI = false, bool SP2 = false, bool F8 = false>
__device__ __forceinline__ void gemm_phase(PG8_LAS unsigned char* lds, const Gemm g, const Sched& S, const Epi& E) {
    const int tid = threadIdx.x, wid = __builtin_amdgcn_readfirstlane(tid >> 6), lane = tid & 63, wr = wid >> 2, wc = wid & 3, fr = lane & 15, fq = lane >> 4;
    const int Kb = g.Kb, nt = Kb / 128;
    unsigned voffA[2], voffB[2];
#pragma unroll
    for (int i = 0; i < 2; ++i) { int R, C; stage_rc(tid * 16 + i * 8192, R, C); const int Rb = Epi::PERM ? ((R & ~31) + perm32(R & 31)) : R;
        voffA[i] = (unsigned)(R * Kb + C * 2); voffB[i] = (unsigned)(Rb * Kb + C * 2); }
    const size_t kstep = (size_t)(BK * 2);
    const size_t hstep = (size_t)HALF * Kb;
    const size_t tstep = 2 * hstep;
    const unsigned ldsw = (unsigned)wid * 1024u;
    const int aoff = lds_byte(wr * 64 + fr, fq * 8), boff = lds_byte(wc * 32 + fr, fq * 8);
#define PG8_SA(b, h) (((b) * 2 + (h)) * HTB)
#define PG8_SB(b, h) ((4 + (b) * 2 + (h)) * HTB)
#define PG8_STAGE(bufoff, gbase, voff) do { _Pragma("unroll") for (int _i = 0; _i < 2; ++_i) \
        __builtin_amdgcn_global_load_lds((const unsigned*)((const char*)(gbase) + (voff)[_i]), (PG8_LAS unsigned*)(lds + (bufoff) + ldsw + _i * 8192), 16, 0, 0); } while (0)
#define PG8_LDA(dst, b, h) do { if constexpr (F8) { _Pragma("unroll") for (int m = 0; m < 4; ++m) { dst##8[m].lo = *(const PG8_LAS v4i*)(lds + PG8_SA(b, h) + aoff + m * 2048); dst##8[m].hi = *(const PG8_LAS v4i*)(lds + PG8_SA(b, h) + aoff + m * 2048 + 1024); } } \
        else { _Pragma("unroll") for (int m = 0; m < 4; ++m) _Pragma("unroll") for (int k = 0; k < 2; ++k) dst[m][k] = *(const PG8_LAS bf16x8*)(lds + PG8_SA(b, h) + aoff + m * 2048 + k * 1024); } } while (0)
#define PG8_LDB(dst, b, h) do { if constexpr (F8) { _Pragma("unroll") for (int n = 0; n < 2; ++n) { dst##8[n].lo = *(const PG8_LAS v4i*)(lds + PG8_SB(b, h) + boff + n * 2048); dst##8[n].hi = *(const PG8_LAS v4i*)(lds + PG8_SB(b, h) + boff + n * 2048 + 1024); } } \
        else { _Pragma("unroll") for (int n = 0; n < 2; ++n) _Pragma("unroll") for (int k = 0; k < 2; ++k) dst[n][k] = *(const PG8_LAS bf16x8*)(lds + PG8_SB(b, h) + boff + n * 2048 + k * 1024); } } while (0)
#define PG8_MMA(ai, bj, At, Bt) do { __builtin_amdgcn_s_setprio(1); if constexpr (F8) { _Pragma("unroll") for (int m = 0; m < 4; ++m) _Pragma("unroll") for (int n = 0; n < 2; ++n) \
            asm volatile("v_mfma_f32_16x16x128_f8f6f4 %0, %1, %2, %0" : "+v"(acc[ai][bj][m][n]) : "v"(Bt##8[n]), "v"(At##8[m])); } \
        else { _Pragma("unroll") for (int m = 0; m < 4; ++m) _Pragma("unroll") for (int n = 0; n < 2; ++n) _Pragma("unroll") for (int k = 0; k < 2; ++k) \
            acc[ai][bj][m][n] = __builtin_amdgcn_mfma_f32_16x16x32_bf16(Bt[n][k], At[m][k], acc[ai][bj][m][n], 0, 0, 0); } __builtin_amdgcn_s_setprio(0); } while (0)
#define PG8_WAIT_V(n) asm volatile("s_waitcnt vmcnt(" #n ")" ::: "memory")
#define PG8_WAIT_L(n) asm volatile("s_waitcnt lgkmcnt(" #n ")" ::: "memory")
#define PG8_BAR __builtin_amdgcn_s_barrier()
#define PG8_SCHED __builtin_amdgcn_sched_barrier(0)
    Unit cur, nxt; int ui = 0;
    if (!S.next(0, cur)) return;
    f32x4 acc[2][2][4][2];
#pragma unroll
    for (int a = 0; a < 2; ++a)
#pragma unroll
        for (int b = 0; b < 2; ++b)
#pragma unroll
            for (int m = 0; m < 4; ++m)
#pragma unroll
                for (int n = 0; n < 2; ++n) acc[a][b][m][n] = (f32x4){0.f, 0.f, 0.f, 0.f};
    bf16x8 At[4][2], B0[2][2], B1[2][2]; v8i At8[4], B08[2], B18[2];
    const char* cA = (const char*)g.A + (size_t)cur.pm * tstep; const char* cB = (const char*)g.Bt + (size_t)cur.pn * tstep;
    if constexpr (Sched::SPLITK) { cA += (size_t)cur.kt0 * kstep; cB += (size_t)cur.kt0 * kstep; }
    S.a_ready(cur);
    if constexpr (SP2) {
        PG8_STAGE(PG8_SB(0, 0), cB, voffB); PG8_STAGE(PG8_SB(0, 1), cB + hstep, voffB); PG8_STAGE(PG8_SA(0, 0), cA, voffA); PG8_STAGE(PG8_SA(0, 1), cA + hstep, voffA);
        if (wr == 1) PG8_BAR;
        PG8_WAIT_V(2); PG8_BAR;
        PG8_STAGE(PG8_SB(1, 0), cB + kstep, voffB); PG8_STAGE(PG8_SA(1, 0), cA + kstep, voffA); PG8_STAGE(PG8_SB(1, 1), cB + hstep + kstep, voffB);
        PG8_WAIT_V(6); PG8_BAR;
    } else {
        PG8_STAGE(PG8_SB(0, 0), cB, voffB); PG8_STAGE(PG8_SA(0, 0), cA, voffA); PG8_STAGE(PG8_SB(0, 1), cB + hstep, voffB); PG8_STAGE(PG8_SA(0, 1), cA + hstep, voffA);
        if (wr == 1) PG8_BAR;
        PG8_WAIT_V(4); PG8_BAR;
        PG8_STAGE(PG8_SB(1, 0), cB + kstep, voffB); PG8_STAGE(PG8_SA(1, 0), cA + kstep, voffA); PG8_STAGE(PG8_SB(1, 1), cB + hstep + kstep, voffB);
        PG8_WAIT_V(6); PG8_BAR;
    }
    for (;;) {
        const bool has_next = S.next(ui + 1, nxt);
        const char* nA = has_next ? (const char*)g.A + (size_t)nxt.pm * tstep : cA; const char* nB = has_next ? (const char*)g.Bt + (size_t)nxt.pn * tstep : cB;
        if constexpr (Sched::SPLITK) { if (has_next) { nA += (size_t)nxt.kt0 * kstep; nB += (size_t)nxt.kt0 * kstep; } }
        const int ntu = Sched::SPLITK ? cur.knt : nt;
        for (int t = 0; t < ntu; t += 2) {
            const bool last = (t == ntu - 2);
            const char* a1 = cA + (size_t)(t + 1) * kstep;
            const char* a2 = last ? nA : cA + (size_t)(t + 2) * kstep; const char* b2 = last ? nB : cB + (size_t)(t + 2) * kstep;
            const char* a3 = a2 + kstep; const char* b3 = b2 + kstep;
            if (last && has_next) S.a_ready(nxt);
            if constexpr (SP2) {
            PG8_LDB(B0, 0, 0); PG8_LDB(B1, 0, 1); PG8_SCHED; PG8_LDA(At, 0, 0); PG8_STAGE(PG8_SA(1, 1), a1 + hstep, voffA);
            PG8_WAIT_V(8); PG8_WAIT_L(0); PG8_BAR; PG8_MMA(0, 0, At, B0); PG8_MMA(0, 1, At, B1); PG8_BAR; PG8_SCHED;
            PG8_LDA(At, 0, 1); PG8_STAGE(PG8_SB(0, 0), b2, voffB); PG8_STAGE(PG8_SB(0, 1), b2 + hstep, voffB); PG8_STAGE(PG8_SA(0, 0), a2, voffA);
            PG8_WAIT_V(8); PG8_WAIT_L(0); PG8_BAR; PG8_MMA(1, 0, At, B0); PG8_MMA(1, 1, At, B1); PG8_BAR; PG8_SCHED;
            PG8_LDB(B0, 1, 0); PG8_LDB(B1, 1, 1); PG8_SCHED; PG8_LDA(At, 1, 0); PG8_STAGE(PG8_SA(0, 1), a2 + hstep, voffA);
            PG8_WAIT_V(8); PG8_WAIT_L(0); PG8_BAR; PG8_MMA(0, 0, At, B0); PG8_MMA(0, 1, At, B1); PG8_BAR; PG8_SCHED;
            PG8_LDA(At, 1, 1); PG8_STAGE(PG8_SB(1, 0), b3, voffB); PG8_STAGE(PG8_SB(1, 1), b3 + hstep, voffB); PG8_STAGE(PG8_SA(1, 0), a3, voffA);
            PG8_WAIT_V(8); PG8_WAIT_L(0); PG8_BAR; PG8_MMA(1, 0, At, B0); PG8_MMA(1, 1, At, B1); PG8_BAR; PG8_SCHED;
            } else {
            PG8_LDB(B0, 0, 0); PG8_SCHED; PG8_LDA(At, 0, 0); PG8_STAGE(PG8_SA(1, 1), a1 + hstep, voffA);
            PG8_WAIT_L(8); PG8_BAR; PG8_WAIT_L(0); PG8_MMA(0, 0, At, B0); PG8_BAR; PG8_SCHED;
            PG8_LDB(B1, 0, 1); PG8_STAGE(PG8_SB(0, 0), b2, voffB);
            PG8_BAR; PG8_WAIT_L(0); PG8_MMA(0, 1, At, B1); PG8_BAR;
            PG8_LDA(At, 0, 1); PG8_STAGE(PG8_SA(0, 0), a2, voffA);
            PG8_BAR; PG8_WAIT_L(0); PG8_MMA(1, 0, At, B0); PG8_BAR; PG8_SCHED;
            PG8_STAGE(PG8_SB(0, 1), b2 + hstep, voffB);
            PG8_WAIT_V(6); PG8_BAR; PG8_MMA(1, 1, At, B1); PG8_BAR;
            PG8_LDB(B0, 1, 0); PG8_SCHED; PG8_LDA(At, 1, 0); PG8_STAGE(PG8_SA(0, 1), a2 + hstep, voffA);
            PG8_WAIT_L(8); PG8_BAR; PG8_WAIT_L(0); PG8_MMA(0, 0, At, B0); PG8_BAR; PG8_SCHED;
            PG8_LDB(B1, 1, 1); PG8_STAGE(PG8_SB(1, 0), b3, voffB);
            PG8_BAR; PG8_WAIT_L(0); PG8_MMA(0, 1, At, B1); PG8_BAR;
            PG8_LDA(At, 1, 1); PG8_STAGE(PG8_SA(1, 0), a3, voffA);
            PG8_BAR; PG8_WAIT_L(0); PG8_MMA(1, 0, At, B0); PG8_BAR; PG8_SCHED;
            PG8_STAGE(PG8_SB(1, 1), b3 + hstep, voffB);
            PG8_WAIT_V(6); PG8_BAR; PG8_MMA(1, 1, At, B1); PG8_BAR;
            }
        }
        if constexpr (ALIGN_EPI) { if (wr == 0) PG8_BAR; }
        if constexpr (F8) {
#pragma unroll
            for (int a = 0; a < 2; ++a)
#pragma unroll
                for (int b = 0; b < 2; ++b) {
                    if (a == 0 && b == 0) asm volatile("s_nop 15\n\ts_nop 15" : "+v"(acc[0][0][0][0]), "+v"(acc[0][0][0][1]), "+v"(acc[0][0][1][0]), "+v"(acc[0][0][1][1]), "+v"(acc[0][0][2][0]), "+v"(acc[0][0][2][1]), "+v"(acc[0][0][3][0]), "+v"(acc[0][0][3][1]));
                    else asm volatile("" : "+v"(acc[a][b][0][0]), "+v"(acc[a][b][0][1]), "+v"(acc[a][b][1][0]), "+v"(acc[a][b][1][1]), "+v"(acc[a][b][2][0]), "+v"(acc[a][b][2][1]), "+v"(acc[a][b][3][0]), "+v"(acc[a][b][3][1])); }
        }
        bool run_epi = true;
        if constexpr (Sched::SPLITK) {
            if (cur.part >= 0) {
                const __amdgpu_buffer_rsrc_t prs = __builtin_amdgcn_make_buffer_rsrc((void*)S.pbuf, 0, 64 << 20, 0x00020000);
                const int pofs = __builtin_amdgcn_readfirstlane((cur.tix * cur.sp + cur.part) * 262144);
#pragma unroll
                for (int a = 0; a < 2; ++a)
#pragma unroll
                    for (int b = 0; b < 2; ++b)
#pragma unroll
                        for (int m = 0; m < 4; ++m)
#pragma unroll
                            for (int n = 0; n < 2; ++n)
                                __builtin_amdgcn_raw_buffer_store_b128(__builtin_bit_cast(u32x4, acc[a][b][m][n]), prs, ((((a * 2 + b) * 4 + m) * 2 + n) * 512 + tid) * 16, pofs, 16);
                asm volatile("s_waitcnt vmcnt(0)" ::: "memory");
                PG8_BAR;
                if (tid == 0) { const unsigned old = __hip_atomic_fetch_add(S.pcnt + cur.tix, 1u, __ATOMIC_RELAXED, __HIP_MEMORY_SCOPE_AGENT);
                    if (old == (unsigned)(cur.sp - 1)) __builtin_amdgcn_fence(__ATOMIC_ACQUIRE, "agent");
                    *(volatile PG8_LAS unsigned*)S.lflag = old; }
                asm volatile("s_waitcnt vmcnt(0) lgkmcnt(0)" ::: "memory");
                PG8_BAR;
                const unsigned arrived = *(volatile PG8_LAS unsigned*)S.lflag;
                run_epi = (arrived == (unsigned)(cur.sp - 1));
                if (run_epi) {
                    const int tofs = __builtin_amdgcn_readfirstlane(cur.tix * cur.sp * 262144);
#pragma unroll
                    for (int a = 0; a < 2; ++a)
#pragma unroll
                        for (int b = 0; b < 2; ++b)
#pragma unroll
                            for (int m = 0; m < 4; ++m)
#pragma unroll
                                for (int n = 0; n < 2; ++n)
                                    acc[a][b][m][n] = __builtin_bit_cast(f32x4, __builtin_amdgcn_raw_buffer_load_b128(prs, ((((a * 2 + b) * 4 + m) * 2 + n) * 512 + tid) * 16, tofs, 16));
                    for (int pp = 1; pp < cur.sp; ++pp) { const int qofs = __builtin_amdgcn_readfirstlane(tofs + pp * 262144);
#pragma unroll
                        for (int a = 0; a < 2; ++a)
#pragma unroll
                            for (int b = 0; b < 2; ++b) {
                                f32x4 tp[4][2];
#pragma unroll
                                for (int m = 0; m < 4; ++m)
#pragma unroll
                                    for (int n = 0; n < 2; ++n) tp[m][n] = __builtin_bit_cast(f32x4, __builtin_amdgcn_raw_buffer_load_b128(prs, ((((a * 2 + b) * 4 + m) * 2 + n) * 512 + tid) * 16, qofs, 16));
#pragma unroll
                                for (int m = 0; m < 4; ++m)
#pragma unroll
                                    for (int n = 0; n < 2; ++n) acc[a][b][m][n] += tp[m][n];
                                __builtin_amdgcn_sched_barrier(0); } }
                }
            }
        }
        if constexpr (!Epi::AFTER_DRAIN) { if (run_epi) E(acc, cur, wr, wc, fr, fq); S.done(cur); }
        if (!has_next) break;
#pragma unroll
        for (int a = 0; a < 2; ++a)
#pragma unroll
            for (int b = 0; b < 2; ++b)
#pragma unroll
                for (int m = 0; m < 4; ++m)
#pragma unroll
                    for (int n = 0; n < 2; ++n) acc[a][b][m][n] = (f32x4){0.f, 0.f, 0.f, 0.f};
        cur = nxt; cA = nA; cB = nB; ++ui;
        if constexpr (ALIGN_EPI) { if (wr == 1) PG8_BAR; }
    }
    PG8_WAIT_V(0);
    if constexpr (!ALIGN_EPI) { if (wr == 0) PG8_BAR; }
    PG8_BAR;
#undef PG8_SA
#undef PG8_SB
#undef PG8_STAGE
#undef PG8_LDA
#undef PG8_LDB
#undef PG8_MMA
#undef PG8_WAIT_V
#undef PG8_WAIT_L
#undef PG8_BAR
#undef PG8_SCHED
}
}

constexpr int NWAVES = 8;
constexpr int NB = 8, SEQ = 2048, D = 2048, M = NB * SEQ, DIN = 6144, DG = 1024, DH = 1024, FF = 5632, GU = 2 * FF, NE = 8;
constexpr int MOE_ROWS = 2 * M + NE * 256;
constexpr float EPS = 1e-6f, F_MIN = 1e-6f;

constexpr size_t MiB = 1u << 20;
constexpr size_t WS_CTL = 0, CTL_ZERO_BYTES = 1 * MiB;
constexpr size_t WS_SMALL = 1 * MiB;
constexpr size_t SM_WC = 1 * MiB;
constexpr size_t SM_TOKE = 0, SM_TOKW = 131072, SM_TOKP = 262144, SM_WHIST = 393216, SM_TS = 524288;
constexpr size_t WS_WIN = 4 * MiB;
constexpr size_t WS_WO = WS_WIN + (size_t)2 * DIN * D * 2;
constexpr size_t WS_WGU = WS_WO + (size_t)2 * D * D * 2;
constexpr size_t WS_WD = WS_WGU + (size_t)GU * D * 2;
constexpr size_t WS_EGU = WS_WD + (size_t)D * FF * 2;
constexpr size_t WS_ED = WS_EGU + (size_t)NE * GU * D * 2;
constexpr size_t WS_XN = WS_ED + (size_t)NE * D * FF * 2;
constexpr size_t WS_R = WS_XN + (size_t)M * D * 2;
constexpr size_t WS_Z = WS_R;
constexpr size_t WS_Y = WS_Z + (size_t)M * DIN * 2;
constexpr size_t WS_O = WS_Y + (size_t)M * D * 2;
constexpr size_t WS_H = WS_R;
constexpr size_t WS_XS = WS_R + (size_t)MOE_ROWS * FF * 2;
constexpr size_t WS_XS8 = WS_XS + (size_t)MOE_ROWS * D * 2;
constexpr size_t WS_END = WS_XS8 + (size_t)MOE_ROWS * D;
static_assert(WS_O + (size_t)M * DH * 4 <= WS_XS, "O inside region R");
static_assert(WS_WIN % 256 == 0 && WS_XN % 256 == 0 && WS_R % 256 == 0 && WS_XS % 256 == 0, "alignment");

constexpr int CW_BAR = 4096;

constexpr int RING_OFF = 0, RING_BYTES = 131072;
constexpr int LDSCTL_OFF = 135168, MISC_OFF = LDSCTL_OFF + 320;
constexpr int LDS_BYTES = 147456;

#define GAS __attribute__((address_space(1)))
#define LAS __attribute__((address_space(3)))
typedef unsigned short bf16;
typedef unsigned v4u __attribute__((ext_vector_type(4)));
typedef unsigned v2u __attribute__((ext_vector_type(2)));
typedef float f32x4 __attribute__((ext_vector_type(4)));
typedef float f32x2 __attribute__((ext_vector_type(2)));
typedef int i32x4 __attribute__((ext_vector_type(4)));
typedef int i32x2 __attribute__((ext_vector_type(2)));
#define LDS_WAIT() asm volatile("s_waitcnt lgkmcnt(0)" ::: "memory")
#define VM_WAIT() asm volatile("s_waitcnt vmcnt(0)" ::: "memory")
__device__ __forceinline__ unsigned f2bf(float f) { return (unsigned)__builtin_bit_cast(unsigned short, (__bf16)f); }
__device__ __forceinline__ unsigned pk2(float lo, float hi) { return pg8::cvt_pk_bf16(lo, hi); }
__device__ __forceinline__ float bflo(unsigned p) { return __builtin_bit_cast(float, p << 16); }
__device__ __forceinline__ float bfhi(unsigned p) { return __builtin_bit_cast(float, p & 0xffff0000u); }
__device__ __forceinline__ float sigmoid_f(float x) { return 1.0f / (1.0f + __expf(-x)); }
__device__ __forceinline__ float silu_x(float x) { return x / (1.0f + __expf(-x)); }
__device__ __forceinline__ float gelu_tanh(float x) { const float u = 0.7978845608028654f * (x + 0.044715f * x * x * x); return x / (1.0f + __expf(-2.0f * u)); }
template <int CTRL, int ROW_MASK> __device__ __forceinline__ float dpp_f(float v) { return __builtin_bit_cast(float, __builtin_amdgcn_update_dpp(0, __builtin_bit_cast(int, v), CTRL, ROW_MASK, 0xF, false)); }
__device__ __forceinline__ float row16_sum(float v) {
    v += dpp_f<0xB1, 0xF>(v);
    v += dpp_f<0x4E, 0xF>(v);
    v += dpp_f<0x141, 0xF>(v);
    v += dpp_f<0x140, 0xF>(v);
    return v;
}
__device__ __forceinline__ float wave_sum(float v) {
    v = row16_sum(v);
    v += dpp_f<0x142, 0xA>(v);
    v += dpp_f<0x143, 0xC>(v);
    return __builtin_bit_cast(float, __builtin_amdgcn_readlane(__builtin_bit_cast(int, v), 63));
}
__device__ __forceinline__ int wave_sum_i(int v) {
#pragma unroll
    for (int o = 1; o < 64; o <<= 1) v += __shfl_xor(v, o);
    return v;
}

#define XB_TMO      128
#define XB_XCNT(j)  (256  + 64 * (j))
#define XB_XSUB(j)  (1280 + 64 * (j))
#define XB_XGEN(j)  (2304 + 64 * (j))
#define XB_TOP      3328
#define XB_TOPGEN   3392
#define XCD_BAR_WORDS 3456
#define XB_SPIN_CAP (1u << 22)
__device__ __forceinline__ unsigned xb_ld(unsigned* p)              { return __hip_atomic_load(p, __ATOMIC_RELAXED, __HIP_MEMORY_SCOPE_AGENT); }
__device__ __forceinline__ unsigned xb_add(unsigned* p, unsigned v) { return __hip_atomic_fetch_add(p, v, __ATOMIC_RELAXED, __HIP_MEMORY_SCOPE_AGENT); }
__device__ __forceinline__ unsigned xb_xcc_id() { return (unsigned)__builtin_amdgcn_s_getreg((3 << 11) | 20) & 0xFu; }
#define XB_SPIN(cond, bar) do { unsigned _sp = 0; while (cond) { __builtin_amdgcn_s_sleep(1); \
    if ((++_sp & 255u) == 0u) { if (xb_ld(&(bar)[XB_TMO])) break; if (_sp > XB_SPIN_CAP) { atomicAdd(&(bar)[XB_TMO], 1u); break; } } } } while (0)
struct XcdBarrier { unsigned* bar; unsigned x; volatile LAS unsigned* st; };
__device__ __forceinline__ XcdBarrier xcd_barrier_post(unsigned* bar, volatile LAS unsigned* st) {
    XcdBarrier b; b.bar = bar; b.x = xb_xcc_id(); b.st = st;
    if (threadIdx.x == 0) (void)xb_add(&bar[XB_XCNT(b.x)], 1u);
    return b;
}
__device__ __forceinline__ void xcd_barrier_complete(unsigned* bar, unsigned x, unsigned& nloc, unsigned& nx) {
    const unsigned G = gridDim.x * gridDim.y * gridDim.z;
    unsigned sum, cnt, mine, sp = 0u;
    for (;;) {
        sum = 0u; cnt = 0u; mine = 0u;
#pragma unroll
        for (unsigned j = 0; j < 16; ++j) { const unsigned c = xb_ld(&bar[XB_XCNT(j)]); sum += c; cnt += (c > 0u) ? 1u : 0u; mine = (j == x) ? c : mine; }
        if (sum == G) break;
        __builtin_amdgcn_s_sleep(1);
        if ((++sp & 255u) == 0u) { if (xb_ld(&bar[XB_TMO])) break; if (sp > XB_SPIN_CAP) { atomicAdd(&bar[XB_TMO], 1u); break; } }
    }
    nloc = mine > 0u ? mine : 1u; nx = cnt > 0u ? cnt : 1u;
}
__device__ __forceinline__ void xcd_barrier(const XcdBarrier& b) {
    asm volatile("s_waitcnt vmcnt(0)" ::: "memory");
    __syncthreads();
    if (threadIdx.x == 0) {
        unsigned* bar = b.bar;
        __builtin_amdgcn_s_waitcnt(0);
        unsigned nloc = b.st[0], nx = b.st[1];
        if (nloc == 0u) { xcd_barrier_complete(bar, b.x, nloc, nx); b.st[0] = nloc; b.st[1] = nx; }
        const unsigned old = xb_add(&bar[XB_XSUB(b.x)], 1u);
        const unsigned gen = old / nloc;
        if (old + 1u == (gen + 1u) * nloc) {
            __builtin_amdgcn_fence(__ATOMIC_RELEASE, "agent");
            asm volatile("s_waitcnt vmcnt(0)" ::: "memory");
            const unsigned og = xb_add(&bar[XB_TOP], 1u);
            const unsigned tg = og / nx;
            if (og + 1u == (tg + 1u) * nx) xb_add(&bar[XB_TOPGEN], 1u);
            else XB_SPIN(xb_ld(&bar[XB_TOPGEN]) == tg, bar);
            __builtin_amdgcn_fence(__ATOMIC_ACQUIRE, "agent");
            xb_add(&bar[XB_XGEN(b.x)], 1u);
            asm volatile("s_waitcnt vmcnt(0)" ::: "memory");
        } else {
            XB_SPIN(xb_ld(&bar[XB_XGEN(b.x)]) == gen, bar);
            __builtin_amdgcn_fence(__ATOMIC_ACQUIRE, "agent");
            asm volatile("s_waitcnt vmcnt(0)" ::: "memory");
        }
    }
    __syncthreads();
}

struct Frame {
    LAS unsigned char* lds;
    int tid, lane, wave, G, gw, NGW;
    unsigned char* ws;
};

__device__ __forceinline__ void transpose_item(const float* W, int K, int N, bf16* WT, int mode, LAS float* scr, int item, int lane) {
    const int nblk = N / 32, kb = item / nblk, nb = item % nblk, k0 = 64 * kb, n0 = 32 * nb;
    const int kr = lane >> 3, nc = lane & 7;
    f32x4 v[8];
#pragma unroll
    for (int i = 0; i < 8; ++i) v[i] = *(const f32x4*)(W + (size_t)(k0 + 8 * i + kr) * N + n0 + 4 * nc);
#pragma unroll
    for (int i = 0; i < 8; ++i) { LAS float* d = scr + (8 * i + kr) * 33 + 4 * nc; d[0] = v[i].x; d[1] = v[i].y; d[2] = v[i].z; d[3] = v[i].w; }
    LDS_WAIT(); asm volatile("" ::: "memory");
    const int c = lane & 7;
    const int rbase = (mode == 0) ? n0 : (256 * (n0 >> 7) + (n0 & 127) + (mode == 2 ? 128 : 0));
#pragma unroll
    for (int j = 0; j < 4; ++j) { const int n = (lane >> 3) + 8 * j; const LAS float* s = scr + (8 * c) * 33 + n;
        v4u o; o.x = pk2(s[0 * 33], s[1 * 33]); o.y = pk2(s[2 * 33], s[3 * 33]); o.z = pk2(s[4 * 33], s[5 * 33]); o.w = pk2(s[6 * 33], s[7 * 33]);
        *(v4u*)(WT + (size_t)(rbase + n) * K + k0 + 8 * c) = o; }
    LDS_WAIT(); asm volatile("" ::: "memory");
}
__device__ __forceinline__ void conv_matrix(Frame& F, const float* W, int K, int N, bf16* WT, int mode) {
    LAS float* scr = (LAS float*)(F.lds + RING_OFF + F.wave * 16384);
    const int nitems = (K / 64) * (N / 32);
    for (int it = F.gw; it < nitems; it += F.NGW) transpose_item(W, K, N, WT, mode, scr, it, F.lane);
}
__device__ __forceinline__ void transpose_item8(const float* W, int K, int N, unsigned char* WT, int mode, float scale, LAS float* scr, int item, int lane) {
    const int nblk = N / 32, kb = item / nblk, nb = item % nblk, k0 = 64 * kb, n0 = 32 * nb;
    const int kr = lane >> 3, nc = lane & 7;
    f32x4 v[8];
#pragma unroll
    for (int i = 0; i < 8; ++i) v[i] = *(const f32x4*)(W + (size_t)(k0 + 8 * i + kr) * N + n0 + 4 * nc);
#pragma unroll
    for (int i = 0; i < 8; ++i) { LAS float* d = scr + (8 * i + kr) * 33 + 4 * nc; d[0] = v[i].x; d[1] = v[i].y; d[2] = v[i].z; d[3] = v[i].w; }
    LDS_WAIT(); asm volatile("" ::: "memory");
    const int c = lane & 7;
    const int rbase = (mode == 0) ? n0 : (256 * (n0 >> 7) + (n0 & 127) + (mode == 2 ? 128 : 0));
#pragma unroll
    for (int j = 0; j < 4; ++j) { const int n = (lane >> 3) + 8 * j; const LAS float* s = scr + (8 * c) * 33 + n;
        v2u o; o.x = pg8::pk4_fp8(s[0 * 33] * scale, s[1 * 33] * scale, s[2 * 33] * scale, s[3 * 33] * scale); o.y = pg8::pk4_fp8(s[4 * 33] * scale, s[5 * 33] * scale, s[6 * 33] * scale, s[7 * 33] * scale);
        *(v2u*)(WT + (size_t)(rbase + n) * K + k0 + 8 * c) = o; }
    LDS_WAIT(); asm volatile("" ::: "memory");
}
constexpr int CONV_CH = 8, CW_CONV = 8192;
static_assert(((D / 64) * (DIN / 32)) % CONV_CH == 0 && ((D / 64) * (D / 32)) % CONV_CH == 0 && ((D / 64) * (FF / 32)) % CONV_CH == 0 && ((FF / 64) * (D / 32)) % CONV_CH == 0, "conversion chunks must be whole");
constexpr int CW_SK = 16384, CW_GMLP = 24576, NGF = 64;
__device__ __forceinline__ void conv_load(const float* W, int N, int item, int lane, f32x4 (&v)[8]) {
    const int nblk = N / 32, kb = item / nblk, nb = item % nblk, k0 = 64 * kb, n0 = 32 * nb, kr = lane >> 3, nc = lane & 7;
#pragma unroll
    for (int i = 0; i < 8; ++i) v[i] = *(const f32x4*)(W + (size_t)(k0 + 8 * i + kr) * N + n0 + 4 * nc);
}
__device__ __forceinline__ void conv_proc(int K, int N, void* WT, int mode, float scale8, LAS float* scr, int item, int lane, const f32x4 (&v)[8]) {
    const int nblk = N / 32, kb = item / nblk, nb = item % nblk, k0 = 64 * kb, n0 = 32 * nb, kr = lane >> 3, nc = lane & 7;
#pragma unroll
    for (int i = 0; i < 8; ++i) { LAS float* d = scr + (8 * i + kr) * 33 + 4 * nc; d[0] = v[i].x; d[1] = v[i].y; d[2] = v[i].z; d[3] = v[i].w; }
    LDS_WAIT(); asm volatile("" ::: "memory");
    const int c = lane & 7;
    const int rbase = (mode == 0) ? n0 : (256 * (n0 >> 7) + (n0 & 127) + (mode == 2 ? 128 : 0));
#pragma unroll
    for (int j = 0; j < 4; ++j) { const int n = (lane >> 3) + 8 * j; const LAS float* s = scr + (8 * c) * 33 + n;
        if (scale8 != 0.f) { v2u o; o.x = pg8::pk4_fp8(s[0 * 33] * scale8, s[1 * 33] * scale8, s[2 * 33] * scale8, s[3 * 33] * scale8); o.y = pg8::pk4_fp8(s[4 * 33] * scale8, s[5 * 33] * scale8, s[6 * 33] * scale8, s[7 * 33] * scale8);
            *(v2u*)((unsigned char*)WT + (size_t)(rbase + n) * K + k0 + 8 * c) = o; }
        else { v4u o; o.x = pk2(s[0 * 33], s[1 * 33]); o.y = pk2(s[2 * 33], s[3 * 33]); o.z = pk2(s[4 * 33], s[5 * 33]); o.w = pk2(s[6 * 33], s[7 * 33]);
            *(v4u*)((bf16*)WT + (size_t)(rbase + n) * K + k0 + 8 * c) = o; } }
    LDS_WAIT(); asm volatile("" ::: "memory");
}
__device__ __forceinline__ void conv_queue(Frame& F, int job, const float* W, int K, int N, void* WT, int mode, float scale8 = 0.f) {
    LAS float* scr = (LAS float*)(F.lds + RING_OFF + F.wave * 16384);
    unsigned* ctr = (unsigned*)(F.ws + WS_CTL) + CW_CONV + 64 * job;
    const int nitems = (K / 64) * (N / 32), nch = nitems / CONV_CH;
    for (;;) {
        unsigned c = 0; if (F.lane == 0) c = __hip_atomic_fetch_add(ctr, 1u, __ATOMIC_RELAXED, __HIP_MEMORY_SCOPE_AGENT);
        c = __builtin_amdgcn_readfirstlane(c);
        if ((int)c >= nch) break;
        const int i0 = (int)c * CONV_CH, ilast = i0 + CONV_CH - 1;
        f32x4 va[8], vb[8];
        conv_load(W, N, i0, F.lane, va);
#pragma unroll 1
        for (int it = i0; it < i0 + CONV_CH; it += 2) {
            conv_load(W, N, it + 1, F.lane, vb);
            conv_proc(K, N, WT, mode, scale8, scr, it, F.lane, va);
            conv_load(W, N, it + 2 < ilast ? it + 2 : ilast, F.lane, va);
            conv_proc(K, N, WT, mode, scale8, scr, it + 1, F.lane, vb);
        }
    }
}

__device__ __forceinline__ void norm_row(const float* xrow, const float* gain, int lane, f32x4 (&v)[8]) {
    const f32x4* xr = (const f32x4*)xrow + lane; float s = 0.f;
#pragma unroll
    for (int j = 0; j < 8; ++j) { v[j] = xr[64 * j]; s += (v[j].x * v[j].x + v[j].y * v[j].y) + (v[j].z * v[j].z + v[j].w * v[j].w); }
    const float rstd = 1.0f / sqrtf(wave_sum(s) * (1.0f / D) + EPS);
    const f32x4* gr = (const f32x4*)gain + lane;
#pragma unroll
    for (int j = 0; j < 8; ++j) v[j] = v[j] * rstd * gr[64 * j];
}
__device__ __forceinline__ void store_row_bf16(bf16* orow, int lane, const f32x4 (&v)[8]) {
    v2u* o8 = (v2u*)orow + lane;
#pragma unroll
    for (int j = 0; j < 8; ++j) { v2u w; w.x = pk2(v[j].x, v[j].y); w.y = pk2(v[j].z, v[j].w); o8[64 * j] = w; }
}


__device__ __forceinline__ void norm_row_b(const bf16* xrow, const float* gain, int lane, f32x4 (&v)[8]) {
    const v4u* xr = (const v4u*)xrow + lane; float s = 0.f;
#pragma unroll
    for (int j = 0; j < 4; ++j) { const v4u t = xr[64 * j]; v[2 * j] = (f32x4){bflo(t.x), bfhi(t.x), bflo(t.y), bfhi(t.y)}; v[2 * j + 1] = (f32x4){bflo(t.z), bfhi(t.z), bflo(t.w), bfhi(t.w)}; }
#pragma unroll
    for (int j = 0; j < 8; ++j) s += (v[j].x * v[j].x + v[j].y * v[j].y) + (v[j].z * v[j].z + v[j].w * v[j].w);
    const float rstd = 1.0f / sqrtf(wave_sum(s) * (1.0f / D) + EPS);
    const f32x4* gr = (const f32x4*)gain + 2 * lane;
#pragma unroll
    for (int j = 0; j < 4; ++j) { v[2 * j] = v[2 * j] * rstd * gr[128 * j]; v[2 * j + 1] = v[2 * j + 1] * rstd * gr[128 * j + 1]; }
}
__device__ __forceinline__ void load_raw_b(const bf16* xrow, int lane, v4u (&t)[4]) { const v4u* xr = (const v4u*)xrow + lane;
#pragma unroll
    for (int j = 0; j < 4; ++j) t[j] = xr[64 * j]; }
__device__ __forceinline__ void load_gain_b(const float* gain, int lane, f32x4 (&g)[8]) { const f32x4* gr = (const f32x4*)gain + 2 * lane;
#pragma unroll
    for (int j = 0; j < 4; ++j) { g[2 * j] = gr[128 * j]; g[2 * j + 1] = gr[128 * j + 1]; } }
__device__ __forceinline__ void norm_raw_b(const v4u (&t)[4], const f32x4 (&g)[8], f32x4 (&v)[8]) {
    float s = 0.f;
#pragma unroll
    for (int j = 0; j < 4; ++j) { v[2 * j] = (f32x4){bflo(t[j].x), bfhi(t[j].x), bflo(t[j].y), bfhi(t[j].y)}; v[2 * j + 1] = (f32x4){bflo(t[j].z), bfhi(t[j].z), bflo(t[j].w), bfhi(t[j].w)}; }
#pragma unroll
    for (int j = 0; j < 8; ++j) s += (v[j].x * v[j].x + v[j].y * v[j].y) + (v[j].z * v[j].z + v[j].w * v[j].w);
    const float rstd = 1.0f / sqrtf(wave_sum(s) * (1.0f / D) + EPS);
#pragma unroll
    for (int j = 0; j < 8; ++j) v[j] = v[j] * rstd * g[j];
}
__device__ __forceinline__ void load_raw_f(const float* xrow, int lane, f32x4 (&t)[8]) { const f32x4* xr = (const f32x4*)xrow + lane;
#pragma unroll
    for (int j = 0; j < 8; ++j) t[j] = xr[64 * j]; }
__device__ __forceinline__ void norm_raw_f(const f32x4 (&t)[8], const f32x4 (&g)[8], f32x4 (&v)[8]) {
    float s = 0.f;
#pragma unroll
    for (int j = 0; j < 8; ++j) s += (t[j].x * t[j].x + t[j].y * t[j].y) + (t[j].z * t[j].z + t[j].w * t[j].w);
    const float rstd = 1.0f / sqrtf(wave_sum(s) * (1.0f / D) + EPS);
#pragma unroll
    for (int j = 0; j < 8; ++j) v[j] = t[j] * rstd * g[j];
}
__device__ __forceinline__ void store_row_bf16_b(bf16* orow, int lane, const f32x4 (&v)[8]) {
    v4u* o = (v4u*)orow + lane;
#pragma unroll
    for (int j = 0; j < 4; ++j) { v4u w; w.x = pk2(v[2 * j].x, v[2 * j].y); w.y = pk2(v[2 * j].z, v[2 * j].w); w.z = pk2(v[2 * j + 1].x, v[2 * j + 1].y); w.w = pk2(v[2 * j + 1].z, v[2 * j + 1].w); o[64 * j] = w; }
}

typedef short bf16x8v __attribute__((ext_vector_type(8)));
typedef short s16x4 __attribute__((ext_vector_type(4)));
constexpr int RS = 272;
__device__ __forceinline__ unsigned nat_base(unsigned lane) { return (lane & 15u) * RS + (lane >> 4) * 16u; }
__device__ __forceinline__ constexpr unsigned nat_off(unsigned rb, unsigned s) { return rb * 16u * RS + s * 64u; }
__device__ __forceinline__ unsigned tr_base(unsigned lane) { return (8u * (lane >> 4) + ((lane & 15u) >> 2)) * RS + (lane & 3u) * 8u; }
__device__ __forceinline__ constexpr unsigned tr_off(unsigned c, unsigned ks, unsigned t) { return (32u * ks + 4u * t) * RS + 32u * c; }
__device__ __forceinline__ bf16x8v tr_frag(LAS unsigned char* p, unsigned c, unsigned ks) {
    const s16x4 a = __builtin_amdgcn_ds_read_tr16_b64_v4i16((LAS s16x4*)(p + tr_off(c, ks, 0)));
    const s16x4 b = __builtin_amdgcn_ds_read_tr16_b64_v4i16((LAS s16x4*)(p + tr_off(c, ks, 1)));
    return __builtin_shufflevector(a, b, 0, 1, 2, 3, 4, 5, 6, 7);
}
__device__ __forceinline__ f32x4 mfma16(bf16x8v a, bf16x8v b, f32x4 c) { return __builtin_amdgcn_mfma_f32_16x16x32_bf16(a, b, c, 0, 0, 0); }
__device__ __forceinline__ f32x4 zero4() { f32x4 z = (f32x4){0.f, 0.f, 0.f, 0.f}; asm volatile("" : "+v"(z)); return z; }
__device__ __forceinline__ bf16x8v pack8(f32x4 a, f32x4 b) { v4u w; w.x = pg8::cvt_pk_bf16(a[0], a[1]); w.y = pg8::cvt_pk_bf16(a[2], a[3]); w.z = pg8::cvt_pk_bf16(b[0], b[1]); w.w = pg8::cvt_pk_bf16(b[2], b[3]); return __builtin_bit_cast(bf16x8v, w); }

__device__ __forceinline__ void gmlp_unit(Frame& F, const bf16* Z, bf16* Y, const bf16* Wc, const float* ln_w, const float* ln_b, const float* b_s, const float* out_w, int u) {
    const int h = u & 7, n = (u >> 3) & 15, b = u >> 7; const size_t row0 = (size_t)b * SEQ + n * 128;
    LAS unsigned char* VT = F.lds; LAS unsigned char* WT = F.lds + 128 * RS;
    const int lane = F.lane, w = F.wave, g = lane >> 4, lr = lane & 15;
    {
        const f32x2 lw = ((const f32x2*)(ln_w + h * 128))[lane], lb = ((const f32x2*)(ln_b + h * 128))[lane];
        unsigned pk[16];
#pragma unroll
        for (int i = 0; i < 16; ++i) pk[i] = ((const unsigned*)(Z + (row0 + 16 * w + i) * DIN + DG + h * 128))[lane];
#pragma unroll
        for (int i = 0; i < 16; ++i) { const pg8::f32x2c gv2 = pg8::gelu_2((pg8::f32x2c){bflo(pk[i]), bfhi(pk[i])}); const float a = gv2.x, c = gv2.y;
            const float mu = wave_sum(a + c) * (1.0f / 128.0f); const float da = a - mu, dc = c - mu;
            const float var = wave_sum(da * da + dc * dc) * (1.0f / 128.0f); const float rs = 1.0f / sqrtf(var + EPS);
            *(LAS unsigned*)(VT + (16 * w + i) * RS + lane * 4) = pk2(da * rs * lw.x + lb.x, dc * rs * lw.y + lb.y); }
        v4u wt4[4];
#pragma unroll
        for (int i = 0; i < 4; ++i) { const int nn = F.tid + 512 * i, row = nn >> 4, ch = nn & 15; wt4[i] = *(const v4u*)(Wc + (size_t)h * 16384 + row * 128 + ch * 8); }
#pragma unroll
        for (int i = 0; i < 4; ++i) { const int nn = F.tid + 512 * i, row = nn >> 4, ch = nn & 15; *(LAS v4u*)(WT + row * RS + ch * 16) = wt4[i]; }
    }
    __syncthreads();
    f32x4 acc[8];
#pragma unroll
    for (int ct = 0; ct < 8; ++ct) acc[ct] = zero4();
    LAS unsigned char* vtr = VT + tr_base(lane); LAS unsigned char* wnb = WT + nat_base(lane) + w * 16 * RS;
#pragma unroll
    for (int ks = 0; ks < 4; ++ks) {
        const bf16x8v Bf = *(const LAS bf16x8v*)(wnb + nat_off(0, ks));
#pragma unroll
        for (int ct = 0; ct < 8; ++ct) { const bf16x8v Af = tr_frag(vtr, ct, ks); acc[ct] = mfma16(Af, Bf, acc[ct]); }
    }
    const int t = 16 * w + lr; const size_t row = row0 + t; const float bs = b_s[h * 128 + t];
    float ss = 0.f;
#pragma unroll
    for (int ct = 0; ct < 8; ++ct) { const v2u up = *(const v2u*)(Z + row * DIN + h * 128 + 16 * ct + 4 * g);
        const pg8::f32x2c ua = pg8::gelu_2((pg8::f32x2c){bflo(up.x), bfhi(up.x)}), ub = pg8::gelu_2((pg8::f32x2c){bflo(up.y), bfhi(up.y)});
        f32x4 y; y[0] = ua.x * (acc[ct][0] + bs); y[1] = ua.y * (acc[ct][1] + bs); y[2] = ub.x * (acc[ct][2] + bs); y[3] = ub.y * (acc[ct][3] + bs);
        acc[ct] = y; ss += (y[0] * y[0] + y[1] * y[1]) + (y[2] * y[2] + y[3] * y[3]); }
    f32x4 ow[8];
#pragma unroll
    for (int ct = 0; ct < 8; ++ct) ow[ct] = *(const f32x4*)(out_w + h * 128 + 16 * ct + 4 * g);
    ss += __shfl_xor(ss, 16); ss += __shfl_xor(ss, 32);
    const float rs = __builtin_amdgcn_rsqf(ss * (1.0f / 128.0f) + EPS);
#pragma unroll
    for (int ct = 0; ct < 8; ++ct) { v2u o;
        o.x = pk2(acc[ct][0] * rs * ow[ct][0], acc[ct][1] * rs * ow[ct][1]); o.y = pk2(acc[ct][2] * rs * ow[ct][2], acc[ct][3] * rs * ow[ct][3]);
        *(v2u*)(Y + row * D + h * 128 + 16 * ct + 4 * g) = o; }
    __syncthreads();
}

__device__ __forceinline__ void hgrn_item(Frame& F, const bf16* Z, bf16* Y, const float* out_w, int b, int h) {
    LAS unsigned char* Lb = F.lds;
    constexpr int QT = 0, KT = 64 * RS, IT = 128 * RS, PT = 192 * RS, EMo = PT + 64 * 144, ELo = EMo + 512, ELMo = ELo + 512, SEGo = ELMo + 512, NSo = SEGo + 4096, OTo = NSo + 2048, OWo = OTo + 64 * RS;
    static_assert(OWo + 512 <= RING_BYTES, "hgrn LDS map");
    const int lane = F.lane, w = F.wave, g = lane >> 4, lr = lane & 15, dp = lane, seg = w;
    f32x4 Sacc[8];
#pragma unroll
    for (int i = 0; i < 8; ++i) Sacc[i] = zero4();
    LAS unsigned char* q_nat = Lb + QT + nat_base(lane); LAS unsigned char* k_nat = Lb + KT + nat_base(lane);
    LAS unsigned char* k_tr = Lb + KT + tr_base(lane); LAS unsigned char* i_tr = Lb + IT + tr_base(lane);
    LAS unsigned char* p_rd = Lb + PT + lr * 144 + g * 16; LAS unsigned char* p_wr = Lb + PT + lr * 144 + g * 8;
    LAS unsigned char* q_in = Lb + QT + lr * RS + g * 8;
    unsigned rq[8], rg[8]; v4u ri[2];
    const __amdgpu_buffer_rsrc_t zrs = __builtin_amdgcn_make_buffer_rsrc((void*)Z, 0, (int)((size_t)M * DIN * 2), 0x00020000);
    const int vq = (2 * DG + h * 128 + 2 * dp) * 2;
    int vi[2];
#pragma unroll
    for (int i = 0; i < 2; ++i) { const int nn = F.tid + 512 * i, row = nn >> 4, ch = nn & 15; vi[i] = row * (DIN * 2) + (2 * DG + 2 * DH + h * 128 + ch * 8) * 2; }
#define HGRN_LOAD_G(cc) do { const int _s0 = __builtin_amdgcn_readfirstlane((int)(((size_t)b * SEQ + (size_t)(cc) * 64) * (DIN * 2))); \
        _Pragma("unroll") for (int r = 0; r < 8; ++r) rg[r] = (unsigned)__builtin_amdgcn_raw_buffer_load_b32(zrs, vq + DH * 2, _s0 + (8 * seg + r) * (DIN * 2), 0); } while (0)
#define HGRN_LOAD_Q(cc) do { const int _s0 = __builtin_amdgcn_readfirstlane((int)(((size_t)b * SEQ + (size_t)(cc) * 64) * (DIN * 2))); \
        _Pragma("unroll") for (int r = 0; r < 8; ++r) rq[r] = (unsigned)__builtin_amdgcn_raw_buffer_load_b32(zrs, vq, _s0 + (8 * seg + r) * (DIN * 2), 0); } while (0)
    if (F.tid < 32) *(LAS f32x4*)(Lb + OWo + F.tid * 16) = *(const f32x4*)(out_w + h * 128 + F.tid * 4);
    HGRN_LOAD_G(0); HGRN_LOAD_Q(0);
#define HGRN_OUTPUT(cc) do { const size_t _r0 = (size_t)b * SEQ + (size_t)(cc) * 64; \
        _Pragma("unroll") for (int i = 0; i < 2; ++i) { const int nn = F.tid + 512 * i, t = nn >> 4, ch = nn & 15; \
            const f32x4 n0 = *(const LAS f32x4*)(Lb + NSo + t * 32), n1 = *(const LAS f32x4*)(Lb + NSo + t * 32 + 16); \
            const float ssum = ((n0[0] + n0[1]) + (n0[2] + n0[3])) + ((n1[0] + n1[1]) + (n1[2] + n1[3])); \
            const float rs = __builtin_amdgcn_rsqf(ssum * (1.0f / 128.0f) + EPS); \
            const v4u ov = *(const LAS v4u*)(Lb + OTo + t * RS + ch * 16); \
            const v4u gv = gvc[i]; \
            const f32x4 w0 = *(const LAS f32x4*)(Lb + OWo + ch * 32), w1 = *(const LAS f32x4*)(Lb + OWo + ch * 32 + 16); \
            v4u yv; \
            yv.x = pk2(bflo(ov.x) * rs * w0[0] * bflo(gv.x), bfhi(ov.x) * rs * w0[1] * bfhi(gv.x)); yv.y = pk2(bflo(ov.y) * rs * w0[2] * bflo(gv.y), bfhi(ov.y) * rs * w0[3] * bfhi(gv.y)); \
            yv.z = pk2(bflo(ov.z) * rs * w1[0] * bflo(gv.z), bfhi(ov.z) * rs * w1[1] * bfhi(gv.z)); yv.w = pk2(bflo(ov.w) * rs * w1[2] * bflo(gv.w), bfhi(ov.w) * rs * w1[3] * bfhi(gv.w)); \
            *(v4u*)(Y + (_r0 + t) * D + DG + h * 128 + ch * 8) = yv; } } while (0)
    v4u gvc[2];
    for (int c = 0; c < SEQ / 64; ++c) {
        const size_t r0 = (size_t)b * SEQ + c * 64;
        float pre0 = 0.f, pre1 = 0.f, mid0 = 0.f, mid1 = 0.f, tot0 = 0.f, tot1 = 0.f;
        {
            const int s0c = __builtin_amdgcn_readfirstlane((int)(r0 * (DIN * 2)));
            float s0 = 0.f, s1 = 0.f;
#pragma unroll
            for (int r = 0; r < 8; ++r) { s0 += bflo(rg[r]); s1 += bfhi(rg[r]); }
            *(LAS f32x2*)(Lb + SEGo + (seg * 128 + 2 * dp) * 4) = (f32x2){s0, s1};
#pragma unroll
            for (int i = 0; i < 2; ++i) ri[i] = __builtin_bit_cast(v4u, __builtin_amdgcn_raw_buffer_load_b128(zrs, vi[i], s0c, 0));
            __syncthreads();
            if (c > 0) HGRN_OUTPUT(c - 1);
#pragma unroll
            for (int i = 0; i < 2; ++i) gvc[i] = __builtin_bit_cast(v4u, __builtin_amdgcn_raw_buffer_load_b128(zrs, vi[i] + DH * 2, s0c, 0));
#pragma unroll
            for (int sg = 0; sg < 8; ++sg) { const f32x2 t = *(const LAS f32x2*)(Lb + SEGo + (sg * 128 + 2 * dp) * 4);
                if (sg < seg) { pre0 += t.x; pre1 += t.y; } if (sg < 4) { mid0 += t.x; mid1 += t.y; } tot0 += t.x; tot1 += t.y; }
            float aa0 = pre0, aa1 = pre1;
#pragma unroll
            for (int r = 0; r < 8; ++r) {
                const float g0 = bflo(rg[r]), g1 = bfhi(rg[r]); aa0 += g0; aa1 += g1;
                const float k0 = 1.0f - __expf(g0), k1 = 1.0f - __expf(g1);
                const float q0 = bflo(rq[r]) * __expf(aa0 - mid0), q1 = bfhi(rq[r]) * __expf(aa1 - mid1);
                const float kk0 = k0 * __expf(mid0 - aa0), kk1 = k1 * __expf(mid1 - aa1);
                const unsigned o = (8 * seg + r) * RS + dp * 4;
                *(LAS unsigned*)(Lb + QT + o) = pk2(q0, q1); *(LAS unsigned*)(Lb + KT + o) = pk2(kk0, kk1);
                if (r & 1) __builtin_amdgcn_sched_barrier(0);
            }
#pragma unroll
            for (int i = 0; i < 2; ++i) { const int nn = F.tid + 512 * i, row = nn >> 4, ch = nn & 15; *(LAS v4u*)(Lb + IT + row * RS + ch * 16) = ri[i]; }
            if (seg == 0) { *(LAS f32x2*)(Lb + EMo + 8 * dp) = (f32x2){__expf(mid0), __expf(mid1)}; *(LAS f32x2*)(Lb + ELo + 8 * dp) = (f32x2){__expf(tot0), __expf(tot1)};
                *(LAS f32x2*)(Lb + ELMo + 8 * dp) = (f32x2){__expf(tot0 - mid0), __expf(tot1 - mid1)}; }
            if (c + 1 < SEQ / 64) { HGRN_LOAD_G(c + 1); HGRN_LOAD_Q(c + 1); }
        }
        __syncthreads();
#pragma unroll
        for (int it = 0; it < 2; ++it) { const int idx = w + 8 * it, tt = idx >> 2, st = idx & 3;
            f32x4 d = zero4();
#pragma unroll
            for (int ks = 0; ks < 4; ++ks) { const bf16x8v Af = *(const LAS bf16x8v*)(k_nat + st * 16 * RS + nat_off(0, ks)); const bf16x8v Bf = *(const LAS bf16x8v*)(q_nat + tt * 16 * RS + nat_off(0, ks));
                d = mfma16(Af, Bf, d); }
            const int sdiff = 16 * (st - tt) + 4 * g - lr;
#pragma unroll
            for (int r = 0; r < 4; ++r) d[r] = (sdiff + r > 0) ? 0.f : d[r];
            v2u pk; pk.x = pk2(d[0], d[1]); pk.y = pk2(d[2], d[3]);
            *(LAS v2u*)(p_wr + tt * 16 * 144 + st * 32) = pk;
        }
        __syncthreads();
        bf16x8v If[2];
#pragma unroll
        for (int ks = 0; ks < 2; ++ks) If[ks] = tr_frag(i_tr + w * 32, 0, ks);
        f32x4 acc[4];
#pragma unroll
        for (int tt = 0; tt < 4; ++tt) acc[tt] = zero4();
#pragma unroll
        for (int tt = 0; tt < 4; ++tt)
#pragma unroll
            for (int ks = 0; ks < 2; ++ks) if (32 * ks <= 16 * tt + 15) { const bf16x8v Af = *(const LAS bf16x8v*)(p_rd + tt * 16 * 144 + ks * 64);
                acc[tt] = mfma16(Af, If[ks], acc[tt]); }
        __builtin_amdgcn_sched_barrier(0);
#pragma unroll
        for (int kk = 0; kk < 4; ++kk) {
            const f32x4 em0 = *(const LAS f32x4*)(Lb + EMo + (32 * kk + 4 * g) * 4), em1 = *(const LAS f32x4*)(Lb + EMo + (32 * kk + 16 + 4 * g) * 4);
            const bf16x8v Bf = pack8(Sacc[2 * kk] * em0, Sacc[2 * kk + 1] * em1);
#pragma unroll
            for (int tt = 0; tt < 4; ++tt) {
                const v2u x0 = *(const LAS v2u*)(q_in + tt * 16 * RS + kk * 64), x1 = *(const LAS v2u*)(q_in + tt * 16 * RS + kk * 64 + 32);
                v4u xa; xa.x = x0.x; xa.y = x0.y; xa.z = x1.x; xa.w = x1.y;
                acc[tt] = mfma16(__builtin_bit_cast(bf16x8v, xa), Bf, acc[tt]); }
            __builtin_amdgcn_sched_barrier(0);
        }
#pragma unroll
        for (int dt = 0; dt < 8; ++dt) { f32x4 La = zero4();
#pragma unroll
            for (int ks = 0; ks < 2; ++ks) { const bf16x8v Af = tr_frag(k_tr, dt, ks); La = mfma16(Af, If[ks], La); }
            const f32x4 el = *(const LAS f32x4*)(Lb + ELo + (16 * dt + 4 * g) * 4), elm = *(const LAS f32x4*)(Lb + ELMo + (16 * dt + 4 * g) * 4);
            Sacc[dt] = el * Sacc[dt] + elm * La;
            __builtin_amdgcn_sched_barrier(0); }
#pragma unroll
        for (int tt = 0; tt < 4; ++tt)
#pragma unroll
            for (int r = 0; r < 4; ++r) { const float p = row16_sum(acc[tt][r] * acc[tt][r]);
                if (lr == 0) *(LAS float*)(Lb + NSo + ((16 * tt + 4 * g + r) * 8 + w) * 4) = p;
                *(LAS unsigned short*)(Lb + OTo + (16 * tt + 4 * g + r) * RS + (16 * w + lr) * 2) = (unsigned short)f2bf(acc[tt][r]); }
    }
    __syncthreads();
    HGRN_OUTPUT(SEQ / 64 - 1);
#undef HGRN_LOAD_G
#undef HGRN_LOAD_Q
#undef HGRN_OUTPUT
    __syncthreads();
}

struct Args { const float* in[20]; float* out; unsigned char* ws; int ph_lo, ph_hi; };
constexpr int NPHASE = 17;

#define IN(k) (lo <= (k) && (k) < hi)
#define SEAM(k) do { if (IN(k) && IN((k) + 1)) xcd_barrier(bar); } while (0)
template <int l> __device__ __forceinline__ void layer_phases(Frame& F, const Args& args, const XcdBarrier& bar, const int lo, const int hi) {
    unsigned char* ws = F.ws; float* out = args.out;
    bf16* XN = (bf16*)(ws + WS_XN); bf16* Z = (bf16*)(ws + WS_Z); bf16* Y = (bf16*)(ws + WS_Y); float* O = (float*)(ws + WS_O); bf16* H = (bf16*)(ws + WS_H);
        const int pb = 1 + 7 * l;
        bf16* XR = (bf16*)(ws + WS_O);
        if (IN(pb + 0)) {
            f32x4 gn[8];
            if constexpr (l == 0) {
#pragma unroll
                for (int j = 0; j < 8; ++j) gn[j] = ((const f32x4*)args.in[1] + F.lane)[64 * j];
                f32x4 rc[8]; if (F.gw < M) load_raw_f(args.in[0] + (size_t)F.gw * D, F.lane, rc);
                for (int m = F.gw; m < M; m += F.NGW) { f32x4 rn[8], v[8];
#pragma unroll
                    for (int j = 0; j < 8; ++j) rn[j] = rc[j];
                    if (m + F.NGW < M) load_raw_f(args.in[0] + (size_t)(m + F.NGW) * D, F.lane, rn);
                    norm_raw_f(rc, gn, v); store_row_bf16(XN + (size_t)m * D, F.lane, v);
#pragma unroll
                    for (int j = 0; j < 8; ++j) rc[j] = rn[j]; }
            } else {
                load_gain_b(args.in[1] + l * D, F.lane, gn);
                v4u rc[4]; if (F.gw < M) load_raw_b(XR + (size_t)F.gw * D, F.lane, rc);
                for (int m = F.gw; m < M; m += F.NGW) { v4u rn[4]; f32x4 v[8];
#pragma unroll
                    for (int j = 0; j < 4; ++j) rn[j] = rc[j];
                    if (m + F.NGW < M) load_raw_b(XR + (size_t)(m + F.NGW) * D, F.lane, rn);
                    norm_raw_b(rc, gn, v); store_row_bf16_b(XN + (size_t)m * D, F.lane, v);
#pragma unroll
                    for (int j = 0; j < 4; ++j) rc[j] = rn[j]; }
            }
        }
        SEAM(pb + 0);
        if (IN(pb + 1)) {
            pg8::Gemm g{XN, (bf16*)(ws + WS_WIN) + (size_t)l * DIN * D, 2 * D}; pg8::StaticOrder S; S.init(M, DIN, F.G, (int)blockIdx.x);
            pg8::EpiZ E{Z, DIN, args.in[8], l};
            pg8::gemm_phase<pg8::EpiZ, pg8::StaticOrder, true, true>(F.lds + RING_OFF, g, S, E);
        }
        SEAM(pb + 1);
        if (IN(pb + 2)) for (int rep = 0; rep < REP_MIX; ++rep) {
            const int nh = (F.G >= 128) ? 64 : 0;
            if (nh == 0 || (int)blockIdx.x < nh) for (int it = blockIdx.x; it < NB * 8; it += (nh ? nh : F.G)) hgrn_item(F, Z, Y, args.in[9] + l * DH, it >> 3, it & 7);
        }
        auto gmlp_pull = [&]() {
            unsigned* gctr = (unsigned*)(ws + WS_CTL) + CW_GMLP + 64 * l; volatile LAS unsigned* gw = (volatile LAS unsigned*)(F.lds + MISC_OFF + 96);
            for (;;) {
                __syncthreads();
                if (F.tid == 0) *gw = __hip_atomic_fetch_add(gctr, 1u, __ATOMIC_RELAXED, __HIP_MEMORY_SCOPE_AGENT);
                __syncthreads();
                const int u = (int)*gw;
                if (u >= NB * 16 * 8) break;
                gmlp_unit(F, Z, Y, (const bf16*)(ws + WS_SMALL + SM_WC) + (size_t)l * 8 * 16384, args.in[5] + l * DG, args.in[6] + l * DG, args.in[4] + l * DG, args.in[7] + l * DG, u);
            }
        };
        if (IN(pb + 2)) { const int nh = (F.G >= 128) ? 64 : 0; if ((int)blockIdx.x >= nh && (int)blockIdx.x < nh + NGF) gmlp_pull(); }
        if (IN(pb + 2)) {
            bf16* WIN = (bf16*)(ws + WS_WIN); bf16* WO = (bf16*)(ws + WS_WO); bf16* WGU = (bf16*)(ws + WS_WGU); bf16* WD = (bf16*)(ws + WS_WD); bf16* EGU = (bf16*)(ws + WS_EGU); bf16* ED = (bf16*)(ws + WS_ED);
            if constexpr (l == 0) {
                conv_queue(F, 0, args.in[2] + (size_t)D * DIN, D, DIN, WIN + (size_t)DIN * D, 0); conv_queue(F, 1, args.in[10] + (size_t)D * D, D, D, WO + (size_t)D * D, 0);
                conv_queue(F, 2, args.in[12], D, FF, WGU, 1, (DENSE_F8 == 1 || DENSE_F8 == 3) ? pg8::F8_SW1 : 0.f); conv_queue(F, 3, args.in[13], D, FF, WGU, 2, (DENSE_F8 == 1 || DENSE_F8 == 3) ? pg8::F8_SW1 : 0.f); conv_queue(F, 4, args.in[14], FF, D, WD, 0, (DENSE_F8 == 1 || DENSE_F8 == 2) ? pg8::F8_SW2 : 0.f);
            }
            for (int e = (l == 0 ? 0 : 3); e < (l == 0 ? 3 : NE); ++e) {
                unsigned char* EGU8 = (unsigned char*)(ws + WS_EGU); unsigned char* ED8 = (unsigned char*)(ws + WS_ED);
                conv_queue(F, 8 + 3 * e, args.in[16] + (size_t)e * D * FF, D, FF, EGU8 + (size_t)e * GU * D, 1, pg8::F8_SW1); conv_queue(F, 9 + 3 * e, args.in[17] + (size_t)e * D * FF, D, FF, EGU8 + (size_t)e * GU * D, 2, pg8::F8_SW1);
                conv_queue(F, 10 + 3 * e, args.in[18] + (size_t)e * FF * D, FF, D, ED8 + (size_t)e * D * FF, 0, pg8::F8_SW2); }
            gmlp_pull();
        }
        SEAM(pb + 2);
        if (IN(pb + 3)) {
            pg8::Gemm g{Y, (bf16*)(ws + WS_WO) + (size_t)l * D * D, 2 * D}; pg8::StaticOrder S; S.init(M, D, F.G, (int)blockIdx.x);
            if constexpr (l == 0) { pg8::EpiResidB<true> E{args.in[0], XR, D, 1.0f}; pg8::gemm_phase<pg8::EpiResidB<true>, pg8::StaticOrder, true, true>(F.lds + RING_OFF, g, S, E); }
            else { pg8::EpiResidB<false> E{XR, XR, D, 1.0f}; pg8::gemm_phase<pg8::EpiResidB<false>, pg8::StaticOrder, true, true>(F.lds + RING_OFF, g, S, E); }
        }
        SEAM(pb + 3);
        if (IN(pb + 4)) {
            int hc[8];
#pragma unroll
            for (int e = 0; e < 8; ++e) hc[e] = 0;
            if constexpr (l == 1) {
                f32x4 rv8[8];
#pragma unroll
                for (int j = 0; j < 8; ++j) { const int c = F.tid + j * (NWAVES * 64), k = c >> 1, hh = c & 1; rv8[j] = *(const f32x4*)(args.in[15] + (size_t)k * 8 + 4 * hh); }
#pragma unroll
                for (int j = 0; j < 8; ++j) { const int c = F.tid + j * (NWAVES * 64), k = c >> 1, hh = c & 1;
                    *(LAS f32x4*)(F.lds + ((((k >> 9) * 8 + (k & 7)) * 2 + hh) << 10) + ((k >> 3) & 63) * 16) = rv8[j]; }
                __syncthreads();
            }
            f32x4 gn[8]; load_gain_b(args.in[11] + l * D, F.lane, gn);
            v4u rc[4]; if (F.gw < M) load_raw_b(XR + (size_t)F.gw * D, F.lane, rc);
            for (int m = F.gw; m < M; m += F.NGW) {
                v4u rn[4];
#pragma unroll
                for (int j = 0; j < 4; ++j) rn[j] = rc[j];
                if (m + F.NGW < M) load_raw_b(XR + (size_t)(m + F.NGW) * D, F.lane, rn);
                f32x4 v[8]; norm_raw_b(rc, gn, v);
#pragma unroll
                for (int j = 0; j < 4; ++j) rc[j] = rn[j];
                if constexpr (l == 0) {
                    if constexpr (DENSE_F8 == 3) { v2u* d8 = (v2u*)(ws + WS_XS8 + (size_t)m * D) + F.lane;
#pragma unroll
                        for (int j = 0; j < 4; ++j) { const f32x4 a0 = v[2 * j] * pg8::F8_SX, a1 = v[2 * j + 1] * pg8::F8_SX; v2u q; q.x = pg8::pk4_fp8(a0[0], a0[1], a0[2], a0[3]); q.y = pg8::pk4_fp8(a1[0], a1[1], a1[2], a1[3]); d8[64 * j] = q; } }
                    else store_row_bf16_b(XN + (size_t)m * D, F.lane, v); }
                if constexpr (l == 1) {
                    asm volatile("" ::: "memory");
                    float lg[8];
#pragma unroll
                    for (int e = 0; e < 8; ++e) lg[e] = 0.f;
#pragma unroll
                    for (int j = 0; j < 4; ++j)
#pragma unroll
                        for (int i = 0; i < 8; ++i) { const f32x4 r0 = *(const LAS f32x4*)(F.lds + (((j * 8 + i) * 2) << 10) + F.lane * 16), r1 = *(const LAS f32x4*)(F.lds + (((j * 8 + i) * 2 + 1) << 10) + F.lane * 16); const float hv = v[2 * j + (i >> 2)][i & 3];
                            lg[0] += hv * r0.x; lg[1] += hv * r0.y; lg[2] += hv * r0.z; lg[3] += hv * r0.w; lg[4] += hv * r1.x; lg[5] += hv * r1.y; lg[6] += hv * r1.z; lg[7] += hv * r1.w; }
#pragma unroll
                    for (int e = 0; e < 8; ++e) lg[e] = wave_sum(lg[e]);
                    int e0 = 0; float v0 = lg[0];
#pragma unroll
                    for (int e = 1; e < 8; ++e) if (lg[e] > v0) { v0 = lg[e]; e0 = e; }
                    int e1 = -1; float v1 = -3.0e38f;
#pragma unroll
                    for (int e = 0; e < 8; ++e) if (e != e0 && lg[e] > v1) { v1 = lg[e]; e1 = e; }
                    const float ex = __expf(v1 - v0), w0 = 1.0f / (1.0f + ex), w1 = ex / (1.0f + ex);
                    if (F.lane == 0) { *(i32x2*)(((int*)(ws + WS_SMALL + SM_TOKE)) + 2 * m) = (i32x2){e0, e1}; *(f32x2*)(((float*)(ws + WS_SMALL + SM_TOKW)) + 2 * m) = (f32x2){w0, w1}; }
#pragma unroll
                    for (int e = 0; e < 8; ++e) hc[e] += (e == e0 ? 1 : 0) + (e == e1 ? 1 : 0);
                }
            }
            if (l == 1 && F.lane == 0) { *(i32x4*)(((int*)(ws + WS_SMALL + SM_WHIST)) + 8 * F.gw) = (i32x4){hc[0], hc[1], hc[2], hc[3]}; *(i32x4*)(((int*)(ws + WS_SMALL + SM_WHIST)) + 8 * F.gw + 4) = (i32x4){hc[4], hc[5], hc[6], hc[7]}; }
        }
        SEAM(pb + 4);
        if constexpr (l == 0) {
            if (IN(6)) {
                pg8::StaticOrder S; S.init(M, GU, F.G, (int)blockIdx.x);
                if constexpr (DENSE_F8 == 1) { pg8::Gemm g{ws + WS_XS8, ws + WS_WGU, D}; pg8::EpiSwiglu8 E{(unsigned char*)H, FF, pg8::F8_INV1};
                    pg8::gemm_phase<pg8::EpiSwiglu8, pg8::StaticOrder, true, true, true>(F.lds + RING_OFF, g, S, E); }
                else if constexpr (DENSE_F8 == 2) { pg8::Gemm g{XN, (bf16*)(ws + WS_WGU), 2 * D}; pg8::EpiSwiglu8 E{(unsigned char*)H, FF, 1.0f};
                    pg8::gemm_phase<pg8::EpiSwiglu8, pg8::StaticOrder, true, true>(F.lds + RING_OFF, g, S, E); }
                else if constexpr (DENSE_F8 == 3) { pg8::Gemm g{ws + WS_XS8, ws + WS_WGU, D}; pg8::EpiSwiglu E{H, FF, pg8::F8_INV1};
                    pg8::gemm_phase<pg8::EpiSwiglu, pg8::StaticOrder, false, true, true>(F.lds + RING_OFF, g, S, E); }
                else { pg8::Gemm g{XN, (bf16*)(ws + WS_WGU), 2 * D}; pg8::EpiSwiglu E{H, FF, 1.0f};
                    pg8::gemm_phase<pg8::EpiSwiglu, pg8::StaticOrder, true, true>(F.lds + RING_OFF, g, S, E); }
            }
            SEAM(6);
            if (IN(7)) {
                pg8::StaticOrder S; S.init(M, D, F.G, (int)blockIdx.x);
                if constexpr (DENSE_F8 == 1 || DENSE_F8 == 2) { pg8::Gemm g{H, ws + WS_WD, FF}; pg8::EpiResidB<false> E{XR, XR, D, pg8::F8_INV2};
                    pg8::gemm_phase<pg8::EpiResidB<false>, pg8::StaticOrder, true, true, true>(F.lds + RING_OFF, g, S, E); }
                else { pg8::Gemm g{H, (bf16*)(ws + WS_WD), 2 * FF}; pg8::EpiResidB<false> E{XR, XR, D, 1.0f};
                    pg8::gemm_phase<pg8::EpiResidB<false>, pg8::StaticOrder, true, true>(F.lds + RING_OFF, g, S, E); }
            }
            SEAM(7);
        }
}

__global__ void __launch_bounds__(NWAVES * 64, 2) trunk_fwd(Args args) {
    extern __shared__ __attribute__((aligned(16))) unsigned char lds[];
    Frame F;
    F.lds = (LAS unsigned char*)lds;
    F.tid = threadIdx.x; F.lane = F.tid & 63; F.wave = __builtin_amdgcn_readfirstlane(F.tid >> 6);
    F.G = gridDim.x; F.gw = blockIdx.x * NWAVES + F.wave; F.NGW = F.G * NWAVES; F.ws = args.ws;
    unsigned char* ws = args.ws;
    for (int u = F.tid; u < (LDS_BYTES - LDSCTL_OFF) / 4; u += NWAVES * 64) ((LAS unsigned*)(F.lds + LDSCTL_OFF))[u] = 0u;
    __syncthreads();
    volatile LAS unsigned* MISC = (volatile LAS unsigned*)(F.lds + MISC_OFF);
    const int lo = args.ph_lo, hi = args.ph_hi;
    XcdBarrier bar; bar.bar = (unsigned*)(ws + WS_CTL) + CW_BAR; bar.x = 0; bar.st = nullptr;
    if (hi - lo > 1) bar = xcd_barrier_post((unsigned*)(ws + WS_CTL) + CW_BAR, MISC + 8);

    float* out = args.out;
    bf16* XN = (bf16*)(ws + WS_XN); bf16* H = (bf16*)(ws + WS_H); bf16* XS = (bf16*)(ws + WS_XS);
    int* TOKE = (int*)(ws + WS_SMALL + SM_TOKE); float* TOKW = (float*)(ws + WS_SMALL + SM_TOKW); int* TOKP = (int*)(ws + WS_SMALL + SM_TOKP);
    int* WHIST = (int*)(ws + WS_SMALL + SM_WHIST); int* MTS = (int*)(ws + WS_SMALL + SM_TS);

    if (IN(0)) for (int rep = 0; rep < REP_CONV; ++rep) {
        bf16* WIN = (bf16*)(ws + WS_WIN); bf16* WO = (bf16*)(ws + WS_WO); bf16* WGU = (bf16*)(ws + WS_WGU); bf16* WD = (bf16*)(ws + WS_WD);
        bf16* EGU = (bf16*)(ws + WS_EGU); bf16* ED = (bf16*)(ws + WS_ED);
        { bf16* WC = (bf16*)(ws + WS_SMALL + SM_WC); const float* wsp = args.in[3];
            for (int i = blockIdx.x * (NWAVES * 64) + F.tid; i < 8 * 16384; i += F.G * NWAVES * 64) { const int t = (i >> 6) & 127, sx = 2 * (i & 63); const f32x2 wv = *(const f32x2*)(wsp + 2 * i); ((unsigned*)WC)[i] = pk2(sx <= t ? wv.x : 0.f, sx + 1 <= t ? wv.y : 0.f); } }
        conv_matrix(F, args.in[2], D, DIN, WIN, 0); conv_matrix(F, args.in[10], D, D, WO, 0);
    }

    layer_phases<0>(F, args, bar, lo, hi);
    layer_phases<1>(F, args, bar, lo, hi);

    if (IN(13)) {
        int pre[8], tot[8];
#pragma unroll
        for (int e = 0; e < 8; ++e) { pre[e] = 0; tot[e] = 0; }
        for (int w = F.lane; w < F.NGW; w += 64) { const i32x4 a = *(const i32x4*)(WHIST + 8 * w), b = *(const i32x4*)(WHIST + 8 * w + 4); const int hv[8] = {a.x, a.y, a.z, a.w, b.x, b.y, b.z, b.w};
#pragma unroll
            for (int e = 0; e < 8; ++e) { tot[e] += hv[e]; pre[e] += (w < F.gw) ? hv[e] : 0; } }
        int base[8], ts[9]; ts[0] = 0;
#pragma unroll
        for (int e = 0; e < 8; ++e) { tot[e] = wave_sum_i(tot[e]); pre[e] = wave_sum_i(pre[e]); ts[e + 1] = ts[e] + ((tot[e] + 255) >> 8); base[e] = ts[e] * 256 + pre[e]; }
        if (F.gw == 0 && F.lane == 0) {
#pragma unroll
            for (int e = 0; e < 9; ++e) MTS[e] = ts[e]; }
        f32x4 gn[8]; load_gain_b(args.in[11] + D, F.lane, gn);
        v4u rc[4]; if (F.gw < M) load_raw_b((const bf16*)(ws + WS_O) + (size_t)F.gw * D, F.lane, rc);
        for (int m = F.gw; m < M; m += F.NGW) {
            v4u rn[4];
#pragma unroll
            for (int j = 0; j < 4; ++j) rn[j] = rc[j];
            if (m + F.NGW < M) load_raw_b((const bf16*)(ws + WS_O) + (size_t)(m + F.NGW) * D, F.lane, rn);
            const i32x2 ee = *(const i32x2*)(TOKE + 2 * m); int p0 = 0, p1 = 0;
#pragma unroll
            for (int e = 0; e < 8; ++e) { if (ee.x == e) { p0 = base[e]; base[e] += 1; } if (ee.y == e) { p1 = base[e]; base[e] += 1; } }
            if (F.lane == 0) *(i32x2*)(TOKP + 2 * m) = (i32x2){p0, p1};
            unsigned char* XS8 = (unsigned char*)(ws + WS_XS8);
            f32x4 v[8]; norm_raw_b(rc, gn, v);
#pragma unroll
            for (int j = 0; j < 4; ++j) rc[j] = rn[j];
            v2u* d0 = (v2u*)(XS8 + (size_t)p0 * D) + F.lane; v2u* d1 = (v2u*)(XS8 + (size_t)p1 * D) + F.lane;
#pragma unroll
            for (int j = 0; j < 4; ++j) { const f32x4 a0 = v[2 * j] * pg8::F8_SX, a1 = v[2 * j + 1] * pg8::F8_SX; v2u q;
                q.x = pg8::pk4_fp8(a0[0], a0[1], a0[2], a0[3]); q.y = pg8::pk4_fp8(a1[0], a1[1], a1[2], a1[3]);
                d0[64 * j] = q; d1[64 * j] = q; }
        }
    }
    SEAM(13);
    if (IN(14)) for (int rep = 0; rep < REP_G16; ++rep) {
        pg8::MoeOrder S; S.G = F.G; S.c = (int)blockIdx.x; S.nN = GU / 256;
#pragma unroll
        for (int e = 0; e < 9; ++e) S.ts[e] = __builtin_amdgcn_readfirstlane(MTS[e]);
        pg8::Gemm g{ws + WS_XS8, ws + WS_EGU, D}; pg8::EpiSwiglu8 E{(unsigned char*)H, FF, pg8::F8_INV1};
        pg8::gemm_phase<pg8::EpiSwiglu8, pg8::MoeOrder, false, true, true>(F.lds + RING_OFF, g, S, E);
    }
    SEAM(14);
    if (IN(15)) {
        pg8::MoeOrderT<true> S; S.G = F.G; S.c = (int)blockIdx.x; S.nN = D / 256;
#pragma unroll
        for (int e = 0; e < 9; ++e) S.ts[e] = __builtin_amdgcn_readfirstlane(MTS[e]);
        S.ntk = FF / 128; S.pbuf = (float*)(ws + WS_XN); S.pcnt = (unsigned*)(ws + WS_CTL) + CW_SK; S.lflag = (LAS unsigned*)(F.lds + MISC_OFF + 64);
        pg8::Gemm g{H, ws + WS_ED, FF}; pg8::EpiStoreBf16s E{XS, D, pg8::F8_INV2};
        pg8::gemm_phase<pg8::EpiStoreBf16s, pg8::MoeOrderT<true>, true, true, true>(F.lds + RING_OFF, g, S, E);
    }
    SEAM(15);
    if (IN(16)) {
        const bf16* XR = (const bf16*)(ws + WS_O);
        f32x4 gn[8]; load_gain_b(args.in[19], F.lane, gn);
        v4u xc[4], ac[4], bc[4]; i32x2 ppn = (i32x2){0, 0}; f32x2 wwc = (f32x2){0.f, 0.f}, wwn = (f32x2){0.f, 0.f};
        if (F.gw < M) { const i32x2 pp = *(const i32x2*)(TOKP + 2 * F.gw); wwc = *(const f32x2*)(TOKW + 2 * F.gw);
            load_raw_b(XR + (size_t)F.gw * D, F.lane, xc); load_raw_b(XS + (size_t)pp.x * D, F.lane, ac); load_raw_b(XS + (size_t)pp.y * D, F.lane, bc); }
        if (F.gw + F.NGW < M) { ppn = *(const i32x2*)(TOKP + 2 * (F.gw + F.NGW)); wwn = *(const f32x2*)(TOKW + 2 * (F.gw + F.NGW)); }
        for (int m = F.gw; m < M; m += F.NGW) {
            v4u xn[4], an[4], bn[4]; i32x2 ppnn = ppn; f32x2 wwnn = wwn;
#pragma unroll
            for (int j = 0; j < 4; ++j) { xn[j] = xc[j]; an[j] = ac[j]; bn[j] = bc[j]; }
            if (m + F.NGW < M) { load_raw_b(XR + (size_t)(m + F.NGW) * D, F.lane, xn); load_raw_b(XS + (size_t)ppn.x * D, F.lane, an); load_raw_b(XS + (size_t)ppn.y * D, F.lane, bn); }
            if (m + 2 * F.NGW < M) { ppnn = *(const i32x2*)(TOKP + 2 * (m + 2 * F.NGW)); wwnn = *(const f32x2*)(TOKW + 2 * (m + 2 * F.NGW)); }
            const f32x2 ww = wwc;
            f32x4 v[8]; float s = 0.f;
#pragma unroll
            for (int j = 0; j < 4; ++j) { const v4u px = xc[j], pa = ac[j], pb2 = bc[j];
                v[2 * j] = (f32x4){bflo(px.x) + ww.x * bflo(pa.x) + ww.y * bflo(pb2.x), bfhi(px.x) + ww.x * bfhi(pa.x) + ww.y * bfhi(pb2.x), bflo(px.y) + ww.x * bflo(pa.y) + ww.y * bflo(pb2.y), bfhi(px.y) + ww.x * bfhi(pa.y) + ww.y * bfhi(pb2.y)};
                v[2 * j + 1] = (f32x4){bflo(px.z) + ww.x * bflo(pa.z) + ww.y * bflo(pb2.z), bfhi(px.z) + ww.x * bfhi(pa.z) + ww.y * bfhi(pb2.z), bflo(px.w) + ww.x * bflo(pa.w) + ww.y * bflo(pb2.w), bfhi(px.w) + ww.x * bfhi(pa.w) + ww.y * bfhi(pb2.w)}; }
#pragma unroll
            for (int j = 0; j < 8; ++j) s += (v[j].x * v[j].x + v[j].y * v[j].y) + (v[j].z * v[j].z + v[j].w * v[j].w);
            const float rstd = 1.0f / sqrtf(wave_sum(s) * (1.0f / D) + EPS);
            f32x4* orow = (f32x4*)(out + (size_t)m * D) + 2 * F.lane;
#pragma unroll
            for (int j = 0; j < 4; ++j) { orow[128 * j] = v[2 * j] * rstd * gn[2 * j]; orow[128 * j + 1] = v[2 * j + 1] * rstd * gn[2 * j + 1]; }
#pragma unroll
            for (int j = 0; j < 4; ++j) { xc[j] = xn[j]; ac[j] = an[j]; bc[j] = bn[j]; }
            wwc = wwn; ppn = ppnn; wwn = wwnn;
        }
    }
}

extern "C" void kernel_launch(void* const* d_in, const int* in_sizes, int n_in, void* d_out, int out_size, void* d_ws, size_t ws_size, hipStream_t stream) {
    static int grid = 0;
    if (grid == 0) {
        if (n_in != 20 || in_sizes[0] != M * D || out_size != M * D || ws_size < WS_END) { fprintf(stderr, "kernel_launch: unexpected shapes / workspace (n_in %d, ws %zu, need %zu); nothing launched\n", n_in, ws_size, (size_t)WS_END); grid = -1; return; }
        int dev = 0, cus = 0, per_cu = 0;
        if (hipGetDevice(&dev) != hipSuccess || hipDeviceGetAttribute(&cus, hipDeviceAttributeMultiprocessorCount, dev) != hipSuccess) { grid = -1; return; }
        if (hipFuncSetAttribute((const void*)trunk_fwd, hipFuncAttributeMaxDynamicSharedMemorySize, LDS_BYTES) != hipSuccess) { fprintf(stderr, "kernel_launch: hipFuncSetAttribute failed\n"); grid = -1; return; }
        if (hipOccupancyMaxActiveBlocksPerMultiprocessor(&per_cu, (const void*)trunk_fwd, NWAVES * 64, LDS_BYTES) != hipSuccess || per_cu < 1) fprintf(stderr, "kernel_launch: occupancy query reports %d\n", per_cu);
        (void)hipGetLastError();
        grid = cus;
    }
    if (grid < 0) return;
    if (hipMemsetAsync((char*)d_ws + WS_CTL, 0, CTL_ZERO_BYTES, stream) != hipSuccess) return;
    Args a{};
    for (int i = 0; i < 20; ++i) a.in[i] = (const float*)d_in[i];
    a.out = (float*)d_out; a.ws = (unsigned char*)d_ws;
#if MK_ONE_LAUNCH
    a.ph_lo = 0; a.ph_hi = NPHASE;
    hipLaunchKernelGGL(trunk_fwd, dim3(grid), dim3(NWAVES * 64), LDS_BYTES, stream, a);
#else
    for (int p = 0; p < NPHASE; ++p) {
        a.ph_lo = p; a.ph_hi = p + 1;
        hipLaunchKernelGGL(trunk_fwd, dim3(grid), dim3(NWAVES * 64), LDS_BYTES, stream, a);
    }
#endif
}
```

```cpp
#include <hip/hip_runtime.h>
#include <cstdio>
#include <cstdint>

#ifndef REP_CONV
#define REP_CONV 1
#endif
#ifndef REP_MIX
#define REP_MIX 1
#endif
#ifndef REP_G16
#define REP_G16 1
#endif
#ifndef DENSE_F8
#define DENSE_F8 3
#endif
#ifndef MK_ONE_LAUNCH
#define MK_ONE_LAUNCH 1
#endif

namespace pg8 {
#define PG8_LAS __attribute__((address_space(3)))
typedef unsigned short bf16_t;
typedef short bf16x8 __attribute__((ext_vector_type(8)));
typedef float f32x4 __attribute__((ext_vector_type(4)));
typedef unsigned u32x4 __attribute__((ext_vector_type(4)));
constexpr int BM = 256, BK = 64, HALF = 128, HTB = HALF * BK * 2, STAGE_BYTES = 8 * HTB, NXCD = 8, WGM = 8;

__host__ __device__ __forceinline__ int lds_byte(int r, int c) { const int st = (r >> 4) * 2 + (c >> 5), rr = r & 15, cc = c & 31, ob = rr * 64 + cc * 2; return st * 1024 + (ob ^ (((ob >> 9) & 1) << 5)); }
__host__ __device__ __forceinline__ void stage_rc(int b, int& R, int& C) { const int st = b / 1024, sb = b % 1024, swz = sb ^ (((sb >> 9) & 1) << 5); R = (st >> 1) * 16 + swz / 64; C = (st & 1) * 32 + (swz % 64) / 2; }
__host__ __device__ __forceinline__ int perm32(int rho) { const int n = rho >> 4, i = rho & 15; return 8 * (i >> 2) + 4 * n + (i & 3); }

struct Unit { int pm, pn, po; int kt0, knt, part, tix, sp; };
struct Gemm { const void* A; const void* Bt; int Kb; };

struct StaticOrder {
    static constexpr bool SPLITK = false;
    int nM, nN, nwg, G, c;
    __host__ __device__ void init(int M, int N, int G_, int c_) { nM = M / BM; nN = N / BM; nwg = nM * nN; G = G_; c = c_; }
    __host__ __device__ bool next(int i, Unit& u) const {
        const long L = (long)i * G + c; if (L >= nwg) return false;
        int wgid = (int)L; { const int q = nwg / NXCD, r = nwg % NXCD, xcd = wgid % NXCD, off = wgid / NXCD; wgid = (xcd < r ? xcd * (q + 1) : r * (q + 1) + (xcd - r) * q) + off; }
        const int nig = WGM * nN, gid = wgid / nig, fm = gid * WGM, gsz = (nM - fm) < WGM ? (nM - fm) : WGM;
        u.pm = fm + ((wgid % nig) % gsz); u.pn = (wgid % nig) / gsz; u.po = u.pn; return true;
    }
    __device__ __forceinline__ void a_ready(const Unit&) const {}
    __device__ __forceinline__ void done(const Unit&) const {}
};
template <bool SK> struct MoeOrderT {
    static constexpr bool SPLITK = SK;
    int G, c, nN; int ts[9];
    int ntk; float* pbuf; unsigned* pcnt; PG8_LAS unsigned* lflag;
    __device__ __forceinline__ void locate(int L, Unit& u) const {
        int e = 0;
#pragma unroll
        for (int j = 1; j < 8; ++j) e = (L >= ts[j] * nN) ? j : e;
        int tse = ts[0], tsn = ts[1];
#pragma unroll
        for (int j = 1; j < 8; ++j) { tse = (e == j) ? ts[j] : tse; tsn = (e == j) ? ts[j + 1] : tsn; }
        const int l = L - tse * nN, te = tsn - tse;
        const int cg = l / (te * 4), rem = l - cg * (te * 4), pr = rem >> 2;
        u.pm = tse + pr; u.po = cg * 4 + (rem & 3); u.pn = e * nN + u.po;
    }
    __device__ __forceinline__ int unit_index(int i) const { const int per = G >> 3; return ((G & 7) == 0) ? (i * 8 + (c & 7)) * per + (c >> 3) : i * G + c; }
    __device__ __forceinline__ int nsplit(int T) const { int sp = 1; if (SK && T > 0) { sp = G / T; sp = sp > 4 ? 4 : sp; } return sp; }
    __device__ __forceinline__ bool next(int i, Unit& u) const {
        const int total = ts[8] * nN;
        if constexpr (SK) {
            const int R = total / G, T = total - R * G, sp = nsplit(T);
            if (i >= R && sp > 1) {
                if (i > R || c >= T * sp) return false;
                const int part = c / T, tix = c - part * T, pairs = ntk >> 1, base = pairs / sp, extra = pairs - base * sp;
                locate(R * G + tix, u);
                u.part = part; u.tix = tix; u.sp = sp; u.kt0 = 2 * (part * base + (part < extra ? part : extra)); u.knt = 2 * (base + (part < extra ? 1 : 0)); return true;
            }
            u.part = -1; u.tix = 0; u.sp = 1; u.kt0 = 0; u.knt = ntk;
        }
        const int L = unit_index(i); if (L >= total) return false;
        locate(L, u); return true;
    }
    __device__ __forceinline__ void a_ready(const Unit&) const {}
    __device__ __forceinline__ void done(const Unit&) const {}
};
typedef MoeOrderT<false> MoeOrder;


typedef float f32x2c __attribute__((ext_vector_type(2)));
typedef __bf16 bf16x2c __attribute__((ext_vector_type(2)));
__device__ __forceinline__ unsigned cvt_pk_bf16(float lo, float hi) { const f32x2c v = {lo, hi}; return __builtin_bit_cast(unsigned, __builtin_convertvector(v, bf16x2c)); }

struct EpiStoreBf16 {
    static constexpr bool PERM = true, AFTER_DRAIN = false;
    bf16_t* O; int ldc;
    __device__ __forceinline__ void operator()(const f32x4 (&acc)[2][2][4][2], const Unit& u, int wr, int wc, int fr, int fq) const {
        const int row0 = u.pm * BM + wr * 64 + fr, col0 = u.po * BM + wc * 32 + 8 * fq;
#pragma unroll
        for (int ai = 0; ai < 2; ++ai)
#pragma unroll
            for (int m = 0; m < 4; ++m) { bf16_t* rowp = O + (size_t)(row0 + ai * HALF + m * 16) * ldc + col0;
#pragma unroll
                for (int bj = 0; bj < 2; ++bj) { const f32x4 v0 = acc[ai][bj][m][0], v1 = acc[ai][bj][m][1];
                    u32x4 w; w.x = cvt_pk_bf16(v0[0], v0[1]); w.y = cvt_pk_bf16(v0[2], v0[3]); w.z = cvt_pk_bf16(v1[0], v1[1]); w.w = cvt_pk_bf16(v1[2], v1[3]);
                    *(u32x4*)(rowp + bj * HALF) = w; } }
    }
};
struct EpiResid {
    static constexpr bool PERM = false, AFTER_DRAIN = false;
    const float* base; float* out; int ldc; float scale;
    __device__ __forceinline__ void operator()(const f32x4 (&acc)[2][2][4][2], const Unit& u, int wr, int wc, int fr, int fq) const {
        const int row0 = u.pm * BM + wr * 64 + fr, col0 = u.po * BM + wc * 32 + 4 * fq;
#pragma unroll
        for (int ai = 0; ai < 2; ++ai)
#pragma unroll
            for (int m = 0; m < 4; ++m) { const size_t off = (size_t)(row0 + ai * HALF + m * 16) * ldc + col0;
#pragma unroll
                for (int bj = 0; bj < 2; ++bj)
#pragma unroll
                    for (int n = 0; n < 2; ++n) { const f32x4 b = *(const f32x4*)(base + off + bj * HALF + n * 16); *(f32x4*)(out + off + bj * HALF + n * 16) = b + acc[ai][bj][m][n] * scale; }
                asm volatile("" ::: "memory"); }
    }
};
template <bool BASE_F32> struct EpiResidB {
    static constexpr bool PERM = true, AFTER_DRAIN = false;
    const void* base; bf16_t* out; int ldc; float scale;
    __device__ __forceinline__ void operator()(const f32x4 (&acc)[2][2][4][2], const Unit& u, int wr, int wc, int fr, int fq) const {
        const int row0 = u.pm * BM + wr * 64 + fr, col0 = u.po * BM + wc * 32 + 8 * fq;
        if constexpr (!BASE_F32) {
            u32x4 t[2][4][2];
#pragma unroll
            for (int ai = 0; ai < 2; ++ai)
#pragma unroll
                for (int m = 0; m < 4; ++m)
#pragma unroll
                    for (int bj = 0; bj < 2; ++bj) t[ai][m][bj] = *(const u32x4*)((const bf16_t*)base + (size_t)(row0 + ai * HALF + m * 16) * ldc + col0 + bj * HALF);
#pragma unroll
            for (int ai = 0; ai < 2; ++ai)
#pragma unroll
                for (int m = 0; m < 4; ++m)
#pragma unroll
                    for (int bj = 0; bj < 2; ++bj) { const u32x4 q = t[ai][m][bj];
                        const f32x4 b0 = (f32x4){__builtin_bit_cast(float, q.x << 16), __builtin_bit_cast(float, q.x & 0xffff0000u), __builtin_bit_cast(float, q.y << 16), __builtin_bit_cast(float, q.y & 0xffff0000u)};
                        const f32x4 b1 = (f32x4){__builtin_bit_cast(float, q.z << 16), __builtin_bit_cast(float, q.z & 0xffff0000u), __builtin_bit_cast(float, q.w << 16), __builtin_bit_cast(float, q.w & 0xffff0000u)};
                        const f32x4 v0 = b0 + acc[ai][bj][m][0] * scale, v1 = b1 + acc[ai][bj][m][1] * scale;
                        u32x4 w; w.x = cvt_pk_bf16(v0[0], v0[1]); w.y = cvt_pk_bf16(v0[2], v0[3]); w.z = cvt_pk_bf16(v1[0], v1[1]); w.w = cvt_pk_bf16(v1[2], v1[3]);
                        *(u32x4*)(out + (size_t)(row0 + ai * HALF + m * 16) * ldc + col0 + bj * HALF) = w; }
            return;
        }
#pragma unroll
        for (int ai = 0; ai < 2; ++ai) {
            f32x4 b0[4][2], b1[4][2];
            if constexpr (BASE_F32) {
#pragma unroll
                for (int m = 0; m < 4; ++m)
#pragma unroll
                    for (int bj = 0; bj < 2; ++bj) { const float* bp = (const float*)base + (size_t)(row0 + ai * HALF + m * 16) * ldc + col0 + bj * HALF; b0[m][bj] = *(const f32x4*)bp; b1[m][bj] = *(const f32x4*)(bp + 4); }
            } else {
                u32x4 t[4][2];
#pragma unroll
                for (int m = 0; m < 4; ++m)
#pragma unroll
                    for (int bj = 0; bj < 2; ++bj) t[m][bj] = *(const u32x4*)((const bf16_t*)base + (size_t)(row0 + ai * HALF + m * 16) * ldc + col0 + bj * HALF);
#pragma unroll
                for (int m = 0; m < 4; ++m)
#pragma unroll
                    for (int bj = 0; bj < 2; ++bj) { const u32x4 q = t[m][bj];
                        b0[m][bj] = (f32x4){__builtin_bit_cast(float, q.x << 16), __builtin_bit_cast(float, q.x & 0xffff0000u), __builtin_bit_cast(float, q.y << 16), __builtin_bit_cast(float, q.y & 0xffff0000u)};
                        b1[m][bj] = (f32x4){__builtin_bit_cast(float, q.z << 16), __builtin_bit_cast(float, q.z & 0xffff0000u), __builtin_bit_cast(float, q.w << 16), __builtin_bit_cast(float, q.w & 0xffff0000u)}; }
            }
#pragma unroll
            for (int m = 0; m < 4; ++m)
#pragma unroll
                for (int bj = 0; bj < 2; ++bj) { const f32x4 v0 = b0[m][bj] + acc[ai][bj][m][0] * scale, v1 = b1[m][bj] + acc[ai][bj][m][1] * scale;
                    u32x4 w; w.x = cvt_pk_bf16(v0[0], v0[1]); w.y = cvt_pk_bf16(v0[2], v0[3]); w.z = cvt_pk_bf16(v1[0], v1[1]); w.w = cvt_pk_bf16(v1[2], v1[3]);
                    *(u32x4*)(out + (size_t)(row0 + ai * HALF + m * 16) * ldc + col0 + bj * HALF) = w; }
        }
    }
};
__device__ __forceinline__ float silu_f(float x) { return x * __builtin_amdgcn_rcpf(1.0f + __expf(-x)); }
__device__ __forceinline__ f32x2c exp2_2(f32x2c t) { return (f32x2c){__builtin_amdgcn_exp2f(t.x), __builtin_amdgcn_exp2f(t.y)}; }
__device__ __forceinline__ f32x2c rcp_2(f32x2c t) { return (f32x2c){__builtin_amdgcn_rcpf(t.x), __builtin_amdgcn_rcpf(t.y)}; }
__device__ __forceinline__ f32x2c silu_2(f32x2c x) { return x * rcp_2(exp2_2(x * -1.4426950408889634f) + 1.0f); }
__device__ __forceinline__ f32x2c gelu_2(f32x2c x) { const f32x2c t = x * (x * x * -0.10294322f + -2.3022082f); return x * rcp_2(exp2_2(t) + 1.0f); }
__device__ __forceinline__ unsigned cvt_pk_bf16_2(f32x2c v) { return __builtin_bit_cast(unsigned, __builtin_convertvector(v, bf16x2c)); }
struct EpiSwiglu {
    static constexpr bool PERM = true, AFTER_DRAIN = false;
    bf16_t* O; int ldc; float isc;
    __device__ __forceinline__ void operator()(const f32x4 (&acc)[2][2][4][2], const Unit& u, int wr, int wc, int fr, int fq) const {
        const int row0 = u.pm * BM + wr * 64 + fr, col0 = u.po * HALF + wc * 32 + 8 * fq;
        const float kn = -1.4426950408889634f * isc, invC = 1.0f / (isc * isc);
#pragma unroll
        for (int ai = 0; ai < 2; ++ai)
#pragma unroll
            for (int m = 0; m < 4; ++m) { bf16_t* rowp = O + (size_t)(row0 + ai * HALF + m * 16) * ldc + col0;
                const f32x4 g0 = acc[ai][0][m][0], g1 = acc[ai][0][m][1], u0 = acc[ai][1][m][0], u1 = acc[ai][1][m][1];
                const f32x2c ga = {g0[0], g0[1]}, gb = {g0[2], g0[3]}, gc = {g1[0], g1[1]}, gd = {g1[2], g1[3]};
                const f32x2c ua = {u0[0], u0[1]}, ub = {u0[2], u0[3]}, uc = {u1[0], u1[1]}, ud = {u1[2], u1[3]};
                const f32x2c ha = (ga * ua) * rcp_2(exp2_2(ga * kn) * invC + invC), hb = (gb * ub) * rcp_2(exp2_2(gb * kn) * invC + invC);
                const f32x2c hc = (gc * uc) * rcp_2(exp2_2(gc * kn) * invC + invC), hd = (gd * ud) * rcp_2(exp2_2(gd * kn) * invC + invC);
                u32x4 w; w.x = cvt_pk_bf16_2(ha); w.y = cvt_pk_bf16_2(hb); w.z = cvt_pk_bf16_2(hc); w.w = cvt_pk_bf16_2(hd);
                *(u32x4*)rowp = w; }
    }
};


__device__ __forceinline__ float clamp8(float v) { return __builtin_amdgcn_fmed3f(v, -448.0f, 448.0f); }
__device__ __forceinline__ unsigned pk4_fp8(float a, float b, float c, float d) { int p = __builtin_amdgcn_cvt_pk_fp8_f32(clamp8(a), clamp8(b), 0, false); p = __builtin_amdgcn_cvt_pk_fp8_f32(clamp8(c), clamp8(d), p, true); return (unsigned)p; }
constexpr float F8_SX = 8.0f, F8_SW1 = 256.0f, F8_SH = 4.0f, F8_SW2 = 512.0f;
constexpr float F8_INV1 = 1.0f / (F8_SX * F8_SW1), F8_INV2 = 1.0f / (F8_SH * F8_SW2);
typedef unsigned u32x2 __attribute__((ext_vector_type(2)));
struct EpiSwiglu8 {
    static constexpr bool PERM = true, AFTER_DRAIN = false;
    unsigned char* O; int ldc; float isc;
    __device__ __forceinline__ void operator()(const f32x4 (&acc)[2][2][4][2], const Unit& u, int wr, int wc, int fr, int fq) const {
        const int row0 = u.pm * BM + wr * 64 + fr, col0 = u.po * HALF + wc * 32 + 8 * fq;
        const float kn = -1.4426950408889634f * isc, invC = 1.0f / (isc * isc * F8_SH);
#pragma unroll
        for (int ai = 0; ai < 2; ++ai)
#pragma unroll
            for (int m = 0; m < 4; ++m) { unsigned char* rowp = O + (size_t)(row0 + ai * HALF + m * 16) * ldc + col0;
                const f32x4 g0 = acc[ai][0][m][0], g1 = acc[ai][0][m][1], u0 = acc[ai][1][m][0], u1 = acc[ai][1][m][1];
                const f32x2c ga = {g0[0], g0[1]}, gb = {g0[2], g0[3]}, gc = {g1[0], g1[1]}, gd = {g1[2], g1[3]};
                const f32x2c ua = {u0[0], u0[1]}, ub = {u0[2], u0[3]}, uc = {u1[0], u1[1]}, ud = {u1[2], u1[3]};
                const f32x2c ha = (ga * ua) * rcp_2(exp2_2(ga * kn) * invC + invC), hb = (gb * ub) * rcp_2(exp2_2(gb * kn) * invC + invC);
                const f32x2c hc = (gc * uc) * rcp_2(exp2_2(gc * kn) * invC + invC), hd = (gd * ud) * rcp_2(exp2_2(gd * kn) * invC + invC);
                u32x2 w; w.x = pk4_fp8(ha.x, ha.y, hb.x, hb.y); w.y = pk4_fp8(hc.x, hc.y, hd.x, hd.y);
                *(u32x2*)rowp = w; }
    }
};
struct EpiStoreBf16s {
    static constexpr bool PERM = true, AFTER_DRAIN = false;
    bf16_t* O; int ldc; float scale;
    __device__ __forceinline__ void operator()(const f32x4 (&acc)[2][2][4][2], const Unit& u, int wr, int wc, int fr, int fq) const {
        const int row0 = u.pm * BM + wr * 64 + fr, col0 = u.po * BM + wc * 32 + 8 * fq;
#pragma unroll
        for (int ai = 0; ai < 2; ++ai)
#pragma unroll
            for (int m = 0; m < 4; ++m) { bf16_t* rowp = O + (size_t)(row0 + ai * HALF + m * 16) * ldc + col0;
#pragma unroll
                for (int bj = 0; bj < 2; ++bj) { const f32x4 v0 = acc[ai][bj][m][0] * scale, v1 = acc[ai][bj][m][1] * scale;
                    u32x4 w; w.x = cvt_pk_bf16(v0[0], v0[1]); w.y = cvt_pk_bf16(v0[2], v0[3]); w.z = cvt_pk_bf16(v1[0], v1[1]); w.w = cvt_pk_bf16(v1[2], v1[3]);
                    *(u32x4*)(rowp + bj * HALF) = w; } }
    }
};

__device__ __forceinline__ float gelu_f(float x) { const float u = 0.7978845608028654f * (x + 0.044715f * x * x * x); return x * __builtin_amdgcn_rcpf(1.0f + __expf(-2.0f * u)); }
struct EpiZ {
    static constexpr bool PERM = true, AFTER_DRAIN = false;
    bf16_t* O; int ldc; const float* lbl; int layer;
    __device__ __forceinline__ void operator()(const f32x4 (&acc)[2][2][4][2], const Unit& u, int wr, int wc, int fr, int fq) const {
        const int row0 = u.pm * BM + wr * 64 + fr, col0 = u.po * BM + wc * 32 + 8 * fq, blk = u.po >> 2;
#pragma unroll
        for (int bj = 0; bj < 2; ++bj) {
            float lb[8];
#pragma unroll
            for (int j = 0; j < 8; ++j) lb[j] = 0.f;
            if (blk == 3 && layer == 1) { const int cc = col0 + bj * HALF - 3072;
                const f32x4 a0 = *(const f32x4*)(lbl + cc), a1 = *(const f32x4*)(lbl + cc + 4), b0 = *(const f32x4*)(lbl + 1024 + cc), b1 = *(const f32x4*)(lbl + 1024 + cc + 4);
#pragma unroll
                for (int j = 0; j < 4; ++j) { lb[j] = 1.0f / (1.0f + __expf(a0[j] - b0[j])); lb[4 + j] = 1.0f / (1.0f + __expf(a1[j] - b1[j])); } }
#pragma unroll
            for (int ai = 0; ai < 2; ++ai)
#pragma unroll
                for (int m = 0; m < 4; ++m) { bf16_t* rowp = O + (size_t)(row0 + ai * HALF + m * 16) * ldc + col0 + bj * HALF;
                    const f32x4 q0 = acc[ai][bj][m][0], q1 = acc[ai][bj][m][1];
                    f32x2c v[4] = {{q0[0], q0[1]}, {q0[2], q0[3]}, {q1[0], q1[1]}, {q1[2], q1[3]}};
                    if (blk == 2 || blk == 5) {
#pragma unroll
                        for (int j = 0; j < 4; ++j) v[j] = silu_2(v[j]);
                    } else if (blk == 3) {
#pragma unroll
                        for (int j = 0; j < 4; ++j) { const f32x2c sg = rcp_2(exp2_2(v[j] * -1.4426950408889634f) + 1.0f); const f32x2c lbv = {lb[2 * j], lb[2 * j + 1]}; const f32x2c f = lbv + (1.0f - lbv) * sg;
                            v[j] = (f32x2c){__builtin_amdgcn_logf(__builtin_amdgcn_fmed3f(f.x, 1e-6f, 1.0f)), __builtin_amdgcn_logf(__builtin_amdgcn_fmed3f(f.y, 1e-6f, 1.0f))} * 0.6931471805599453f; }
                    }
                    u32x4 w; w.x = cvt_pk_bf16_2(v[0]); w.y = cvt_pk_bf16_2(v[1]); w.z = cvt_pk_bf16_2(v[2]); w.w = cvt_pk_bf16_2(v[3]);
                    *(u32x4*)rowp = w; }
        }
    }
};

typedef int v8i __attribute__((ext_vector_type(8)));
typedef int v4i __attribute__((ext_vector_type(4)));
template <class Epi, class Sched, bool ALIGN_EPI = false, bool SP2 = false, bool F8 = false>
__device__ __forceinline__ void gemm_phase(PG8_LAS unsigned char* lds, const Gemm g, const Sched& S, const Epi& E) {
    const int tid = threadIdx.x, wid = __builtin_amdgcn_readfirstlane(tid >> 6), lane = tid & 63, wr = wid >> 2, wc = wid & 3, fr = lane & 15, fq = lane >> 4;
    const int Kb = g.Kb, nt = Kb / 128;
    unsigned voffA[2], voffB[2];
#pragma unroll
    for (int i = 0; i < 2; ++i) { int R, C; stage_rc(tid * 16 + i * 8192, R, C); const int Rb = Epi::PERM ? ((R & ~31) + perm32(R & 31)) : R;
        voffA[i] = (unsigned)(R * Kb + C * 2); voffB[i] = (unsigned)(Rb * Kb + C * 2); }
    const size_t kstep = (size_t)(BK * 2);
    const size_t hstep = (size_t)HALF * Kb;
    const size_t tstep = 2 * hstep;
    const unsigned ldsw = (unsigned)wid * 1024u;
    const int aoff = lds_byte(wr * 64 + fr, fq * 8), boff = lds_byte(wc * 32 + fr, fq * 8);
#define PG8_SA(b, h) (((b) * 2 + (h)) * HTB)
#define PG8_SB(b, h) ((4 + (b) * 2 + (h)) * HTB)
#define PG8_STAGE(bufoff, gbase, voff) do { _Pragma("unroll") for (int _i = 0; _i < 2; ++_i) \
        __builtin_amdgcn_global_load_lds((const unsigned*)((const char*)(gbase) + (voff)[_i]), (PG8_LAS unsigned*)(lds + (bufoff) + ldsw + _i * 8192), 16, 0, 0); } while (0)
#define PG8_LDA(dst, b, h) do { if constexpr (F8) { _Pragma("unroll") for (int m = 0; m < 4; ++m) { dst##8[m].lo = *(const PG8_LAS v4i*)(lds + PG8_SA(b, h) + aoff + m * 2048); dst##8[m].hi = *(const PG8_LAS v4i*)(lds + PG8_SA(b, h) + aoff + m * 2048 + 1024); } } \
        else { _Pragma("unroll") for (int m = 0; m < 4; ++m) _Pragma("unroll") for (int k = 0; k < 2; ++k) dst[m][k] = *(const PG8_LAS bf16x8*)(lds + PG8_SA(b, h) + aoff + m * 2048 + k * 1024); } } while (0)
#define PG8_LDB(dst, b, h) do { if constexpr (F8) { _Pragma("unroll") for (int n = 0; n < 2; ++n) { dst##8[n].lo = *(const PG8_LAS v4i*)(lds + PG8_SB(b, h) + boff + n * 2048); dst##8[n].hi = *(const PG8_LAS v4i*)(lds + PG8_SB(b, h) + boff + n * 2048 + 1024); } } \
        else { _Pragma("unroll") for (int n = 0; n < 2; ++n) _Pragma("unroll") for (int k = 0; k < 2; ++k) dst[n][k] = *(const PG8_LAS bf16x8*)(lds + PG8_SB(b, h) + boff + n * 2048 + k * 1024); } } while (0)
#define PG8_MMA(ai, bj, At, Bt) do { __builtin_amdgcn_s_setprio(1); if constexpr (F8) { _Pragma("unroll") for (int m = 0; m < 4; ++m) _Pragma("unroll") for (int n = 0; n < 2; ++n) \
            asm volatile("v_mfma_f32_16x16x128_f8f6f4 %0, %1, %2, %0" : "+v"(acc[ai][bj][m][n]) : "v"(Bt##8[n]), "v"(At##8[m])); } \
        else { _Pragma("unroll") for (int m = 0; m < 4; ++m) _Pragma("unroll") for (int n = 0; n < 2; ++n) _Pragma("unroll") for (int k = 0; k < 2; ++k) \
            acc[ai][bj][m][n] = __builtin_amdgcn_mfma_f32_16x16x32_bf16(Bt[n][k], At[m][k], acc[ai][bj][m][n], 0, 0, 0); } __builtin_amdgcn_s_setprio(0); } while (0)
#define PG8_WAIT_V(n) asm volatile("s_waitcnt vmcnt(" #n ")" ::: "memory")
#define PG8_WAIT_L(n) asm volatile("s_waitcnt lgkmcnt(" #n ")" ::: "memory")
#define PG8_BAR __builtin_amdgcn_s_barrier()
#define PG8_SCHED __builtin_amdgcn_sched_barrier(0)
    Unit cur, nxt; int ui = 0;
    if (!S.next(0, cur)) return;
    f32x4 acc[2][2][4][2];
#pragma unroll
    for (int a = 0; a < 2; ++a)
#pragma unroll
        for (int b = 0; b < 2; ++b)
#pragma unroll
            for (int m = 0; m < 4; ++m)
#pragma unroll
                for (int n = 0; n < 2; ++n) acc[a][b][m][n] = (f32x4){0.f, 0.f, 0.f, 0.f};
    bf16x8 At[4][2], B0[2][2], B1[2][2]; v8i At8[4], B08[2], B18[2];
    const char* cA = (const char*)g.A + (size_t)cur.pm * tstep; const char* cB = (const char*)g.Bt + (size_t)cur.pn * tstep;
    if constexpr (Sched::SPLITK) { cA += (size_t)cur.kt0 * kstep; cB += (size_t)cur.kt0 * kstep; }
    S.a_ready(cur);
    if constexpr (SP2) {
        PG8_STAGE(PG8_SB(0, 0), cB, voffB); PG8_STAGE(PG8_SB(0, 1), cB + hstep, voffB); PG8_STAGE(PG8_SA(0, 0), cA, voffA); PG8_STAGE(PG8_SA(0, 1), cA + hstep, voffA);
        if (wr == 1) PG8_BAR;
        PG8_WAIT_V(2); PG8_BAR;
        PG8_STAGE(PG8_SB(1, 0), cB + kstep, voffB); PG8_STAGE(PG8_SA(1, 0), cA + kstep, voffA); PG8_STAGE(PG8_SB(1, 1), cB + hstep + kstep, voffB);
        PG8_WAIT_V(6); PG8_BAR;
    } else {
        PG8_STAGE(PG8_SB(0, 0), cB, voffB); PG8_STAGE(PG8_SA(0, 0), cA, voffA); PG8_STAGE(PG8_SB(0, 1), cB + hstep, voffB); PG8_STAGE(PG8_SA(0, 1), cA + hstep, voffA);
        if (wr == 1) PG8_BAR;
        PG8_WAIT_V(4); PG8_BAR;
        PG8_STAGE(PG8_SB(1, 0), cB + kstep, voffB); PG8_STAGE(PG8_SA(1, 0), cA + kstep, voffA); PG8_STAGE(PG8_SB(1, 1), cB + hstep + kstep, voffB);
        PG8_WAIT_V(6); PG8_BAR;
    }
    for (;;) {
        const bool has_next = S.next(ui + 1, nxt);
        const char* nA = has_next ? (const char*)g.A + (size_t)nxt.pm * tstep : cA; const char* nB = has_next ? (const char*)g.Bt + (size_t)nxt.pn * tstep : cB;
        if constexpr (Sched::SPLITK) { if (has_next) { nA += (size_t)nxt.kt0 * kstep; nB += (size_t)nxt.kt0 * kstep; } }
        const int ntu = Sched::SPLITK ? cur.knt : nt;
        for (int t = 0; t < ntu; t += 2) {
            const bool last = (t == ntu - 2);
            const char* a1 = cA + (size_t)(t + 1) * kstep;
            const char* a2 = last ? nA : cA + (size_t)(t + 2) * kstep; const char* b2 = last ? nB : cB + (size_t)(t + 2) * kstep;
            const char* a3 = a2 + kstep; const char* b3 = b2 + kstep;
            if (last && has_next) S.a_ready(nxt);
            if constexpr (SP2) {
            PG8_LDB(B0, 0, 0); PG8_LDB(B1, 0, 1); PG8_SCHED; PG8_LDA(At, 0, 0); PG8_STAGE(PG8_SA(1, 1), a1 + hstep, voffA);
            PG8_WAIT_V(8); PG8_WAIT_L(0); PG8_BAR; PG8_MMA(0, 0, At, B0); PG8_MMA(0, 1, At, B1); PG8_BAR; PG8_SCHED;
            PG8_LDA(At, 0, 1); PG8_STAGE(PG8_SB(0, 0), b2, voffB); PG8_STAGE(PG8_SB(0, 1), b2 + hstep, voffB); PG8_STAGE(PG8_SA(0, 0), a2, voffA);
            PG8_WAIT_V(8); PG8_WAIT_L(0); PG8_BAR; PG8_MMA(1, 0, At, B0); PG8_MMA(1, 1, At, B1); PG8_BAR; PG8_SCHED;
            PG8_LDB(B0, 1, 0); PG8_LDB(B1, 1, 1); PG8_SCHED; PG8_LDA(At, 1, 0); PG8_STAGE(PG8_SA(0, 1), a2 + hstep, voffA);
            PG8_WAIT_V(8); PG8_WAIT_L(0); PG8_BAR; PG8_MMA(0, 0, At, B0); PG8_MMA(0, 1, At, B1); PG8_BAR; PG8_SCHED;
            PG8_LDA(At, 1, 1); PG8_STAGE(PG8_SB(1, 0), b3, voffB); PG8_STAGE(PG8_SB(1, 1), b3 + hstep, voffB); PG8_STAGE(PG8_SA(1, 0), a3, voffA);
            PG8_WAIT_V(8); PG8_WAIT_L(0); PG8_BAR; PG8_MMA(1, 0, At, B0); PG8_MMA(1, 1, At, B1); PG8_BAR; PG8_SCHED;
            } else {
            PG8_LDB(B0, 0, 0); PG8_SCHED; PG8_LDA(At, 0, 0); PG8_STAGE(PG8_SA(1, 1), a1 + hstep, voffA);
            PG8_WAIT_L(8); PG8_BAR; PG8_WAIT_L(0); PG8_MMA(0, 0, At, B0); PG8_BAR; PG8_SCHED;
            PG8_LDB(B1, 0, 1); PG8_STAGE(PG8_SB(0, 0), b2, voffB);
            PG8_BAR; PG8_WAIT_L(0); PG8_MMA(0, 1, At, B1); PG8_BAR;
            PG8_LDA(At, 0, 1); PG8_STAGE(PG8_SA(0, 0), a2, voffA);
            PG8_BAR; PG8_WAIT_L(0); PG8_MMA(1, 0, At, B0); PG8_BAR; PG8_SCHED;
            PG8_STAGE(PG8_SB(0, 1), b2 + hstep, voffB);
            PG8_WAIT_V(6); PG8_BAR; PG8_MMA(1, 1, At, B1); PG8_BAR;
            PG8_LDB(B0, 1, 0); PG8_SCHED; PG8_LDA(At, 1, 0); PG8_STAGE(PG8_SA(0, 1), a2 + hstep, voffA);
            PG8_WAIT_L(8); PG8_BAR; PG8_WAIT_L(0); PG8_MMA(0, 0, At, B0); PG8_BAR; PG8_SCHED;
            PG8_LDB(B1, 1, 1); PG8_STAGE(PG8_SB(1, 0), b3, voffB);
            PG8_BAR; PG8_WAIT_L(0); PG8_MMA(0, 1, At, B1); PG8_BAR;
            PG8_LDA(At, 1, 1); PG8_STAGE(PG8_SA(1, 0), a3, voffA);
            PG8_BAR; PG8_WAIT_L(0); PG8_MMA(1, 0, At, B0); PG8_BAR; PG8_SCHED;
            PG8_STAGE(PG8_SB(1, 1), b3 + hstep, voffB);
            PG8_WAIT_V(6); PG8_BAR; PG8_MMA(1, 1, At, B1); PG8_BAR;
            }
        }
        if constexpr (ALIGN_EPI) { if (wr == 0) PG8_BAR; }
        if constexpr (F8) {
#pragma unroll
            for (int a = 0; a < 2; ++a)
#pragma unroll
                for (int b = 0; b < 2; ++b) {
                    if (a == 0 && b == 0) asm volatile("s_nop 15\n\ts_nop 15" : "+v"(acc[0][0][0][0]), "+v"(acc[0][0][0][1]), "+v"(acc[0][0][1][0]), "+v"(acc[0][0][1][1]), "+v"(acc[0][0][2][0]), "+v"(acc[0][0][2][1]), "+v"(acc[0][0][3][0]), "+v"(acc[0][0][3][1]));
                    else asm volatile("" : "+v"(acc[a][b][0][0]), "+v"(acc[a][b][0][1]), "+v"(acc[a][b][1][0]), "+v"(acc[a][b][1][1]), "+v"(acc[a][b][2][0]), "+v"(acc[a][b][2][1]), "+v"(acc[a][b][3][0]), "+v"(acc[a][b][3][1])); }
        }
        bool run_epi = true;
        if constexpr (Sched::SPLITK) {
            if (cur.part >= 0) {
                const __amdgpu_buffer_rsrc_t prs = __builtin_amdgcn_make_buffer_rsrc((void*)S.pbuf, 0, 64 << 20, 0x00020000);
                const int pofs = __builtin_amdgcn_readfirstlane((cur.tix * cur.sp + cur.part) * 262144);
#pragma unroll
                for (int a = 0; a < 2; ++a)
#pragma unroll
                    for (int b = 0; b < 2; ++b)
#pragma unroll
                        for (int m = 0; m < 4; ++m)
#pragma unroll
                            for (int n = 0; n < 2; ++n)
                                __builtin_amdgcn_raw_buffer_store_b128(__builtin_bit_cast(u32x4, acc[a][b][m][n]), prs, ((((a * 2 + b) * 4 + m) * 2 + n) * 512 + tid) * 16, pofs, 16);
                asm volatile("s_waitcnt vmcnt(0)" ::: "memory");
                PG8_BAR;
                if (tid == 0) { const unsigned old = __hip_atomic_fetch_add(S.pcnt + cur.tix, 1u, __ATOMIC_RELAXED, __HIP_MEMORY_SCOPE_AGENT);
                    if (old == (unsigned)(cur.sp - 1)) __builtin_amdgcn_fence(__ATOMIC_ACQUIRE, "agent");
                    *(volatile PG8_LAS unsigned*)S.lflag = old; }
                asm volatile("s_waitcnt vmcnt(0) lgkmcnt(0)" ::: "memory");
                PG8_BAR;
                const unsigned arrived = *(volatile PG8_LAS unsigned*)S.lflag;
                run_epi = (arrived == (unsigned)(cur.sp - 1));
                if (run_epi) {
                    const int tofs = __builtin_amdgcn_readfirstlane(cur.tix * cur.sp * 262144);
#pragma unroll
                    for (int a = 0; a < 2; ++a)
#pragma unroll
                        for (int b = 0; b < 2; ++b)
#pragma unroll
                            for (int m = 0; m < 4; ++m)
#pragma unroll
                                for (int n = 0; n < 2; ++n)
                                    acc[a][b][m][n] = __builtin_bit_cast(f32x4, __builtin_amdgcn_raw_buffer_load_b128(prs, ((((a * 2 + b) * 4 + m) * 2 + n) * 512 + tid) * 16, tofs, 16));
                    for (int pp = 1; pp < cur.sp; ++pp) { const int qofs = __builtin_amdgcn_readfirstlane(tofs + pp * 262144);
#pragma unroll
                        for (int a = 0; a < 2; ++a)
#pragma unroll
                            for (int b = 0; b < 2; ++b) {
                                f32x4 tp[4][2];
#pragma unroll
                                for (int m = 0; m < 4; ++m)
#pragma unroll
                                    for (int n = 0; n < 2; ++n) tp[m][n] = __builtin_bit_cast(f32x4, __builtin_amdgcn_raw_buffer_load_b128(prs, ((((a * 2 + b) * 4 + m) * 2 + n) * 512 + tid) * 16, qofs, 16));
#pragma unroll
                                for (int m = 0; m < 4; ++m)
#pragma unroll
                                    for (int n = 0; n < 2; ++n) acc[a][b][m][n] += tp[m][n];
                                __builtin_amdgcn_sched_barrier(0); } }
                }
            }
        }
        if constexpr (!Epi::AFTER_DRAIN) { if (run_epi) E(acc, cur, wr, wc, fr, fq); S.done(cur); }
        if (!has_next) break;
#pragma unroll
        for (int a = 0; a < 2; ++a)
#pragma unroll
            for (int b = 0; b < 2; ++b)
#pragma unroll
                for (int m = 0; m < 4; ++m)
#pragma unroll
                    for (int n = 0; n < 2; ++n) acc[a][b][m][n] = (f32x4){0.f, 0.f, 0.f, 0.f};
        cur = nxt; cA = nA; cB = nB; ++ui;
        if constexpr (ALIGN_EPI) { if (wr == 1) PG8_BAR; }
    }
    PG8_WAIT_V(0);
    if constexpr (!ALIGN_EPI) { if (wr == 0) PG8_BAR; }
    PG8_BAR;
#undef PG8_SA
#undef PG8_SB
#undef PG8_STAGE
#undef PG8_LDA
#undef PG8_LDB
#undef PG8_MMA
#undef PG8_WAIT_V
#undef PG8_WAIT_L
#undef PG8_BAR
#undef PG8_SCHED
}
}

constexpr int NWAVES = 8;
constexpr int NB = 8, SEQ = 2048, D = 2048, M = NB * SEQ, DIN = 6144, DG = 1024, DH = 1024, FF = 5632, GU = 2 * FF, NE = 8;
constexpr int MOE_ROWS = 2 * M + NE * 256;
constexpr float EPS = 1e-6f, F_MIN = 1e-6f;

constexpr size_t MiB = 1u << 20;
constexpr size_t WS_CTL = 0, CTL_ZERO_BYTES = 1 * MiB;
constexpr size_t WS_SMALL = 1 * MiB;
constexpr size_t SM_WC = 1 * MiB;
constexpr size_t SM_TOKE = 0, SM_TOKW = 131072, SM_TOKP = 262144, SM_WHIST = 393216, SM_TS = 524288;
constexpr size_t WS_WIN = 4 * MiB;
constexpr size_t WS_WO = WS_WIN + (size_t)2 * DIN * D * 2;
constexpr size_t WS_WGU = WS_WO + (size_t)2 * D * D * 2;
constexpr size_t WS_WD = WS_WGU + (size_t)GU * D * 2;
constexpr size_t WS_EGU = WS_WD + (size_t)D * FF * 2;
constexpr size_t WS_ED = WS_EGU + (size_t)NE * GU * D * 2;
constexpr size_t WS_XN = WS_ED + (size_t)NE * D * FF * 2;
constexpr size_t WS_R = WS_XN + (size_t)M * D * 2;
constexpr size_t WS_Z = WS_R;
constexpr size_t WS_Y = WS_Z + (size_t)M * DIN * 2;
constexpr size_t WS_O = WS_Y + (size_t)M * D * 2;
constexpr size_t WS_H = WS_R;
constexpr size_t WS_XS = WS_R + (size_t)MOE_ROWS * FF * 2;
constexpr size_t WS_XS8 = WS_XS + (size_t)MOE_ROWS * D * 2;
constexpr size_t WS_END = WS_XS8 + (size_t)MOE_ROWS * D;
static_assert(WS_O + (size_t)M * DH * 4 <= WS_XS, "O inside region R");
static_assert(WS_WIN % 256 == 0 && WS_XN % 256 == 0 && WS_R % 256 == 0 && WS_XS % 256 == 0, "alignment");

constexpr int CW_BAR = 4096;

constexpr int RING_OFF = 0, RING_BYTES = 131072;
constexpr int LDSCTL_OFF = 135168, MISC_OFF = LDSCTL_OFF + 320;
constexpr int LDS_BYTES = 147456;

#define GAS __attribute__((address_space(1)))
#define LAS __attribute__((address_space(3)))
typedef unsigned short bf16;
typedef unsigned v4u __attribute__((ext_vector_type(4)));
typedef unsigned v2u __attribute__((ext_vector_type(2)));
typedef float f32x4 __attribute__((ext_vector_type(4)));
typedef float f32x2 __attribute__((ext_vector_type(2)));
typedef int i32x4 __attribute__((ext_vector_type(4)));
typedef int i32x2 __attribute__((ext_vector_type(2)));
#define LDS_WAIT() asm volatile("s_waitcnt lgkmcnt(0)" ::: "memory")
#define VM_WAIT() asm volatile("s_waitcnt vmcnt(0)" ::: "memory")
__device__ __forceinline__ unsigned f2bf(float f) { return (unsigned)__builtin_bit_cast(unsigned short, (__bf16)f); }
__device__ __forceinline__ unsigned pk2(float lo, float hi) { return pg8::cvt_pk_bf16(lo, hi); }
__device__ __forceinline__ float bflo(unsigned p) { return __builtin_bit_cast(float, p << 16); }
__device__ __forceinline__ float bfhi(unsigned p) { return __builtin_bit_cast(float, p & 0xffff0000u); }
__device__ __forceinline__ float sigmoid_f(float x) { return 1.0f / (1.0f + __expf(-x)); }
__device__ __forceinline__ float silu_x(float x) { return x / (1.0f + __expf(-x)); }
__device__ __forceinline__ float gelu_tanh(float x) { const float u = 0.7978845608028654f * (x + 0.044715f * x * x * x); return x / (1.0f + __expf(-2.0f * u)); }
template <int CTRL, int ROW_MASK> __device__ __forceinline__ float dpp_f(float v) { return __builtin_bit_cast(float, __builtin_amdgcn_update_dpp(0, __builtin_bit_cast(int, v), CTRL, ROW_MASK, 0xF, false)); }
__device__ __forceinline__ float row16_sum(float v) {
    v += dpp_f<0xB1, 0xF>(v);
    v += dpp_f<0x4E, 0xF>(v);
    v += dpp_f<0x141, 0xF>(v);
    v += dpp_f<0x140, 0xF>(v);
    return v;
}
__device__ __forceinline__ float wave_sum(float v) {
    v = row16_sum(v);
    v += dpp_f<0x142, 0xA>(v);
    v += dpp_f<0x143, 0xC>(v);
    return __builtin_bit_cast(float, __builtin_amdgcn_readlane(__builtin_bit_cast(int, v), 63));
}
__device__ __forceinline__ int wave_sum_i(int v) {
#pragma unroll
    for (int o = 1; o < 64; o <<= 1) v += __shfl_xor(v, o);
    return v;
}

#define XB_TMO      128
#define XB_XCNT(j)  (256  + 64 * (j))
#define XB_XSUB(j)  (1280 + 64 * (j))
#define XB_XGEN(j)  (2304 + 64 * (j))
#define XB_TOP      3328
#define XB_TOPGEN   3392
#define XCD_BAR_WORDS 3456
#define XB_SPIN_CAP (1u << 22)
__device__ __forceinline__ unsigned xb_ld(unsigned* p)              { return __hip_atomic_load(p, __ATOMIC_RELAXED, __HIP_MEMORY_SCOPE_AGENT); }
__device__ __forceinline__ unsigned xb_add(unsigned* p, unsigned v) { return __hip_atomic_fetch_add(p, v, __ATOMIC_RELAXED, __HIP_MEMORY_SCOPE_AGENT); }
__device__ __forceinline__ unsigned xb_xcc_id() { return (unsigned)__builtin_amdgcn_s_getreg((3 << 11) | 20) & 0xFu; }
#define XB_SPIN(cond, bar) do { unsigned _sp = 0; while (cond) { __builtin_amdgcn_s_sleep(1); \
    if ((++_sp & 255u) == 0u) { if (xb_ld(&(bar)[XB_TMO])) break; if (_sp > XB_SPIN_CAP) { atomicAdd(&(bar)[XB_TMO], 1u); break; } } } } while (0)
struct XcdBarrier { unsigned* bar; unsigned x; volatile LAS unsigned* st; };
__device__ __forceinline__ XcdBarrier xcd_barrier_post(unsigned* bar, volatile LAS unsigned* st) {
    XcdBarrier b; b.bar = bar; b.x = xb_xcc_id(); b.st = st;
    if (threadIdx.x == 0) (void)xb_add(&bar[XB_XCNT(b.x)], 1u);
    return b;
}
__device__ __forceinline__ void xcd_barrier_complete(unsigned* bar, unsigned x, unsigned& nloc, unsigned& nx) {
    const unsigned G = gridDim.x * gridDim.y * gridDim.z;
    unsigned sum, cnt, mine, sp = 0u;
    for (;;) {
        sum = 0u; cnt = 0u; mine = 0u;
#pragma unroll
        for (unsigned j = 0; j < 16; ++j) { const unsigned c = xb_ld(&bar[XB_XCNT(j)]); sum += c; cnt += (c > 0u) ? 1u : 0u; mine = (j == x) ? c : mine; }
        if (sum == G) break;
        __builtin_amdgcn_s_sleep(1);
        if ((++sp & 255u) == 0u) { if (xb_ld(&bar[XB_TMO])) break; if (sp > XB_SPIN_CAP) { atomicAdd(&bar[XB_TMO], 1u); break; } }
    }
    nloc = mine > 0u ? mine : 1u; nx = cnt > 0u ? cnt : 1u;
}
__device__ __forceinline__ void xcd_barrier(const XcdBarrier& b) {
    asm volatile("s_waitcnt vmcnt(0)" ::: "memory");
    __syncthreads();
    if (threadIdx.x == 0) {
        unsigned* bar = b.bar;
        __builtin_amdgcn_s_waitcnt(0);
        unsigned nloc = b.st[0], nx = b.st[1];
        if (nloc == 0u) { xcd_barrier_complete(bar, b.x, nloc, nx); b.st[0] = nloc; b.st[1] = nx; }
        const unsigned old = xb_add(&bar[XB_XSUB(b.x)], 1u);
        const unsigned gen = old / nloc;
        if (old + 1u == (gen + 1u) * nloc) {
            __builtin_amdgcn_fence(__ATOMIC_RELEASE, "agent");
            asm volatile("s_waitcnt vmcnt(0)" ::: "memory");
            const unsigned og = xb_add(&bar[XB_TOP], 1u);
            const unsigned tg = og / nx;
            if (og + 1u == (tg + 1u) * nx) xb_add(&bar[XB_TOPGEN], 1u);
            else XB_SPIN(xb_ld(&bar[XB_TOPGEN]) == tg, bar);
            __builtin_amdgcn_fence(__ATOMIC_ACQUIRE, "agent");
            xb_add(&bar[XB_XGEN(b.x)], 1u);
            asm volatile("s_waitcnt vmcnt(0)" ::: "memory");
        } else {
            XB_SPIN(xb_ld(&bar[XB_XGEN(b.x)]) == gen, bar);
            __builtin_amdgcn_fence(__ATOMIC_ACQUIRE, "agent");
            asm volatile("s_waitcnt vmcnt(0)" ::: "memory");
        }
    }
    __syncthreads();
}

struct Frame {
    LAS unsigned char* lds;
    int tid, lane, wave, G, gw, NGW;
    unsigned char* ws;
};

__device__ __forceinline__ void transpose_item(const float* W, int K, int N, bf16* WT, int mode, LAS float* scr, int item, int lane) {
    const int nblk = N / 32, kb = item / nblk, nb = item % nblk, k0 = 64 * kb, n0 = 32 * nb;
    const int kr = lane >> 3, nc = lane & 7;
    f32x4 v[8];
#pragma unroll
    for (int i = 0; i < 8; ++i) v[i] = *(const f32x4*)(W + (size_t)(k0 + 8 * i + kr) * N + n0 + 4 * nc);
#pragma unroll
    for (int i = 0; i < 8; ++i) { LAS float* d = scr + (8 * i + kr) * 33 + 4 * nc; d[0] = v[i].x; d[1] = v[i].y; d[2] = v[i].z; d[3] = v[i].w; }
    LDS_WAIT(); asm volatile("" ::: "memory");
    const int c = lane & 7;
    const int rbase = (mode == 0) ? n0 : (256 * (n0 >> 7) + (n0 & 127) + (mode == 2 ? 128 : 0));
#pragma unroll
    for (int j = 0; j < 4; ++j) { const int n = (lane >> 3) + 8 * j; const LAS float* s = scr + (8 * c) * 33 + n;
        v4u o; o.x = pk2(s[0 * 33], s[1 * 33]); o.y = pk2(s[2 * 33], s[3 * 33]); o.z = pk2(s[4 * 33], s[5 * 33]); o.w = pk2(s[6 * 33], s[7 * 33]);
        *(v4u*)(WT + (size_t)(rbase + n) * K + k0 + 8 * c) = o; }
    LDS_WAIT(); asm volatile("" ::: "memory");
}
__device__ __forceinline__ void conv_matrix(Frame& F, const float* W, int K, int N, bf16* WT, int mode) {
    LAS float* scr = (LAS float*)(F.lds + RING_OFF + F.wave * 16384);
    const int nitems = (K / 64) * (N / 32);
    for (int it = F.gw; it < nitems; it += F.NGW) transpose_item(W, K, N, WT, mode, scr, it, F.lane);
}
__device__ __forceinline__ void transpose_item8(const float* W, int K, int N, unsigned char* WT, int mode, float scale, LAS float* scr, int item, int lane) {
    const int nblk = N / 32, kb = item / nblk, nb = item % nblk, k0 = 64 * kb, n0 = 32 * nb;
    const int kr = lane >> 3, nc = lane & 7;
    f32x4 v[8];
#pragma unroll
    for (int i = 0; i < 8; ++i) v[i] = *(const f32x4*)(W + (size_t)(k0 + 8 * i + kr) * N + n0 + 4 * nc);
#pragma unroll
    for (int i = 0; i < 8; ++i) { LAS float* d = scr + (8 * i + kr) * 33 + 4 * nc; d[0] = v[i].x; d[1] = v[i].y; d[2] = v[i].z; d[3] = v[i].w; }
    LDS_WAIT(); asm volatile("" ::: "memory");
    const int c = lane & 7;
    const int rbase = (mode == 0) ? n0 : (256 * (n0 >> 7) + (n0 & 127) + (mode == 2 ? 128 : 0));
#pragma unroll
    for (int j = 0; j < 4; ++j) { const int n = (lane >> 3) + 8 * j; const LAS float* s = scr + (8 * c) * 33 + n;
        v2u o; o.x = pg8::pk4_fp8(s[0 * 33] * scale, s[1 * 33] * scale, s[2 * 33] * scale, s[3 * 33] * scale); o.y = pg8::pk4_fp8(s[4 * 33] * scale, s[5 * 33] * scale, s[6 * 33] * scale, s[7 * 33] * scale);
        *(v2u*)(WT + (size_t)(rbase + n) * K + k0 + 8 * c) = o; }
    LDS_WAIT(); asm volatile("" ::: "memory");
}
constexpr int CONV_CH = 8, CW_CONV = 8192;
static_assert(((D / 64) * (DIN / 32)) % CONV_CH == 0 && ((D / 64) * (D / 32)) % CONV_CH == 0 && ((D / 64) * (FF / 32)) % CONV_CH == 0 && ((FF / 64) * (D / 32)) % CONV_CH == 0, "conversion chunks must be whole");
constexpr int CW_SK = 16384, CW_GMLP = 24576, NGF = 64;
__device__ __forceinline__ void conv_load(const float* W, int N, int item, int lane, f32x4 (&v)[8]) {
    const int nblk = N / 32, kb = item / nblk, nb = item % nblk, k0 = 64 * kb, n0 = 32 * nb, kr = lane >> 3, nc = lane & 7;
#pragma unroll
    for (int i = 0; i < 8; ++i) v[i] = __builtin_nontemporal_load((const f32x4*)(W + (size_t)(k0 + 8 * i + kr) * N + n0 + 4 * nc));
}
__device__ __forceinline__ void conv_proc(int K, int N, void* WT, int mode, float scale8, LAS float* scr, int item, int lane, const f32x4 (&v)[8]) {
    const int nblk = N / 32, kb = item / nblk, nb = item % nblk, k0 = 64 * kb, n0 = 32 * nb, kr = lane >> 3, nc = lane & 7;
#pragma unroll
    for (int i = 0; i < 8; ++i) { LAS float* d = scr + (8 * i + kr) * 33 + 4 * nc; d[0] = v[i].x; d[1] = v[i].y; d[2] = v[i].z; d[3] = v[i].w; }
    LDS_WAIT(); asm volatile("" ::: "memory");
    const int c = lane & 7;
    const int rbase = (mode == 0) ? n0 : (256 * (n0 >> 7) + (n0 & 127) + (mode == 2 ? 128 : 0));
#pragma unroll
    for (int j = 0; j < 4; ++j) { const int n = (lane >> 3) + 8 * j; const LAS float* s = scr + (8 * c) * 33 + n;
        if (scale8 != 0.f) { v2u o; o.x = pg8::pk4_fp8(s[0 * 33] * scale8, s[1 * 33] * scale8, s[2 * 33] * scale8, s[3 * 33] * scale8); o.y = pg8::pk4_fp8(s[4 * 33] * scale8, s[5 * 33] * scale8, s[6 * 33] * scale8, s[7 * 33] * scale8);
            *(v2u*)((unsigned char*)WT + (size_t)(rbase + n) * K + k0 + 8 * c) = o; }
        else { v4u o; o.x = pk2(s[0 * 33], s[1 * 33]); o.y = pk2(s[2 * 33], s[3 * 33]); o.z = pk2(s[4 * 33], s[5 * 33]); o.w = pk2(s[6 * 33], s[7 * 33]);
            *(v4u*)((bf16*)WT + (size_t)(rbase + n) * K + k0 + 8 * c) = o; } }
    LDS_WAIT(); asm volatile("" ::: "memory");
}
__device__ __forceinline__ void conv_queue(Frame& F, int job, const float* W, int K, int N, void* WT, int mode, float scale8 = 0.f) {
    LAS float* scr = (LAS float*)(F.lds + RING_OFF + F.wave * 16384);
    unsigned* ctr = (unsigned*)(F.ws + WS_CTL) + CW_CONV + 64 * job;
    const int nitems = (K / 64) * (N / 32), nch = nitems / CONV_CH;
    for (;;) {
        unsigned c = 0; if (F.lane == 0) c = __hip_atomic_fetch_add(ctr, 1u, __ATOMIC_RELAXED, __HIP_MEMORY_SCOPE_AGENT);
        c = __builtin_amdgcn_readfirstlane(c);
        if ((int)c >= nch) break;
        const int i0 = (int)c * CONV_CH, ilast = i0 + CONV_CH - 1;
        f32x4 va[8], vb[8];
        conv_load(W, N, i0, F.lane, va);
#pragma unroll 1
        for (int it = i0; it < i0 + CONV_CH; it += 2) {
            conv_load(W, N, it + 1, F.lane, vb);
            conv_proc(K, N, WT, mode, scale8, scr, it, F.lane, va);
            conv_load(W, N, it + 2 < ilast ? it + 2 : ilast, F.lane, va);
            conv_proc(K, N, WT, mode, scale8, scr, it + 1, F.lane, vb);
        }
    }
}

__device__ __forceinline__ void norm_row(const float* xrow, const float* gain, int lane, f32x4 (&v)[8]) {
    const f32x4* xr = (const f32x4*)xrow + lane; float s = 0.f;
#pragma unroll
    for (int j = 0; j < 8; ++j) { v[j] = xr[64 * j]; s += (v[j].x * v[j].x + v[j].y * v[j].y) + (v[j].z * v[j].z + v[j].w * v[j].w); }
    const float rstd = 1.0f / sqrtf(wave_sum(s) * (1.0f / D) + EPS);
    const f32x4* gr = (const f32x4*)gain + lane;
#pragma unroll
    for (int j = 0; j < 8; ++j) v[j] = v[j] * rstd * gr[64 * j];
}
__device__ __forceinline__ void store_row_bf16(bf16* orow, int lane, const f32x4 (&v)[8]) {
    v2u* o8 = (v2u*)orow + lane;
#pragma unroll
    for (int j = 0; j < 8; ++j) { v2u w; w.x = pk2(v[j].x, v[j].y); w.y = pk2(v[j].z, v[j].w); o8[64 * j] = w; }
}


__device__ __forceinline__ void norm_row_b(const bf16* xrow, const float* gain, int lane, f32x4 (&v)[8]) {
    const v4u* xr = (const v4u*)xrow + lane; float s = 0.f;
#pragma unroll
    for (int j = 0; j < 4; ++j) { const v4u t = xr[64 * j]; v[2 * j] = (f32x4){bflo(t.x), bfhi(t.x), bflo(t.y), bfhi(t.y)}; v[2 * j + 1] = (f32x4){bflo(t.z), bfhi(t.z), bflo(t.w), bfhi(t.w)}; }
#pragma unroll
    for (int j = 0; j < 8; ++j) s += (v[j].x * v[j].x + v[j].y * v[j].y) + (v[j].z * v[j].z + v[j].w * v[j].w);
    const float rstd = 1.0f / sqrtf(wave_sum(s) * (1.0f / D) + EPS);
    const f32x4* gr = (const f32x4*)gain + 2 * lane;
#pragma unroll
    for (int j = 0; j < 4; ++j) { v[2 * j] = v[2 * j] * rstd * gr[128 * j]; v[2 * j + 1] = v[2 * j + 1] * rstd * gr[128 * j + 1]; }
}
__device__ __forceinline__ void load_raw_b(const bf16* xrow, int lane, v4u (&t)[4]) { const v4u* xr = (const v4u*)xrow + lane;
#pragma unroll
    for (int j = 0; j < 4; ++j) t[j] = xr[64 * j]; }
__device__ __forceinline__ void load_gain_b(const float* gain, int lane, f32x4 (&g)[8]) { const f32x4* gr = (const f32x4*)gain + 2 * lane;
#pragma unroll
    for (int j = 0; j < 4; ++j) { g[2 * j] = gr[128 * j]; g[2 * j + 1] = gr[128 * j + 1]; } }
__device__ __forceinline__ void norm_raw_b(const v4u (&t)[4], const f32x4 (&g)[8], f32x4 (&v)[8]) {
    float s = 0.f;
#pragma unroll
    for (int j = 0; j < 4; ++j) { v[2 * j] = (f32x4){bflo(t[j].x), bfhi(t[j].x), bflo(t[j].y), bfhi(t[j].y)}; v[2 * j + 1] = (f32x4){bflo(t[j].z), bfhi(t[j].z), bflo(t[j].w), bfhi(t[j].w)}; }
#pragma unroll
    for (int j = 0; j < 8; ++j) s += (v[j].x * v[j].x + v[j].y * v[j].y) + (v[j].z * v[j].z + v[j].w * v[j].w);
    const float rstd = 1.0f / sqrtf(wave_sum(s) * (1.0f / D) + EPS);
#pragma unroll
    for (int j = 0; j < 8; ++j) v[j] = v[j] * rstd * g[j];
}
__device__ __forceinline__ void load_raw_f(const float* xrow, int lane, f32x4 (&t)[8]) { const f32x4* xr = (const f32x4*)xrow + lane;
#pragma unroll
    for (int j = 0; j < 8; ++j) t[j] = xr[64 * j]; }
__device__ __forceinline__ void norm_raw_f(const f32x4 (&t)[8], const f32x4 (&g)[8], f32x4 (&v)[8]) {
    float s = 0.f;
#pragma unroll
    for (int j = 0; j < 8; ++j) s += (t[j].x * t[j].x + t[j].y * t[j].y) + (t[j].z * t[j].z + t[j].w * t[j].w);
    const float rstd = 1.0f / sqrtf(wave_sum(s) * (1.0f / D) + EPS);
#pragma unroll
    for (int j = 0; j < 8; ++j) v[j] = t[j] * rstd * g[j];
}
__device__ __forceinline__ void store_row_bf16_b(bf16* orow, int lane, const f32x4 (&v)[8]) {
    v4u* o = (v4u*)orow + lane;
#pragma unroll
    for (int j = 0; j < 4; ++j) { v4u w; w.x = pk2(v[2 * j].x, v[2 * j].y); w.y = pk2(v[2 * j].z, v[2 * j].w); w.z = pk2(v[2 * j + 1].x, v[2 * j + 1].y); w.w = pk2(v[2 * j + 1].z, v[2 * j + 1].w); o[64 * j] = w; }
}

typedef short bf16x8v __attribute__((ext_vector_type(8)));
typedef short s16x4 __attribute__((ext_vector_type(4)));
constexpr int RS = 272;
__device__ __forceinline__ unsigned nat_base(unsigned lane) { return (lane & 15u) * RS + (lane >> 4) * 16u; }
__device__ __forceinline__ constexpr unsigned nat_off(unsigned rb, unsigned s) { return rb * 16u * RS + s * 64u; }
__device__ __forceinline__ unsigned tr_base(unsigned lane) { return (8u * (lane >> 4) + ((lane & 15u) >> 2)) * RS + (lane & 3u) * 8u; }
__device__ __forceinline__ constexpr unsigned tr_off(unsigned c, unsigned ks, unsigned t) { return (32u * ks + 4u * t) * RS + 32u * c; }
__device__ __forceinline__ bf16x8v tr_frag(LAS unsigned char* p, unsigned c, unsigned ks) {
    const s16x4 a = __builtin_amdgcn_ds_read_tr16_b64_v4i16((LAS s16x4*)(p + tr_off(c, ks, 0)));
    const s16x4 b = __builtin_amdgcn_ds_read_tr16_b64_v4i16((LAS s16x4*)(p + tr_off(c, ks, 1)));
    return __builtin_shufflevector(a, b, 0, 1, 2, 3, 4, 5, 6, 7);
}
__device__ __forceinline__ f32x4 mfma16(bf16x8v a, bf16x8v b, f32x4 c) { return __builtin_amdgcn_mfma_f32_16x16x32_bf16(a, b, c, 0, 0, 0); }
__device__ __forceinline__ f32x4 zero4() { f32x4 z = (f32x4){0.f, 0.f, 0.f, 0.f}; asm volatile("" : "+v"(z)); return z; }
__device__ __forceinline__ bf16x8v pack8(f32x4 a, f32x4 b) { v4u w; w.x = pg8::cvt_pk_bf16(a[0], a[1]); w.y = pg8::cvt_pk_bf16(a[2], a[3]); w.z = pg8::cvt_pk_bf16(b[0], b[1]); w.w = pg8::cvt_pk_bf16(b[2], b[3]); return __builtin_bit_cast(bf16x8v, w); }

__device__ __forceinline__ void gmlp_unit(Frame& F, const bf16* Z, bf16* Y, const bf16* Wc, const float* ln_w, const float* ln_b, const float* b_s, const float* out_w, int u) {
    const int h = u & 7, n = (u >> 3) & 15, b = u >> 7; const size_t row0 = (size_t)b * SEQ + n * 128;
    LAS unsigned char* VT = F.lds; LAS unsigned char* WT = F.lds + 128 * RS;
    const int lane = F.lane, w = F.wave, g = lane >> 4, lr = lane & 15;
    {
        const f32x2 lw = ((const f32x2*)(ln_w + h * 128))[lane], lb = ((const f32x2*)(ln_b + h * 128))[lane];
        unsigned pk[16];
#pragma unroll
        for (int i = 0; i < 16; ++i) pk[i] = ((const unsigned*)(Z + (row0 + 16 * w + i) * DIN + DG + h * 128))[lane];
#pragma unroll
        for (int i = 0; i < 16; ++i) { const pg8::f32x2c gv2 = pg8::gelu_2((pg8::f32x2c){bflo(pk[i]), bfhi(pk[i])}); const float a = gv2.x, c = gv2.y;
            const float mu = wave_sum(a + c) * (1.0f / 128.0f); const float da = a - mu, dc = c - mu;
            const float var = wave_sum(da * da + dc * dc) * (1.0f / 128.0f); const float rs = 1.0f / sqrtf(var + EPS);
            *(LAS unsigned*)(VT + (16 * w + i) * RS + lane * 4) = pk2(da * rs * lw.x + lb.x, dc * rs * lw.y + lb.y); }
        v4u wt4[4];
#pragma unroll
        for (int i = 0; i < 4; ++i) { const int nn = F.tid + 512 * i, row = nn >> 4, ch = nn & 15; wt4[i] = *(const v4u*)(Wc + (size_t)h * 16384 + row * 128 + ch * 8); }
#pragma unroll
        for (int i = 0; i < 4; ++i) { const int nn = F.tid + 512 * i, row = nn >> 4, ch = nn & 15; *(LAS v4u*)(WT + row * RS + ch * 16) = wt4[i]; }
    }
    __syncthreads();
    f32x4 acc[8];
#pragma unroll
    for (int ct = 0; ct < 8; ++ct) acc[ct] = zero4();
    LAS unsigned char* vtr = VT + tr_base(lane); LAS unsigned char* wnb = WT + nat_base(lane) + w * 16 * RS;
#pragma unroll
    for (int ks = 0; ks < 4; ++ks) {
        const bf16x8v Bf = *(const LAS bf16x8v*)(wnb + nat_off(0, ks));
#pragma unroll
        for (int ct = 0; ct < 8; ++ct) { const bf16x8v Af = tr_frag(vtr, ct, ks); acc[ct] = mfma16(Af, Bf, acc[ct]); }
    }
    const int t = 16 * w + lr; const size_t row = row0 + t; const float bs = b_s[h * 128 + t];
    float ss = 0.f;
#pragma unroll
    for (int ct = 0; ct < 8; ++ct) { const v2u up = *(const v2u*)(Z + row * DIN + h * 128 + 16 * ct + 4 * g);
        const pg8::f32x2c ua = pg8::gelu_2((pg8::f32x2c){bflo(up.x), bfhi(up.x)}), ub = pg8::gelu_2((pg8::f32x2c){bflo(up.y), bfhi(up.y)});
        f32x4 y; y[0] = ua.x * (acc[ct][0] + bs); y[1] = ua.y * (acc[ct][1] + bs); y[2] = ub.x * (acc[ct][2] + bs); y[3] = ub.y * (acc[ct][3] + bs);
        acc[ct] = y; ss += (y[0] * y[0] + y[1] * y[1]) + (y[2] * y[2] + y[3] * y[3]); }
    f32x4 ow[8];
#pragma unroll
    for (int ct = 0; ct < 8; ++ct) ow[ct] = *(const f32x4*)(out_w + h * 128 + 16 * ct + 4 * g);
    ss += __shfl_xor(ss, 16); ss += __shfl_xor(ss, 32);
    const float rs = __builtin_amdgcn_rsqf(ss * (1.0f / 128.0f) + EPS);
#pragma unroll
    for (int ct = 0; ct < 8; ++ct) { v2u o;
        o.x = pk2(acc[ct][0] * rs * ow[ct][0], acc[ct][1] * rs * ow[ct][1]); o.y = pk2(acc[ct][2] * rs * ow[ct][2], acc[ct][3] * rs * ow[ct][3]);
        *(v2u*)(Y + row * D + h * 128 + 16 * ct + 4 * g) = o; }
    __syncthreads();
}

__device__ __forceinline__ void hgrn_item(Frame& F, const bf16* Z, bf16* Y, const float* out_w, int b, int h) {
    LAS unsigned char* Lb = F.lds;
    constexpr int QT = 0, KT = 64 * RS, IT = 128 * RS, PT = 192 * RS, EMo = PT + 64 * 144, ELo = EMo + 512, ELMo = ELo + 512, SEGo = ELMo + 512, NSo = SEGo + 4096, OTo = NSo + 2048, OWo = OTo + 64 * RS;
    static_assert(OWo + 512 <= RING_BYTES, "hgrn LDS map");
    const int lane = F.lane, w = F.wave, g = lane >> 4, lr = lane & 15, dp = lane, seg = w;
    f32x4 Sacc[8];
#pragma unroll
    for (int i = 0; i < 8; ++i) Sacc[i] = zero4();
    LAS unsigned char* q_nat = Lb + QT + nat_base(lane); LAS unsigned char* k_nat = Lb + KT + nat_base(lane);
    LAS unsigned char* k_tr = Lb + KT + tr_base(lane); LAS unsigned char* i_tr = Lb + IT + tr_base(lane);
    LAS unsigned char* p_rd = Lb + PT + lr * 144 + g * 16; LAS unsigned char* p_wr = Lb + PT + lr * 144 + g * 8;
    LAS unsigned char* q_in = Lb + QT + lr * RS + g * 8;
    unsigned rq[8], rg[8]; v4u ri[2];
    const __amdgpu_buffer_rsrc_t zrs = __builtin_amdgcn_make_buffer_rsrc((void*)Z, 0, (int)((size_t)M * DIN * 2), 0x00020000);
    const int vq = (2 * DG + h * 128 + 2 * dp) * 2;
    int vi[2];
#pragma unroll
    for (int i = 0; i < 2; ++i) { const int nn = F.tid + 512 * i, row = nn >> 4, ch = nn & 15; vi[i] = row * (DIN * 2) + (2 * DG + 2 * DH + h * 128 + ch * 8) * 2; }
#define HGRN_LOAD_G(cc) do { const int _s0 = __builtin_amdgcn_readfirstlane((int)(((size_t)b * SEQ + (size_t)(cc) * 64) * (DIN * 2))); \
        _Pragma("unroll") for (int r = 0; r < 8; ++r) rg[r] = (unsigned)__builtin_amdgcn_raw_buffer_load_b32(zrs, vq + DH * 2, _s0 + (8 * seg + r) * (DIN * 2), 0); } while (0)
#define HGRN_LOAD_Q(cc) do { const int _s0 = __builtin_amdgcn_readfirstlane((int)(((size_t)b * SEQ + (size_t)(cc) * 64) * (DIN * 2))); \
        _Pragma("unroll") for (int r = 0; r < 8; ++r) rq[r] = (unsigned)__builtin_amdgcn_raw_buffer_load_b32(zrs, vq, _s0 + (8 * seg + r) * (DIN * 2), 0); } while (0)
    if (F.tid < 32) *(LAS f32x4*)(Lb + OWo + F.tid * 16) = *(const f32x4*)(out_w + h * 128 + F.tid * 4);
    HGRN_LOAD_G(0); HGRN_LOAD_Q(0);
#define HGRN_OUTPUT(cc) do { const size_t _r0 = (size_t)b * SEQ + (size_t)(cc) * 64; \
        _Pragma("unroll") for (int i = 0; i < 2; ++i) { const int nn = F.tid + 512 * i, t = nn >> 4, ch = nn & 15; \
            const f32x4 n0 = *(const LAS f32x4*)(Lb + NSo + t * 32), n1 = *(const LAS f32x4*)(Lb + NSo + t * 32 + 16); \
            const float ssum = ((n0[0] + n0[1]) + (n0[2] + n0[3])) + ((n1[0] + n1[1]) + (n1[2] + n1[3])); \
            const float rs = __builtin_amdgcn_rsqf(ssum * (1.0f / 128.0f) + EPS); \
            const v4u ov = *(const LAS v4u*)(Lb + OTo + t * RS + ch * 16); \
            const v4u gv = gvc[i]; \
            const f32x4 w0 = *(const LAS f32x4*)(Lb + OWo + ch * 32), w1 = *(const LAS f32x4*)(Lb + OWo + ch * 32 + 16); \
            v4u yv; \
            yv.x = pk2(bflo(ov.x) * rs * w0[0] * bflo(gv.x), bfhi(ov.x) * rs * w0[1] * bfhi(gv.x)); yv.y = pk2(bflo(ov.y) * rs * w0[2] * bflo(gv.y), bfhi(ov.y) * rs * w0[3] * bfhi(gv.y)); \
            yv.z = pk2(bflo(ov.z) * rs * w1[0] * bflo(gv.z), bfhi(ov.z) * rs * w1[1] * bfhi(gv.z)); yv.w = pk2(bflo(ov.w) * rs * w1[2] * bflo(gv.w), bfhi(ov.w) * rs * w1[3] * bfhi(gv.w)); \
            *(v4u*)(Y + (_r0 + t) * D + DG + h * 128 + ch * 8) = yv; } } while (0)
    v4u gvc[2];
    for (int c = 0; c < SEQ / 64; ++c) {
        const size_t r0 = (size_t)b * SEQ + c * 64;
        float pre0 = 0.f, pre1 = 0.f, mid0 = 0.f, mid1 = 0.f, tot0 = 0.f, tot1 = 0.f;
        {
            const int s0c = __builtin_amdgcn_readfirstlane((int)(r0 * (DIN * 2)));
            float s0 = 0.f, s1 = 0.f;
#pragma unroll
            for (int r = 0; r < 8; ++r) { s0 += bflo(rg[r]); s1 += bfhi(rg[r]); }
            *(LAS f32x2*)(Lb + SEGo + (seg * 128 + 2 * dp) * 4) = (f32x2){s0, s1};
#pragma unroll
            for (int i = 0; i < 2; ++i) ri[i] = __builtin_bit_cast(v4u, __builtin_amdgcn_raw_buffer_load_b128(zrs, vi[i], s0c, 0));
            __syncthreads();
            if (c > 0) HGRN_OUTPUT(c - 1);
#pragma unroll
            for (int i = 0; i < 2; ++i) gvc[i] = __builtin_bit_cast(v4u, __builtin_amdgcn_raw_buffer_load_b128(zrs, vi[i] + DH * 2, s0c, 0));
#pragma unroll
            for (int sg = 0; sg < 8; ++sg) { const f32x2 t = *(const LAS f32x2*)(Lb + SEGo + (sg * 128 + 2 * dp) * 4);
                if (sg < seg) { pre0 += t.x; pre1 += t.y; } if (sg < 4) { mid0 += t.x; mid1 += t.y; } tot0 += t.x; tot1 += t.y; }
            float aa0 = pre0, aa1 = pre1;
#pragma unroll
            for (int r = 0; r < 8; ++r) {
                const float g0 = bflo(rg[r]), g1 = bfhi(rg[r]); aa0 += g0; aa1 += g1;
                const float k0 = 1.0f - __expf(g0), k1 = 1.0f - __expf(g1);
                const float q0 = bflo(rq[r]) * __expf(aa0 - mid0), q1 = bfhi(rq[r]) * __expf(aa1 - mid1);
                const float kk0 = k0 * __expf(mid0 - aa0), kk1 = k1 * __expf(mid1 - aa1);
                const unsigned o = (8 * seg + r) * RS + dp * 4;
                *(LAS unsigned*)(Lb + QT + o) = pk2(q0, q1); *(LAS unsigned*)(Lb + KT + o) = pk2(kk0, kk1);
                if (r & 1) __builtin_amdgcn_sched_barrier(0);
            }
#pragma unroll
            for (int i = 0; i < 2; ++i) { const int nn = F.tid + 512 * i, row = nn >> 4, ch = nn & 15; *(LAS v4u*)(Lb + IT + row * RS + ch * 16) = ri[i]; }
            if (seg == 0) { *(LAS f32x2*)(Lb + EMo + 8 * dp) = (f32x2){__expf(mid0), __expf(mid1)}; *(LAS f32x2*)(Lb + ELo + 8 * dp) = (f32x2){__expf(tot0), __expf(tot1)};
                *(LAS f32x2*)(Lb + ELMo + 8 * dp) = (f32x2){__expf(tot0 - mid0), __expf(tot1 - mid1)}; }
            if (c + 1 < SEQ / 64) { HGRN_LOAD_G(c + 1); HGRN_LOAD_Q(c + 1); }
        }
        __syncthreads();
#pragma unroll
        for (int it = 0; it < 2; ++it) { const int idx = w + 8 * it, tt = idx >> 2, st = idx & 3;
            f32x4 d = zero4();
#pragma unroll
            for (int ks = 0; ks < 4; ++ks) { const bf16x8v Af = *(const LAS bf16x8v*)(k_nat + st * 16 * RS + nat_off(0, ks)); const bf16x8v Bf = *(const LAS bf16x8v*)(q_nat + tt * 16 * RS + nat_off(0, ks));
                d = mfma16(Af, Bf, d); }
            const int sdiff = 16 * (st - tt) + 4 * g - lr;
#pragma unroll
            for (int r = 0; r < 4; ++r) d[r] = (sdiff + r > 0) ? 0.f : d[r];
            v2u pk; pk.x = pk2(d[0], d[1]); pk.y = pk2(d[2], d[3]);
            *(LAS v2u*)(p_wr + tt * 16 * 144 + st * 32) = pk;
        }
        __syncthreads();
        bf16x8v If[2];
#pragma unroll
        for (int ks = 0; ks < 2; ++ks) If[ks] = tr_frag(i_tr + w * 32, 0, ks);
        f32x4 acc[4];
#pragma unroll
        for (int tt = 0; tt < 4; ++tt) acc[tt] = zero4();
#pragma unroll
        for (int tt = 0; tt < 4; ++tt)
#pragma unroll
            for (int ks = 0; ks < 2; ++ks) if (32 * ks <= 16 * tt + 15) { const bf16x8v Af = *(const LAS bf16x8v*)(p_rd + tt * 16 * 144 + ks * 64);
                acc[tt] = mfma16(Af, If[ks], acc[tt]); }
        __builtin_amdgcn_sched_barrier(0);
#pragma unroll
        for (int kk = 0; kk < 4; ++kk) {
            const f32x4 em0 = *(const LAS f32x4*)(Lb + EMo + (32 * kk + 4 * g) * 4), em1 = *(const LAS f32x4*)(Lb + EMo + (32 * kk + 16 + 4 * g) * 4);
            const bf16x8v Bf = pack8(Sacc[2 * kk] * em0, Sacc[2 * kk + 1] * em1);
#pragma unroll
            for (int tt = 0; tt < 4; ++tt) {
                const v2u x0 = *(const LAS v2u*)(q_in + tt * 16 * RS + kk * 64), x1 = *(const LAS v2u*)(q_in + tt * 16 * RS + kk * 64 + 32);
                v4u xa; xa.x = x0.x; xa.y = x0.y; xa.z = x1.x; xa.w = x1.y;
                acc[tt] = mfma16(__builtin_bit_cast(bf16x8v, xa), Bf, acc[tt]); }
            __builtin_amdgcn_sched_barrier(0);
        }
#pragma unroll
        for (int dt = 0; dt < 8; ++dt) { f32x4 La = zero4();
#pragma unroll
            for (int ks = 0; ks < 2; ++ks) { const bf16x8v Af = tr_frag(k_tr, dt, ks); La = mfma16(Af, If[ks], La); }
            const f32x4 el = *(const LAS f32x4*)(Lb + ELo + (16 * dt + 4 * g) * 4), elm = *(const LAS f32x4*)(Lb + ELMo + (16 * dt + 4 * g) * 4);
            Sacc[dt] = el * Sacc[dt] + elm * La;
            __builtin_amdgcn_sched_barrier(0); }
#pragma unroll
        for (int tt = 0; tt < 4; ++tt)
#pragma unroll
            for (int r = 0; r < 4; ++r) { const float p = row16_sum(acc[tt][r] * acc[tt][r]);
                if (lr == 0) *(LAS float*)(Lb + NSo + ((16 * tt + 4 * g + r) * 8 + w) * 4) = p;
                *(LAS unsigned short*)(Lb + OTo + (16 * tt + 4 * g + r) * RS + (16 * w + lr) * 2) = (unsigned short)f2bf(acc[tt][r]); }
    }
    __syncthreads();
    HGRN_OUTPUT(SEQ / 64 - 1);
#undef HGRN_LOAD_G
#undef HGRN_LOAD_Q
#undef HGRN_OUTPUT
    __syncthreads();
}

struct Args { const float* in[20]; float* out; unsigned char* ws; int ph_lo, ph_hi; };
constexpr int NPHASE = 17;

#define IN(k) (lo <= (k) && (k) < hi)
#define SEAM(k) do { if (IN(k) && IN((k) + 1)) xcd_barrier(bar); } while (0)
template <int l> __device__ __forceinline__ void layer_phases(Frame& F, const Args& args, const XcdBarrier& bar, const int lo, const int hi) {
    unsigned char* ws = F.ws; float* out = args.out;
    bf16* XN = (bf16*)(ws + WS_XN); bf16* Z = (bf16*)(ws + WS_Z); bf16* Y = (bf16*)(ws + WS_Y); float* O = (float*)(ws + WS_O); bf16* H = (bf16*)(ws + WS_H);
        const int pb = 1 + 7 * l;
        bf16* XR = (bf16*)(ws + WS_O);
        if (IN(pb + 0)) {
            f32x4 gn[8];
            if constexpr (l == 0) {
#pragma unroll
                for (int j = 0; j < 8; ++j) gn[j] = ((const f32x4*)args.in[1] + F.lane)[64 * j];
                f32x4 rc[8]; if (F.gw < M) load_raw_f(args.in[0] + (size_t)F.gw * D, F.lane, rc);
                for (int m = F.gw; m < M; m += F.NGW) { f32x4 rn[8], v[8];
#pragma unroll
                    for (int j = 0; j < 8; ++j) rn[j] = rc[j];
                    if (m + F.NGW < M) load_raw_f(args.in[0] + (size_t)(m + F.NGW) * D, F.lane, rn);
                    norm_raw_f(rc, gn, v); store_row_bf16(XN + (size_t)m * D, F.lane, v);
#pragma unroll
                    for (int j = 0; j < 8; ++j) rc[j] = rn[j]; }
            } else {
                load_gain_b(args.in[1] + l * D, F.lane, gn);
                v4u rc[4]; if (F.gw < M) load_raw_b(XR + (size_t)F.gw * D, F.lane, rc);
                for (int m = F.gw; m < M; m += F.NGW) { v4u rn[4]; f32x4 v[8];
#pragma unroll
                    for (int j = 0; j < 4; ++j) rn[j] = rc[j];
                    if (m + F.NGW < M) load_raw_b(XR + (size_t)(m + F.NGW) * D, F.lane, rn);
                    norm_raw_b(rc, gn, v); store_row_bf16_b(XN + (size_t)m * D, F.lane, v);
#pragma unroll
                    for (int j = 0; j < 4; ++j) rc[j] = rn[j]; }
            }
        }
        SEAM(pb + 0);
        if (IN(pb + 1)) {
            pg8::Gemm g{XN, (bf16*)(ws + WS_WIN) + (size_t)l * DIN * D, 2 * D}; pg8::StaticOrder S; S.init(M, DIN, F.G, (int)blockIdx.x);
            pg8::EpiZ E{Z, DIN, args.in[8], l};
            pg8::gemm_phase<pg8::EpiZ, pg8::StaticOrder, true, true>(F.lds + RING_OFF, g, S, E);
        }
        SEAM(pb + 1);
        if (IN(pb + 2)) for (int rep = 0; rep < REP_MIX; ++rep) {
            const int nh = (F.G >= 128) ? 64 : 0;
            if (nh == 0 || (int)blockIdx.x < nh) for (int it = blockIdx.x; it < NB * 8; it += (nh ? nh : F.G)) hgrn_item(F, Z, Y, args.in[9] + l * DH, it >> 3, it & 7);
        }
        auto gmlp_pull = [&]() {
            unsigned* gctr = (unsigned*)(ws + WS_CTL) + CW_GMLP + 64 * l; volatile LAS unsigned* gw = (volatile LAS unsigned*)(F.lds + MISC_OFF + 96);
            for (;;) {
                __syncthreads();
                if (F.tid == 0) *gw = __hip_atomic_fetch_add(gctr, 1u, __ATOMIC_RELAXED, __HIP_MEMORY_SCOPE_AGENT);
                __syncthreads();
                const int u = (int)*gw;
                if (u >= NB * 16 * 8) break;
                gmlp_unit(F, Z, Y, (const bf16*)(ws + WS_SMALL + SM_WC) + (size_t)l * 8 * 16384, args.in[5] + l * DG, args.in[6] + l * DG, args.in[4] + l * DG, args.in[7] + l * DG, u);
            }
        };
        if (IN(pb + 2)) { const int nh = (F.G >= 128) ? 64 : 0; if ((int)blockIdx.x >= nh && (int)blockIdx.x < nh + NGF) gmlp_pull(); }
        if (IN(pb + 2)) {
            bf16* WIN = (bf16*)(ws + WS_WIN); bf16* WO = (bf16*)(ws + WS_WO); bf16* WGU = (bf16*)(ws + WS_WGU); bf16* WD = (bf16*)(ws + WS_WD); bf16* EGU = (bf16*)(ws + WS_EGU); bf16* ED = (bf16*)(ws + WS_ED);
            if constexpr (l == 0) {
                conv_queue(F, 0, args.in[2] + (size_t)D * DIN, D, DIN, WIN + (size_t)DIN * D, 0); conv_queue(F, 1, args.in[10] + (size_t)D * D, D, D, WO + (size_t)D * D, 0);
                conv_queue(F, 2, args.in[12], D, FF, WGU, 1, (DENSE_F8 == 1 || DENSE_F8 == 3) ? pg8::F8_SW1 : 0.f); conv_queue(F, 3, args.in[13], D, FF, WGU, 2, (DENSE_F8 == 1 || DENSE_F8 == 3) ? pg8::F8_SW1 : 0.f); conv_queue(F, 4, args.in[14], FF, D, WD, 0, (DENSE_F8 == 1 || DENSE_F8 == 2) ? pg8::F8_SW2 : 0.f);
            }
            for (int e = (l == 0 ? 0 : 3); e < (l == 0 ? 3 : NE); ++e) {
                unsigned char* EGU8 = (unsigned char*)(ws + WS_EGU); unsigned char* ED8 = (unsigned char*)(ws + WS_ED);
                conv_queue(F, 8 + 3 * e, args.in[16] + (size_t)e * D * FF, D, FF, EGU8 + (size_t)e * GU * D, 1, pg8::F8_SW1); conv_queue(F, 9 + 3 * e, args.in[17] + (size_t)e * D * FF, D, FF, EGU8 + (size_t)e * GU * D, 2, pg8::F8_SW1);
                conv_queue(F, 10 + 3 * e, args.in[18] + (size_t)e * FF * D, FF, D, ED8 + (size_t)e * D * FF, 0, pg8::F8_SW2); }
            gmlp_pull();
        }
        SEAM(pb + 2);
        if (IN(pb + 3)) {
            pg8::Gemm g{Y, (bf16*)(ws + WS_WO) + (size_t)l * D * D, 2 * D}; pg8::StaticOrder S; S.init(M, D, F.G, (int)blockIdx.x);
            if constexpr (l == 0) { pg8::EpiResidB<true> E{args.in[0], XR, D, 1.0f}; pg8::gemm_phase<pg8::EpiResidB<true>, pg8::StaticOrder, true, true>(F.lds + RING_OFF, g, S, E); }
            else { pg8::EpiResidB<false> E{XR, XR, D, 1.0f}; pg8::gemm_phase<pg8::EpiResidB<false>, pg8::StaticOrder, true, true>(F.lds + RING_OFF, g, S, E); }
        }
        SEAM(pb + 3);
        if (IN(pb + 4)) {
            int hc[8];
#pragma unroll
            for (int e = 0; e < 8; ++e) hc[e] = 0;
            if constexpr (l == 1) {
                f32x4 rv8[8];
#pragma unroll
                for (int j = 0; j < 8; ++j) { const int c = F.tid + j * (NWAVES * 64), k = c >> 1, hh = c & 1; rv8[j] = *(const f32x4*)(args.in[15] + (size_t)k * 8 + 4 * hh); }
#pragma unroll
                for (int j = 0; j < 8; ++j) { const int c = F.tid + j * (NWAVES * 64), k = c >> 1, hh = c & 1;
                    *(LAS f32x4*)(F.lds + ((((k >> 9) * 8 + (k & 7)) * 2 + hh) << 10) + ((k >> 3) & 63) * 16) = rv8[j]; }
                __syncthreads();
            }
            f32x4 gn[8]; load_gain_b(args.in[11] + l * D, F.lane, gn);
            v4u rc[4]; if (F.gw < M) load_raw_b(XR + (size_t)F.gw * D, F.lane, rc);
            for (int m = F.gw; m < M; m += F.NGW) {
                v4u rn[4];
#pragma unroll
                for (int j = 0; j < 4; ++j) rn[j] = rc[j];
                if (m + F.NGW < M) load_raw_b(XR + (size_t)(m + F.NGW) * D, F.lane, rn);
                f32x4 v[8]; norm_raw_b(rc, gn, v);
#pragma unroll
                for (int j = 0; j < 4; ++j) rc[j] = rn[j];
                if constexpr (l == 0) {
                    if constexpr (DENSE_F8 == 3) { v2u* d8 = (v2u*)(ws + WS_XS8 + (size_t)m * D) + F.lane;
#pragma unroll
                        for (int j = 0; j < 4; ++j) { const f32x4 a0 = v[2 * j] * pg8::F8_SX, a1 = v[2 * j + 1] * pg8::F8_SX; v2u q; q.x = pg8::pk4_fp8(a0[0], a0[1], a0[2], a0[3]); q.y = pg8::pk4_fp8(a1[0], a1[1], a1[2], a1[3]); d8[64 * j] = q; } }
                    else store_row_bf16_b(XN + (size_t)m * D, F.lane, v); }
                if constexpr (l == 1) {
                    asm volatile("" ::: "memory");
                    float lg[8];
#pragma unroll
                    for (int e = 0; e < 8; ++e) lg[e] = 0.f;
#pragma unroll
                    for (int j = 0; j < 4; ++j)
#pragma unroll
                        for (int i = 0; i < 8; ++i) { const f32x4 r0 = *(const LAS f32x4*)(F.lds + (((j * 8 + i) * 2) << 10) + F.lane * 16), r1 = *(const LAS f32x4*)(F.lds + (((j * 8 + i) * 2 + 1) << 10) + F.lane * 16); const float hv = v[2 * j + (i >> 2)][i & 3];
                            lg[0] += hv * r0.x; lg[1] += hv * r0.y; lg[2] += hv * r0.z; lg[3] += hv * r0.w; lg[4] += hv * r1.x; lg[5] += hv * r1.y; lg[6] += hv * r1.z; lg[7] += hv * r1.w; }
#pragma unroll
                    for (int e = 0; e < 8; ++e) lg[e] = wave_sum(lg[e]);
                    int e0 = 0; float v0 = lg[0];
#pragma unroll
                    for (int e = 1; e < 8; ++e) if (lg[e] > v0) { v0 = lg[e]; e0 = e; }
                    int e1 = -1; float v1 = -3.0e38f;
#pragma unroll
                    for (int e = 0; e < 8; ++e) if (e != e0 && lg[e] > v1) { v1 = lg[e]; e1 = e; }
                    const float ex = __expf(v1 - v0), w0 = 1.0f / (1.0f + ex), w1 = ex / (1.0f + ex);
                    if (F.lane == 0) { *(i32x2*)(((int*)(ws + WS_SMALL + SM_TOKE)) + 2 * m) = (i32x2){e0, e1}; *(f32x2*)(((float*)(ws + WS_SMALL + SM_TOKW)) + 2 * m) = (f32x2){w0, w1}; }
#pragma unroll
                    for (int e = 0; e < 8; ++e) hc[e] += (e == e0 ? 1 : 0) + (e == e1 ? 1 : 0);
                }
            }
            if (l == 1 && F.lane == 0) { *(i32x4*)(((int*)(ws + WS_SMALL + SM_WHIST)) + 8 * F.gw) = (i32x4){hc[0], hc[1], hc[2], hc[3]}; *(i32x4*)(((int*)(ws + WS_SMALL + SM_WHIST)) + 8 * F.gw + 4) = (i32x4){hc[4], hc[5], hc[6], hc[7]}; }
        }
        SEAM(pb + 4);
        if constexpr (l == 0) {
            if (IN(6)) {
                pg8::StaticOrder S; S.init(M, GU, F.G, (int)blockIdx.x);
                if constexpr (DENSE_F8 == 1) { pg8::Gemm g{ws + WS_XS8, ws + WS_WGU, D}; pg8::EpiSwiglu8 E{(unsigned char*)H, FF, pg8::F8_INV1};
                    pg8::gemm_phase<pg8::EpiSwiglu8, pg8::StaticOrder, true, true, true>(F.lds + RING_OFF, g, S, E); }
                else if constexpr (DENSE_F8 == 2) { pg8::Gemm g{XN, (bf16*)(ws + WS_WGU), 2 * D}; pg8::EpiSwiglu8 E{(unsigned char*)H, FF, 1.0f};
                    pg8::gemm_phase<pg8::EpiSwiglu8, pg8::StaticOrder, true, true>(F.lds + RING_OFF, g, S, E); }
                else if constexpr (DENSE_F8 == 3) { pg8::Gemm g{ws + WS_XS8, ws + WS_WGU, D}; pg8::EpiSwiglu E{H, FF, pg8::F8_INV1};
                    pg8::gemm_phase<pg8::EpiSwiglu, pg8::StaticOrder, true, true, true>(F.lds + RING_OFF, g, S, E); }
                else { pg8::Gemm g{XN, (bf16*)(ws + WS_WGU), 2 * D}; pg8::EpiSwiglu E{H, FF, 1.0f};
                    pg8::gemm_phase<pg8::EpiSwiglu, pg8::StaticOrder, true, true>(F.lds + RING_OFF, g, S, E); }
            }
            SEAM(6);
            if (IN(7)) {
                pg8::StaticOrder S; S.init(M, D, F.G, (int)blockIdx.x);
                if constexpr (DENSE_F8 == 1 || DENSE_F8 == 2) { pg8::Gemm g{H, ws + WS_WD, FF}; pg8::EpiResidB<false> E{XR, XR, D, pg8::F8_INV2};
                    pg8::gemm_phase<pg8::EpiResidB<false>, pg8::StaticOrder, true, true, true>(F.lds + RING_OFF, g, S, E); }
                else { pg8::Gemm g{H, (bf16*)(ws + WS_WD), 2 * FF}; pg8::EpiResidB<false> E{XR, XR, D, 1.0f};
                    pg8::gemm_phase<pg8::EpiResidB<false>, pg8::StaticOrder, true, true>(F.lds + RING_OFF, g, S, E); }
            }
            SEAM(7);
        }
}

__global__ void __launch_bounds__(NWAVES * 64, 2) trunk_fwd(Args args) {
    extern __shared__ __attribute__((aligned(16))) unsigned char lds[];
    Frame F;
    F.lds = (LAS unsigned char*)lds;
    F.tid = threadIdx.x; F.lane = F.tid & 63; F.wave = __builtin_amdgcn_readfirstlane(F.tid >> 6);
    F.G = gridDim.x; F.gw = blockIdx.x * NWAVES + F.wave; F.NGW = F.G * NWAVES; F.ws = args.ws;
    unsigned char* ws = args.ws;
    for (int u = F.tid; u < (LDS_BYTES - LDSCTL_OFF) / 4; u += NWAVES * 64) ((LAS unsigned*)(F.lds + LDSCTL_OFF))[u] = 0u;
    __syncthreads();
    volatile LAS unsigned* MISC = (volatile LAS unsigned*)(F.lds + MISC_OFF);
    const int lo = args.ph_lo, hi = args.ph_hi;
    XcdBarrier bar; bar.bar = (unsigned*)(ws + WS_CTL) + CW_BAR; bar.x = 0; bar.st = nullptr;
    if (hi - lo > 1) bar = xcd_barrier_post((unsigned*)(ws + WS_CTL) + CW_BAR, MISC + 8);

    float* out = args.out;
    bf16* XN = (bf16*)(ws + WS_XN); bf16* H = (bf16*)(ws + WS_H); bf16* XS = (bf16*)(ws + WS_XS);
    int* TOKE = (int*)(ws + WS_SMALL + SM_TOKE); float* TOKW = (float*)(ws + WS_SMALL + SM_TOKW); int* TOKP = (int*)(ws + WS_SMALL + SM_TOKP);
    int* WHIST = (int*)(ws + WS_SMALL + SM_WHIST); int* MTS = (int*)(ws + WS_SMALL + SM_TS);

    if (IN(0)) for (int rep = 0; rep < REP_CONV; ++rep) {
        bf16* WIN = (bf16*)(ws + WS_WIN); bf16* WO = (bf16*)(ws + WS_WO); bf16* WGU = (bf16*)(ws + WS_WGU); bf16* WD = (bf16*)(ws + WS_WD);
        bf16* EGU = (bf16*)(ws + WS_EGU); bf16* ED = (bf16*)(ws + WS_ED);
        { bf16* WC = (bf16*)(ws + WS_SMALL + SM_WC); const float* wsp = args.in[3];
            for (int i = blockIdx.x * (NWAVES * 64) + F.tid; i < 8 * 16384; i += F.G * NWAVES * 64) { const int t = (i >> 6) & 127, sx = 2 * (i & 63); const f32x2 wv = *(const f32x2*)(wsp + 2 * i); ((unsigned*)WC)[i] = pk2(sx <= t ? wv.x : 0.f, sx + 1 <= t ? wv.y : 0.f); } }
        conv_matrix(F, args.in[2], D, DIN, WIN, 0); conv_matrix(F, args.in[10], D, D, WO, 0);
    }

    layer_phases<0>(F, args, bar, lo, hi);
    layer_phases<1>(F, args, bar, lo, hi);

    if (IN(13)) {
        int pre[8], tot[8];
#pragma unroll
        for (int e = 0; e < 8; ++e) { pre[e] = 0; tot[e] = 0; }
        for (int w = F.lane; w < F.NGW; w += 64) { const i32x4 a = *(const i32x4*)(WHIST + 8 * w), b = *(const i32x4*)(WHIST + 8 * w + 4); const int hv[8] = {a.x, a.y, a.z, a.w, b.x, b.y, b.z, b.w};
#pragma unroll
            for (int e = 0; e < 8; ++e) { tot[e] += hv[e]; pre[e] += (w < F.gw) ? hv[e] : 0; } }
        int base[8], ts[9]; ts[0] = 0;
#pragma unroll
        for (int e = 0; e < 8; ++e) { tot[e] = wave_sum_i(tot[e]); pre[e] = wave_sum_i(pre[e]); ts[e + 1] = ts[e] + ((tot[e] + 255) >> 8); base[e] = ts[e] * 256 + pre[e]; }
        if (F.gw == 0 && F.lane == 0) {
#pragma unroll
            for (int e = 0; e < 9; ++e) MTS[e] = ts[e]; }
        f32x4 gn[8]; load_gain_b(args.in[11] + D, F.lane, gn);
        v4u rc[4]; if (F.gw < M) load_raw_b((const bf16*)(ws + WS_O) + (size_t)F.gw * D, F.lane, rc);
        for (int m = F.gw; m < M; m += F.NGW) {
            v4u rn[4];
#pragma unroll
            for (int j = 0; j < 4; ++j) rn[j] = rc[j];
            if (m + F.NGW < M) load_raw_b((const bf16*)(ws + WS_O) + (size_t)(m + F.NGW) * D, F.lane, rn);
            const i32x2 ee = *(const i32x2*)(TOKE + 2 * m); int p0 = 0, p1 = 0;
#pragma unroll
            for (int e = 0; e < 8; ++e) { if (ee.x == e) { p0 = base[e]; base[e] += 1; } if (ee.y == e) { p1 = base[e]; base[e] += 1; } }
            if (F.lane == 0) *(i32x2*)(TOKP + 2 * m) = (i32x2){p0, p1};
            unsigned char* XS8 = (unsigned char*)(ws + WS_XS8);
            f32x4 v[8]; norm_raw_b(rc, gn, v);
#pragma unroll
            for (int j = 0; j < 4; ++j) rc[j] = rn[j];
            v2u* d0 = (v2u*)(XS8 + (size_t)p0 * D) + F.lane; v2u* d1 = (v2u*)(XS8 + (size_t)p1 * D) + F.lane;
#pragma unroll
            for (int j = 0; j < 4; ++j) { const f32x4 a0 = v[2 * j] * pg8::F8_SX, a1 = v[2 * j + 1] * pg8::F8_SX; v2u q;
                q.x = pg8::pk4_fp8(a0[0], a0[1], a0[2], a0[3]); q.y = pg8::pk4_fp8(a1[0], a1[1], a1[2], a1[3]);
                d0[64 * j] = q; d1[64 * j] = q; }
        }
    }
    SEAM(13);
    if (IN(14)) for (int rep = 0; rep < REP_G16; ++rep) {
        pg8::MoeOrder S; S.G = F.G; S.c = (int)blockIdx.x; S.nN = GU / 256;
#pragma unroll
        for (int e = 0; e < 9; ++e) S.ts[e] = __builtin_amdgcn_readfirstlane(MTS[e]);
        pg8::Gemm g{ws + WS_XS8, ws + WS_EGU, D}; pg8::EpiSwiglu8 E{(unsigned char*)H, FF, pg8::F8_INV1};
        pg8::gemm_phase<pg8::EpiSwiglu8, pg8::MoeOrder, false, true, true>(F.lds + RING_OFF, g, S, E);
    }
    SEAM(14);
    if (IN(15)) {
        pg8::MoeOrderT<true> S; S.G = F.G; S.c = (int)blockIdx.x; S.nN = D / 256;
#pragma unroll
        for (int e = 0; e < 9; ++e) S.ts[e] = __builtin_amdgcn_readfirstlane(MTS[e]);
        S.ntk = FF / 128; S.pbuf = (float*)(ws + WS_XN); S.pcnt = (unsigned*)(ws + WS_CTL) + CW_SK; S.lflag = (LAS unsigned*)(F.lds + MISC_OFF + 64);
        pg8::Gemm g{H, ws + WS_ED, FF}; pg8::EpiStoreBf16s E{XS, D, pg8::F8_INV2};
        pg8::gemm_phase<pg8::EpiStoreBf16s, pg8::MoeOrderT<true>, true, true, true>(F.lds + RING_OFF, g, S, E);
    }
    SEAM(15);
    if (IN(16)) {
        const bf16* XR = (const bf16*)(ws + WS_O);
        f32x4 gn[8]; load_gain_b(args.in[19], F.lane, gn);
        v4u xc[4], ac[4], bc[4]; i32x2 ppn = (i32x2){0, 0}; f32x2 wwc = (f32x2){0.f, 0.f}, wwn = (f32x2){0.f, 0.f};
        if (F.gw < M) { const i32x2 pp = *(const i32x2*)(TOKP + 2 * F.gw); wwc = *(const f32x2*)(TOKW + 2 * F.gw);
            load_raw_b(XR + (size_t)F.gw * D, F.lane, xc); load_raw_b(XS + (size_t)pp.x * D, F.lane, ac); load_raw_b(XS + (size_t)pp.y * D, F.lane, bc); }
        if (F.gw + F.NGW < M) { ppn = *(const i32x2*)(TOKP + 2 * (F.gw + F.NGW)); wwn = *(const f32x2*)(TOKW + 2 * (F.gw + F.NGW)); }
        for (int m = F.gw; m < M; m += F.NGW) {
            v4u xn[4], an[4], bn[4]; i32x2 ppnn = ppn; f32x2 wwnn = wwn;
#pragma unroll
            for (int j = 0; j < 4; ++j) { xn[j] = xc[j]; an[j] = ac[j]; bn[j] = bc[j]; }
            if (m + F.NGW < M) { load_raw_b(XR + (size_t)(m + F.NGW) * D, F.lane, xn); load_raw_b(XS + (size_t)ppn.x * D, F.lane, an); load_raw_b(XS + (size_t)ppn.y * D, F.lane, bn); }
            if (m + 2 * F.NGW < M) { ppnn = *(const i32x2*)(TOKP + 2 * (m + 2 * F.NGW)); wwnn = *(const f32x2*)(TOKW + 2 * (m + 2 * F.NGW)); }
            const f32x2 ww = wwc;
            f32x4 v[8]; float s = 0.f;
#pragma unroll
            for (int j = 0; j < 4; ++j) { const v4u px = xc[j], pa = ac[j], pb2 = bc[j];
                v[2 * j] = (f32x4){bflo(px.x) + ww.x * bflo(pa.x) + ww.y * bflo(pb2.x), bfhi(px.x) + ww.x * bfhi(pa.x) + ww.y * bfhi(pb2.x), bflo(px.y) + ww.x * bflo(pa.y) + ww.y * bflo(pb2.y), bfhi(px.y) + ww.x * bfhi(pa.y) + ww.y * bfhi(pb2.y)};
                v[2 * j + 1] = (f32x4){bflo(px.z) + ww.x * bflo(pa.z) + ww.y * bflo(pb2.z), bfhi(px.z) + ww.x * bfhi(pa.z) + ww.y * bfhi(pb2.z), bflo(px.w) + ww.x * bflo(pa.w) + ww.y * bflo(pb2.w), bfhi(px.w) + ww.x * bfhi(pa.w) + ww.y * bfhi(pb2.w)}; }
#pragma unroll
            for (int j = 0; j < 8; ++j) s += (v[j].x * v[j].x + v[j].y * v[j].y) + (v[j].z * v[j].z + v[j].w * v[j].w);
            const float rstd = 1.0f / sqrtf(wave_sum(s) * (1.0f / D) + EPS);
            f32x4* orow = (f32x4*)(out + (size_t)m * D) + 2 * F.lane;
#pragma unroll
            for (int j = 0; j < 4; ++j) { orow[128 * j] = v[2 * j] * rstd * gn[2 * j]; orow[128 * j + 1] = v[2 * j + 1] * rstd * gn[2 * j + 1]; }
#pragma unroll
            for (int j = 0; j < 4; ++j) { xc[j] = xn[j]; ac[j] = an[j]; bc[j] = bn[j]; }
            wwc = wwn; ppn = ppnn; wwn = wwnn;
        }
    }
}

extern "C" void kernel_launch(void* const* d_in, const int* in_sizes, int n_in, void* d_out, int out_size, void* d_ws, size_t ws_size, hipStream_t stream) {
    static int grid = 0;
    if (grid == 0) {
        if (n_in != 20 || in_sizes[0] != M * D || out_size != M * D || ws_size < WS_END) { fprintf(stderr, "kernel_launch: unexpected shapes / workspace (n_in %d, ws %zu, need %zu); nothing launched\n", n_in, ws_size, (size_t)WS_END); grid = -1; return; }
        int dev = 0, cus = 0, per_cu = 0;
        if (hipGetDevice(&dev) != hipSuccess || hipDeviceGetAttribute(&cus, hipDeviceAttributeMultiprocessorCount, dev) != hipSuccess) { grid = -1; return; }
        if (hipFuncSetAttribute((const void*)trunk_fwd, hipFuncAttributeMaxDynamicSharedMemorySize, LDS_BYTES) != hipSuccess) { fprintf(stderr, "kernel_launch: hipFuncSetAttribute failed\n"); grid = -1; return; }
        if (hipOccupancyMaxActiveBlocksPerMultiprocessor(&per_cu, (const void*)trunk_fwd, NWAVES * 64, LDS_BYTES) != hipSuccess || per_cu < 1) fprintf(stderr, "kernel_launch: occupancy query reports %d\n", per_cu);
        (void)hipGetLastError();
        grid = cus;
    }
    if (grid < 0) return;
    if (hipMemsetAsync((char*)d_ws + WS_CTL, 0, CTL_ZERO_BYTES, stream) != hipSuccess) return;
    Args a{};
    for (int i = 0; i < 20; ++i) a.in[i] = (const float*)d_in[i];
    a.out = (float*)d_out; a.ws = (unsigned char*)d_ws;
#if MK_ONE_LAUNCH
    a.ph_lo = 0; a.ph_hi = NPHASE;
    hipLaunchKernelGGL(trunk_fwd, dim3(grid), dim3(NWAVES * 64), LDS_BYTES, stream, a);
#else
    for (int p = 0; p < NPHASE; ++p) {
        a.ph_lo = p; a.ph_hi = p + 1;
        hipLaunchKernelGGL(trunk_fwd, dim3(grid), dim3(NWAVES * 64), LDS_BYTES, stream, a);
    }
#endif
}
```

```cpp
#include <hip/hip_runtime.h>
#include <cstdio>
#include <cstdint>

#ifndef REP_CONV
#define REP_CONV 1
#endif
#ifndef REP_MIX
#define REP_MIX 1
#endif
#ifndef REP_G16
#define REP_G16 1
#endif
#ifndef DENSE_F8
#define DENSE_F8 3
#endif
#ifndef MK_ONE_LAUNCH
#define MK_ONE_LAUNCH 1
#endif

namespace pg8 {
#define PG8_LAS __attribute__((address_space(3)))
typedef unsigned short bf16_t;
typedef short bf16x8 __attribute__((ext_vector_type(8)));
typedef float f32x4 __attribute__((ext_vector_type(4)));
typedef unsigned u32x4 __attribute__((ext_vector_type(4)));
constexpr int BM = 256, BK = 64, HALF = 128, HTB = HALF * BK * 2, STAGE_BYTES = 8 * HTB, NXCD = 8, WGM = 8;

__host__ __device__ __forceinline__ int lds_byte(int r, int c) { const int st = (r >> 4) * 2 + (c >> 5), rr = r & 15, cc = c & 31, ob = rr * 64 + cc * 2; return st * 1024 + (ob ^ (((ob >> 9) & 1) << 5)); }
__host__ __device__ __forceinline__ void stage_rc(int b, int& R, int& C) { const int st = b / 1024, sb = b % 1024, swz = sb ^ (((sb >> 9) & 1) << 5); R = (st >> 1) * 16 + swz / 64; C = (st & 1) * 32 + (swz % 64) / 2; }
__host__ __device__ __forceinline__ int perm32(int rho) { const int n = rho >> 4, i = rho & 15; return 8 * (i >> 2) + 4 * n + (i & 3); }

struct Unit { int pm, pn, po; int kt0, knt, part, tix, sp; };
struct Gemm { const void* A; const void* Bt; int Kb; };

struct StaticOrder {
    static constexpr bool SPLITK = false;
    int nM, nN, nwg, G, c;
    __host__ __device__ void init(int M, int N, int G_, int c_) { nM = M / BM; nN = N / BM; nwg = nM * nN; G = G_; c = c_; }
    __host__ __device__ bool next(int i, Unit& u) const {
        const long L = (long)i * G + c; if (L >= nwg) return false;
        int wgid = (int)L; { const int q = nwg / NXCD, r = nwg % NXCD, xcd = wgid % NXCD, off = wgid / NXCD; wgid = (xcd < r ? xcd * (q + 1) : r * (q + 1) + (xcd - r) * q) + off; }
        const int nig = WGM * nN, gid = wgid / nig, fm = gid * WGM, gsz = (nM - fm) < WGM ? (nM - fm) : WGM;
        u.pm = fm + ((wgid % nig) % gsz); u.pn = (wgid % nig) / gsz; u.po = u.pn; return true;
    }
    __device__ __forceinline__ void a_ready(const Unit&) const {}
    __device__ __forceinline__ void done(const Unit&) const {}
};
template <bool SK> struct MoeOrderT {
    static constexpr bool SPLITK = SK;
    int G, c, nN; int ts[9];
    int ntk; float* pbuf; unsigned* pcnt; PG8_LAS unsigned* lflag;
    __device__ __forceinline__ void locate(int L, Unit& u) const {
        int e = 0;
#pragma unroll
        for (int j = 1; j < 8; ++j) e = (L >= ts[j] * nN) ? j : e;
        int tse = ts[0], tsn = ts[1];
#pragma unroll
        for (int j = 1; j < 8; ++j) { tse = (e == j) ? ts[j] : tse; tsn = (e == j) ? ts[j + 1] : tsn; }
        const int l = L - tse * nN, te = tsn - tse;
        const int cg = l / (te * 4), rem = l - cg * (te * 4), pr = rem >> 2;
        u.pm = tse + pr; u.po = cg * 4 + (rem & 3); u.pn = e * nN + u.po;
    }
    __device__ __forceinline__ int unit_index(int i) const { const int per = G >> 3; return ((G & 7) == 0) ? (i * 8 + (c & 7)) * per + (c >> 3) : i * G + c; }
    __device__ __forceinline__ int nsplit(int T) const { int sp = 1; if (SK && T > 0) { sp = G / T; sp = sp > 4 ? 4 : sp; } return sp; }
    __device__ __forceinline__ bool next(int i, Unit& u) const {
        const int total = ts[8] * nN;
        if constexpr (SK) {
            const int R = total / G, T = total - R * G, sp = nsplit(T);
            if (i >= R && sp > 1) {
                if (i > R || c >= T * sp) return false;
                const int part = c / T, tix = c - part * T, pairs = ntk >> 1, base = pairs / sp, extra = pairs - base * sp;
                locate(R * G + tix, u);
                u.part = part; u.tix = tix; u.sp = sp; u.kt0 = 2 * (part * base + (part < extra ? part : extra)); u.knt = 2 * (base + (part < extra ? 1 : 0)); return true;
            }
            u.part = -1; u.tix = 0; u.sp = 1; u.kt0 = 0; u.knt = ntk;
        }
        const int L = unit_index(i); if (L >= total) return false;
        locate(L, u); return true;
    }
    __device__ __forceinline__ void a_ready(const Unit&) const {}
    __device__ __forceinline__ void done(const Unit&) const {}
};
typedef MoeOrderT<false> MoeOrder;


typedef float f32x2c __attribute__((ext_vector_type(2)));
typedef __bf16 bf16x2c __attribute__((ext_vector_type(2)));
__device__ __forceinline__ unsigned cvt_pk_bf16(float lo, float hi) { const f32x2c v = {lo, hi}; return __builtin_bit_cast(unsigned, __builtin_convertvector(v, bf16x2c)); }

struct EpiStoreBf16 {
    static constexpr bool PERM = true, AFTER_DRAIN = false;
    bf16_t* O; int ldc;
    __device__ __forceinline__ void operator()(const f32x4 (&acc)[2][2][4][2], const Unit& u, int wr, int wc, int fr, int fq) const {
        const int row0 = u.pm * BM + wr * 64 + fr, col0 = u.po * BM + wc * 32 + 8 * fq;
#pragma unroll
        for (int ai = 0; ai < 2; ++ai)
#pragma unroll
            for (int m = 0; m < 4; ++m) { bf16_t* rowp = O + (size_t)(row0 + ai * HALF + m * 16) * ldc + col0;
#pragma unroll
                for (int bj = 0; bj < 2; ++bj) { const f32x4 v0 = acc[ai][bj][m][0], v1 = acc[ai][bj][m][1];
                    u32x4 w; w.x = cvt_pk_bf16(v0[0], v0[1]); w.y = cvt_pk_bf16(v0[2], v0[3]); w.z = cvt_pk_bf16(v1[0], v1[1]); w.w = cvt_pk_bf16(v1[2], v1[3]);
                    *(u32x4*)(rowp + bj * HALF) = w; } }
    }
};
struct EpiResid {
    static constexpr bool PERM = false, AFTER_DRAIN = false;
    const float* base; float* out; int ldc; float scale;
    __device__ __forceinline__ void operator()(const f32x4 (&acc)[2][2][4][2], const Unit& u, int wr, int wc, int fr, int fq) const {
        const int row0 = u.pm * BM + wr * 64 + fr, col0 = u.po * BM + wc * 32 + 4 * fq;
#pragma unroll
        for (int ai = 0; ai < 2; ++ai)
#pragma unroll
            for (int m = 0; m < 4; ++m) { const size_t off = (size_t)(row0 + ai * HALF + m * 16) * ldc + col0;
#pragma unroll
                for (int bj = 0; bj < 2; ++bj)
#pragma unroll
                    for (int n = 0; n < 2; ++n) { const f32x4 b = *(const f32x4*)(base + off + bj * HALF + n * 16); *(f32x4*)(out + off + bj * HALF + n * 16) = b + acc[ai][bj][m][n] * scale; }
                asm volatile("" ::: "memory"); }
    }
};
template <bool BASE_F32> struct EpiResidB {
    static constexpr bool PERM = true, AFTER_DRAIN = false;
    const void* base; bf16_t* out; int ldc; float scale;
    __device__ __forceinline__ void operator()(const f32x4 (&acc)[2][2][4][2], const Unit& u, int wr, int wc, int fr, int fq) const {
        const int row0 = u.pm * BM + wr * 64 + fr, col0 = u.po * BM + wc * 32 + 8 * fq;
        if constexpr (!BASE_F32) {
            u32x4 t[2][4][2];
#pragma unroll
            for (int ai = 0; ai < 2; ++ai)
#pragma unroll
                for (int m = 0; m < 4; ++m)
#pragma unroll
                    for (int bj = 0; bj < 2; ++bj) t[ai][m][bj] = *(const u32x4*)((const bf16_t*)base + (size_t)(row0 + ai * HALF + m * 16) * ldc + col0 + bj * HALF);
#pragma unroll
            for (int ai = 0; ai < 2; ++ai)
#pragma unroll
                for (int m = 0; m < 4; ++m)
#pragma unroll
                    for (int bj = 0; bj < 2; ++bj) { const u32x4 q = t[ai][m][bj];
                        const f32x4 b0 = (f32x4){__builtin_bit_cast(float, q.x << 16), __builtin_bit_cast(float, q.x & 0xffff0000u), __builtin_bit_cast(float, q.y << 16), __builtin_bit_cast(float, q.y & 0xffff0000u)};
                        const f32x4 b1 = (f32x4){__builtin_bit_cast(float, q.z << 16), __builtin_bit_cast(float, q.z & 0xffff0000u), __builtin_bit_cast(float, q.w << 16), __builtin_bit_cast(float, q.w & 0xffff0000u)};
                        const f32x4 v0 = b0 + acc[ai][bj][m][0] * scale, v1 = b1 + acc[ai][bj][m][1] * scale;
                        u32x4 w; w.x = cvt_pk_bf16(v0[0], v0[1]); w.y = cvt_pk_bf16(v0[2], v0[3]); w.z = cvt_pk_bf16(v1[0], v1[1]); w.w = cvt_pk_bf16(v1[2], v1[3]);
                        *(u32x4*)(out + (size_t)(row0 + ai * HALF + m * 16) * ldc + col0 + bj * HALF) = w; }
            return;
        }
#pragma unroll
        for (int ai = 0; ai < 2; ++ai) {
            f32x4 b0[4][2], b1[4][2];
            if constexpr (BASE_F32) {
#pragma unroll
                for (int m = 0; m < 4; ++m)
#pragma unroll
                    for (int bj = 0; bj < 2; ++bj) { const float* bp = (const float*)base + (size_t)(row0 + ai * HALF + m * 16) * ldc + col0 + bj * HALF; b0[m][bj] = *(const f32x4*)bp; b1[m][bj] = *(const f32x4*)(bp + 4); }
            } else {
                u32x4 t[4][2];
#pragma unroll
                for (int m = 0; m < 4; ++m)
#pragma unroll
                    for (int bj = 0; bj < 2; ++bj) t[m][bj] = *(const u32x4*)((const bf16_t*)base + (size_t)(row0 + ai * HALF + m * 16) * ldc + col0 + bj * HALF);
#pragma unroll
                for (int m = 0; m < 4; ++m)
#pragma unroll
                    for (int bj = 0; bj < 2; ++bj) { const u32x4 q = t[m][bj];
                        b0[m][bj] = (f32x4){__builtin_bit_cast(float, q.x << 16), __builtin_bit_cast(float, q.x & 0xffff0000u), __builtin_bit_cast(float, q.y << 16), __builtin_bit_cast(float, q.y & 0xffff0000u)};
                        b1[m][bj] = (f32x4){__builtin_bit_cast(float, q.z << 16), __builtin_bit_cast(float, q.z & 0xffff0000u), __builtin_bit_cast(float, q.w << 16), __builtin_bit_cast(float, q.w & 0xffff0000u)}; }
            }
#pragma unroll
            for (int m = 0; m < 4; ++m)
#pragma unroll
                for (int bj = 0; bj < 2; ++bj) { const f32x4 v0 = b0[m][bj] + acc[ai][bj][m][0] * scale, v1 = b1[m][bj] + acc[ai][bj][m][1] * scale;
                    u32x4 w; w.x = cvt_pk_bf16(v0[0], v0[1]); w.y = cvt_pk_bf16(v0[2], v0[3]); w.z = cvt_pk_bf16(v1[0], v1[1]); w.w = cvt_pk_bf16(v1[2], v1[3]);
                    *(u32x4*)(out + (size_t)(row0 + ai * HALF + m * 16) * ldc + col0 + bj * HALF) = w; }
        }
    }
};
__device__ __forceinline__ float silu_f(float x) { return x * __builtin_amdgcn_rcpf(1.0f + __expf(-x)); }
__device__ __forceinline__ f32x2c exp2_2(f32x2c t) { return (f32x2c){__builtin_amdgcn_exp2f(t.x), __builtin_amdgcn_exp2f(t.y)}; }
__device__ __forceinline__ f32x2c rcp_2(f32x2c t) { return (f32x2c){__builtin_amdgcn_rcpf(t.x), __builtin_amdgcn_rcpf(t.y)}; }
__device__ __forceinline__ f32x2c silu_2(f32x2c x) { return x * rcp_2(exp2_2(x * -1.4426950408889634f) + 1.0f); }
__device__ __forceinline__ f32x2c gelu_2(f32x2c x) { const f32x2c t = x * (x * x * -0.10294322f + -2.3022082f); return x * rcp_2(exp2_2(t) + 1.0f); }
__device__ __forceinline__ unsigned cvt_pk_bf16_2(f32x2c v) { return __builtin_bit_cast(unsigned, __builtin_convertvector(v, bf16x2c)); }
struct EpiSwiglu {
    static constexpr bool PERM = true, AFTER_DRAIN = false;
    bf16_t* O; int ldc; float isc;
    __device__ __forceinline__ void operator()(const f32x4 (&acc)[2][2][4][2], const Unit& u, int wr, int wc, int fr, int fq) const {
        const int row0 = u.pm * BM + wr * 64 + fr, col0 = u.po * HALF + wc * 32 + 8 * fq;
        const float kn = -1.4426950408889634f * isc, invC = 1.0f / (isc * isc);
#pragma unroll
        for (int ai = 0; ai < 2; ++ai)
#pragma unroll
            for (int m = 0; m < 4; ++m) { bf16_t* rowp = O + (size_t)(row0 + ai * HALF + m * 16) * ldc + col0;
                const f32x4 g0 = acc[ai][0][m][0], g1 = acc[ai][0][m][1], u0 = acc[ai][1][m][0], u1 = acc[ai][1][m][1];
                const f32x2c ga = {g0[0], g0[1]}, gb = {g0[2], g0[3]}, gc = {g1[0], g1[1]}, gd = {g1[2], g1[3]};
                const f32x2c ua = {u0[0], u0[1]}, ub = {u0[2], u0[3]}, uc = {u1[0], u1[1]}, ud = {u1[2], u1[3]};
                const f32x2c ha = (ga * ua) * rcp_2(exp2_2(ga * kn) * invC + invC), hb = (gb * ub) * rcp_2(exp2_2(gb * kn) * invC + invC);
                const f32x2c hc = (gc * uc) * rcp_2(exp2_2(gc * kn) * invC + invC), hd = (gd * ud) * rcp_2(exp2_2(gd * kn) * invC + invC);
                u32x4 w; w.x = cvt_pk_bf16_2(ha); w.y = cvt_pk_bf16_2(hb); w.z = cvt_pk_bf16_2(hc); w.w = cvt_pk_bf16_2(hd);
                *(u32x4*)rowp = w; }
    }
};


__device__ __forceinline__ float clamp8(float v) { return __builtin_amdgcn_fmed3f(v, -448.0f, 448.0f); }
__device__ __forceinline__ unsigned pk4_fp8(float a, float b, float c, float d) { int p = __builtin_amdgcn_cvt_pk_fp8_f32(clamp8(a), clamp8(b), 0, false); p = __builtin_amdgcn_cvt_pk_fp8_f32(clamp8(c), clamp8(d), p, true); return (unsigned)p; }
constexpr float F8_SX = 8.0f, F8_SW1 = 256.0f, F8_SH = 4.0f, F8_SW2 = 512.0f;
constexpr float F8_INV1 = 1.0f / (F8_SX * F8_SW1), F8_INV2 = 1.0f / (F8_SH * F8_SW2);
typedef unsigned u32x2 __attribute__((ext_vector_type(2)));
struct EpiSwiglu8 {
    static constexpr bool PERM = true, AFTER_DRAIN = false;
    unsigned char* O; int ldc; float isc;
    __device__ __forceinline__ void operator()(const f32x4 (&acc)[2][2][4][2], const Unit& u, int wr, int wc, int fr, int fq) const {
        const int row0 = u.pm * BM + wr * 64 + fr, col0 = u.po * HALF + wc * 32 + 8 * fq;
        const float kn = -1.4426950408889634f * isc, invC = 1.0f / (isc * isc * F8_SH);
#pragma unroll
        for (int ai = 0; ai < 2; ++ai)
#pragma unroll
            for (int m = 0; m < 4; ++m) { unsigned char* rowp = O + (size_t)(row0 + ai * HALF + m * 16) * ldc + col0;
                const f32x4 g0 = acc[ai][0][m][0], g1 = acc[ai][0][m][1], u0 = acc[ai][1][m][0], u1 = acc[ai][1][m][1];
                const f32x2c ga = {g0[0], g0[1]}, gb = {g0[2], g0[3]}, gc = {g1[0], g1[1]}, gd = {g1[2], g1[3]};
                const f32x2c ua = {u0[0], u0[1]}, ub = {u0[2], u0[3]}, uc = {u1[0], u1[1]}, ud = {u1[2], u1[3]};
                const f32x2c ha = (ga * ua) * rcp_2(exp2_2(ga * kn) * invC + invC), hb = (gb * ub) * rcp_2(exp2_2(gb * kn) * invC + invC);
                const f32x2c hc = (gc * uc) * rcp_2(exp2_2(gc * kn) * invC + invC), hd = (gd * ud) * rcp_2(exp2_2(gd * kn) * invC + invC);
                u32x2 w; w.x = pk4_fp8(ha.x, ha.y, hb.x, hb.y); w.y = pk4_fp8(hc.x, hc.y, hd.x, hd.y);
                *(u32x2*)rowp = w; }
    }
};
struct EpiStoreBf16s {
    static constexpr bool PERM = true, AFTER_DRAIN = false;
    bf16_t* O; int ldc; float scale;
    __device__ __forceinline__ void operator()(const f32x4 (&acc)[2][2][4][2], const Unit& u, int wr, int wc, int fr, int fq) const {
        const int row0 = u.pm * BM + wr * 64 + fr, col0 = u.po * BM + wc * 32 + 8 * fq;
#pragma unroll
        for (int ai = 0; ai < 2; ++ai)
#pragma unroll
            for (int m = 0; m < 4; ++m) { bf16_t* rowp = O + (size_t)(row0 + ai * HALF + m * 16) * ldc + col0;
#pragma unroll
                for (int bj = 0; bj < 2; ++bj) { const f32x4 v0 = acc[ai][bj][m][0] * scale, v1 = acc[ai][bj][m][1] * scale;
                    u32x4 w; w.x = cvt_pk_bf16(v0[0], v0[1]); w.y = cvt_pk_bf16(v0[2], v0[3]); w.z = cvt_pk_bf16(v1[0], v1[1]); w.w = cvt_pk_bf16(v1[2], v1[3]);
                    *(u32x4*)(rowp + bj * HALF) = w; } }
    }
};

__device__ __forceinline__ float gelu_f(float x) { const float u = 0.7978845608028654f * (x + 0.044715f * x * x * x); return x * __builtin_amdgcn_rcpf(1.0f + __expf(-2.0f * u)); }
struct EpiZ {
    static constexpr bool PERM = true, AFTER_DRAIN = false;
    bf16_t* O; int ldc; const float* lbl; int layer;
    __device__ __forceinline__ void operator()(const f32x4 (&acc)[2][2][4][2], const Unit& u, int wr, int wc, int fr, int fq) const {
        const int row0 = u.pm * BM + wr * 64 + fr, col0 = u.po * BM + wc * 32 + 8 * fq, blk = u.po >> 2;
#pragma unroll
        for (int bj = 0; bj < 2; ++bj) {
            float lb[8];
#pragma unroll
            for (int j = 0; j < 8; ++j) lb[j] = 0.f;
            if (blk == 3 && layer == 1) { const int cc = col0 + bj * HALF - 3072;
                const f32x4 a0 = *(const f32x4*)(lbl + cc), a1 = *(const f32x4*)(lbl + cc + 4), b0 = *(const f32x4*)(lbl + 1024 + cc), b1 = *(const f32x4*)(lbl + 1024 + cc + 4);
#pragma unroll
                for (int j = 0; j < 4; ++j) { lb[j] = 1.0f / (1.0f + __expf(a0[j] - b0[j])); lb[4 + j] = 1.0f / (1.0f + __expf(a1[j] - b1[j])); } }
#pragma unroll
            for (int ai = 0; ai < 2; ++ai)
#pragma unroll
                for (int m = 0; m < 4; ++m) { bf16_t* rowp = O + (size_t)(row0 + ai * HALF + m * 16) * ldc + col0 + bj * HALF;
                    const f32x4 q0 = acc[ai][bj][m][0], q1 = acc[ai][bj][m][1];
                    f32x2c v[4] = {{q0[0], q0[1]}, {q0[2], q0[3]}, {q1[0], q1[1]}, {q1[2], q1[3]}};
                    if (blk == 2 || blk == 5) {
#pragma unroll
                        for (int j = 0; j < 4; ++j) v[j] = silu_2(v[j]);
                    } else if (blk == 3) {
#pragma unroll
                        for (int j = 0; j < 4; ++j) { const f32x2c sg = rcp_2(exp2_2(v[j] * -1.4426950408889634f) + 1.0f); const f32x2c lbv = {lb[2 * j], lb[2 * j + 1]}; const f32x2c f = lbv + (1.0f - lbv) * sg;
                            v[j] = (f32x2c){__builtin_amdgcn_logf(__builtin_amdgcn_fmed3f(f.x, 1e-6f, 1.0f)), __builtin_amdgcn_logf(__builtin_amdgcn_fmed3f(f.y, 1e-6f, 1.0f))} * 0.6931471805599453f; }
                    }
                    u32x4 w; w.x = cvt_pk_bf16_2(v[0]); w.y = cvt_pk_bf16_2(v[1]); w.z = cvt_pk_bf16_2(v[2]); w.w = cvt_pk_bf16_2(v[3]);
                    *(u32x4*)rowp = w; }
        }
    }
};

typedef int v8i __attribute__((ext_vector_type(8)));
typedef int v4i __attribute__((ext_vector_type(4)));
template <class Epi, class Sched, bool ALIGN_EPI = false, bool SP2 = false, bool F8 = false>
__device__ __forceinline__ void gemm_phase(PG8_LAS unsigned char* lds, const Gemm g, const Sched& S, const Epi& E) {
    const int tid = threadIdx.x, wid = __builtin_amdgcn_readfirstlane(tid >> 6), lane = tid & 63, wr = wid >> 2, wc = wid & 3, fr = lane & 15, fq = lane >> 4;
    const int Kb = g.Kb, nt = Kb / 128;
    unsigned voffA[2], voffB[2];
#pragma unroll
    for (int i = 0; i < 2; ++i) { int R, C; stage_rc(tid * 16 + i * 8192, R, C); const int Rb = Epi::PERM ? ((R & ~31) + perm32(R & 31)) : R;
        voffA[i] = (unsigned)(R * Kb + C * 2); voffB[i] = (unsigned)(Rb * Kb + C * 2); }
    const size_t kstep = (size_t)(BK * 2);
    const size_t hstep = (size_t)HALF * Kb;
    const size_t tstep = 2 * hstep;
    const unsigned ldsw = (unsigned)wid * 1024u;
    const int aoff = lds_byte(wr * 64 + fr, fq * 8), boff = lds_byte(wc * 32 + fr, fq * 8);
#define PG8_SA(b, h) (((b) * 2 + (h)) * HTB)
#define PG8_SB(b, h) ((4 + (b) * 2 + (h)) * HTB)
#define PG8_STAGE(bufoff, gbase, voff) do { _Pragma("unroll") for (int _i = 0; _i < 2; ++_i) \
        __builtin_amdgcn_global_load_lds((const unsigned*)((const char*)(gbase) + (voff)[_i]), (PG8_LAS unsigned*)(lds + (bufoff) + ldsw + _i * 8192), 16, 0, 0); } while (0)
#define PG8_LDA(dst, b, h) do { if constexpr (F8) { _Pragma("unroll") for (int m = 0; m < 4; ++m) { dst##8[m].lo = *(const PG8_LAS v4i*)(lds + PG8_SA(b, h) + aoff + m * 2048); dst##8[m].hi = *(const PG8_LAS v4i*)(lds + PG8_SA(b, h) + aoff + m * 2048 + 1024); } } \
        else { _Pragma("unroll") for (int m = 0; m < 4; ++m) _Pragma("unroll") for (int k = 0; k < 2; ++k) dst[m][k] = *(const PG8_LAS bf16x8*)(lds + PG8_SA(b, h) + aoff + m * 2048 + k * 1024); } } while (0)
#define PG8_LDB(dst, b, h) do { if constexpr (F8) { _Pragma("unroll") for (int n = 0; n < 2; ++n) { dst##8[n].lo = *(const PG8_LAS v4i*)(lds + PG8_SB(b, h) + boff + n * 2048); dst##8[n].hi = *(const PG8_LAS v4i*)(lds + PG8_SB(b, h) + boff + n * 2048 + 1024); } } \
        else { _Pragma("unroll") for (int n = 0; n < 2; ++n) _Pragma("unroll") for (int k = 0; k < 2; ++k) dst[n][k] = *(const PG8_LAS bf16x8*)(lds + PG8_SB(b, h) + boff + n * 2048 + k * 1024); } } while (0)
#define PG8_MMA(ai, bj, At, Bt) do { __builtin_amdgcn_s_setprio(1); if constexpr (F8) { _Pragma("unroll") for (int m = 0; m < 4; ++m) _Pragma("unroll") for (int n = 0; n < 2; ++n) \
            asm volatile("v_mfma_f32_16x16x128_f8f6f4 %0, %1, %2, %0" : "+v"(acc[ai][bj][m][n]) : "v"(Bt##8[n]), "v"(At##8[m])); } \
        else { _Pragma("unroll") for (int m = 0; m < 4; ++m) _Pragma("unroll") for (int n = 0; n < 2; ++n) _Pragma("unroll") for (int k = 0; k < 2; ++k) \
            acc[ai][bj][m][n] = __builtin_amdgcn_mfma_f32_16x16x32_bf16(Bt[n][k], At[m][k], acc[ai][bj][m][n], 0, 0, 0); } __builtin_amdgcn_s_setprio(0); } while (0)
#define PG8_WAIT_V(n) asm volatile("s_waitcnt vmcnt(" #n ")" ::: "memory")
#define PG8_WAIT_L(n) asm volatile("s_waitcnt lgkmcnt(" #n ")" ::: "memory")
#define PG8_BAR __builtin_amdgcn_s_barrier()
#define PG8_SCHED __builtin_amdgcn_sched_barrier(0)
    Unit cur, nxt; int ui = 0;
    if (!S.next(0, cur)) return;
    f32x4 acc[2][2][4][2];
#pragma unroll
    for (int a = 0; a < 2; ++a)
#pragma unroll
        for (int b = 0; b < 2; ++b)
#pragma unroll
            for (int m = 0; m < 4; ++m)
#pragma unroll
                for (int n = 0; n < 2; ++n) acc[a][b][m][n] = (f32x4){0.f, 0.f, 0.f, 0.f};
    bf16x8 At[4][2], B0[2][2], B1[2][2]; v8i At8[4], B08[2], B18[2];
    const char* cA = (const char*)g.A + (size_t)cur.pm * tstep; const char* cB = (const char*)g.Bt + (size_t)cur.pn * tstep;
    if constexpr (Sched::SPLITK) { cA += (size_t)cur.kt0 * kstep; cB += (size_t)cur.kt0 * kstep; }
    S.a_ready(cur);
    if constexpr (SP2) {
        PG8_STAGE(PG8_SB(0, 0), cB, voffB); PG8_STAGE(PG8_SB(0, 1), cB + hstep, voffB); PG8_STAGE(PG8_SA(0, 0), cA, voffA); PG8_STAGE(PG8_SA(0, 1), cA + hstep, voffA);
        if (wr == 1) PG8_BAR;
        PG8_WAIT_V(2); PG8_BAR;
        PG8_STAGE(PG8_SB(1, 0), cB + kstep, voffB); PG8_STAGE(PG8_SA(1, 0), cA + kstep, voffA); PG8_STAGE(PG8_SB(1, 1), cB + hstep + kstep, voffB);
        PG8_WAIT_V(6); PG8_BAR;
    } else {
        PG8_STAGE(PG8_SB(0, 0), cB, voffB); PG8_STAGE(PG8_SA(0, 0), cA, voffA); PG8_STAGE(PG8_SB(0, 1), cB + hstep, voffB); PG8_STAGE(PG8_SA(0, 1), cA + hstep, voffA);
        if (wr == 1) PG8_BAR;
        PG8_WAIT_V(4); PG8_BAR;
        PG8_STAGE(PG8_SB(1, 0), cB + kstep, voffB); PG8_STAGE(PG8_SA(1, 0), cA + kstep, voffA); PG8_STAGE(PG8_SB(1, 1), cB + hstep + kstep, voffB);
        PG8_WAIT_V(6); PG8_BAR;
    }
    for (;;) {
        const bool has_next = S.next(ui + 1, nxt);
        const char* nA = has_next ? (const char*)g.A + (size_t)nxt.pm * tstep : cA; const char* nB = has_next ? (const char*)g.Bt + (size_t)nxt.pn * tstep : cB;
        if constexpr (Sched::SPLITK) { if (has_next) { nA += (size_t)nxt.kt0 * kstep; nB += (size_t)nxt.kt0 * kstep; } }
        const int ntu = Sched::SPLITK ? cur.knt : nt;
        for (int t = 0; t < ntu; t += 2) {
            const bool last = (t == ntu - 2);
            const char* a1 = cA + (size_t)(t + 1) * kstep;
            const char* a2 = last ? nA : cA + (size_t)(t + 2) * kstep; const char* b2 = last ? nB : cB + (size_t)(t + 2) * kstep;
            const char* a3 = a2 + kstep; const char* b3 = b2 + kstep;
            if (last && has_next) S.a_ready(nxt);
            if constexpr (SP2) {
            PG8_LDB(B0, 0, 0); PG8_LDB(B1, 0, 1); PG8_SCHED; PG8_LDA(At, 0, 0); PG8_STAGE(PG8_SA(1, 1), a1 + hstep, voffA);
            PG8_WAIT_V(8); PG8_WAIT_L(0); PG8_BAR; PG8_MMA(0, 0, At, B0); PG8_MMA(0, 1, At, B1); PG8_BAR; PG8_SCHED;
            PG8_LDA(At, 0, 1); PG8_STAGE(PG8_SB(0, 0), b2, voffB); PG8_STAGE(PG8_SB(0, 1), b2 + hstep, voffB); PG8_STAGE(PG8_SA(0, 0), a2, voffA);
            PG8_WAIT_V(8); PG8_WAIT_L(0); PG8_BAR; PG8_MMA(1, 0, At, B0); PG8_MMA(1, 1, At, B1); PG8_BAR; PG8_SCHED;
            PG8_LDB(B0, 1, 0); PG8_LDB(B1, 1, 1); PG8_SCHED; PG8_LDA(At, 1, 0); PG8_STAGE(PG8_SA(0, 1), a2 + hstep, voffA);
            PG8_WAIT_V(8); PG8_WAIT_L(0); PG8_BAR; PG8_MMA(0, 0, At, B0); PG8_MMA(0, 1, At, B1); PG8_BAR; PG8_SCHED;
            PG8_LDA(At, 1, 1); PG8_STAGE(PG8_SB(1, 0), b3, voffB); PG8_STAGE(PG8_SB(1, 1), b3 + hstep, voffB); PG8_STAGE(PG8_SA(1, 0), a3, voffA);
            PG8_WAIT_V(8); PG8_WAIT_L(0); PG8_BAR; PG8_MMA(1, 0, At, B0); PG8_MMA(1, 1, At, B1); PG8_BAR; PG8_SCHED;
            } else {
            PG8_LDB(B0, 0, 0); PG8_SCHED; PG8_LDA(At, 0, 0); PG8_STAGE(PG8_SA(1, 1), a1 + hstep, voffA);
            PG8_WAIT_L(8); PG8_BAR; PG8_WAIT_L(0); PG8_MMA(0, 0, At, B0); PG8_BAR; PG8_SCHED;
            PG8_LDB(B1, 0, 1); PG8_STAGE(PG8_SB(0, 0), b2, voffB);
            PG8_BAR; PG8_WAIT_L(0); PG8_MMA(0, 1, At, B1); PG8_BAR;
            PG8_LDA(At, 0, 1); PG8_STAGE(PG8_SA(0, 0), a2, voffA);
            PG8_BAR; PG8_WAIT_L(0); PG8_MMA(1, 0, At, B0); PG8_BAR; PG8_SCHED;
            PG8_STAGE(PG8_SB(0, 1), b2 + hstep, voffB);
            PG8_WAIT_V(6); PG8_BAR; PG8_MMA(1, 1, At, B1); PG8_BAR;
            PG8_LDB(B0, 1, 0); PG8_SCHED; PG8_LDA(At, 1, 0); PG8_STAGE(PG8_SA(0, 1), a2 + hstep, voffA);
            PG8_WAIT_L(8); PG8_BAR; PG8_WAIT_L(0); PG8_MMA(0, 0, At, B0); PG8_BAR; PG8_SCHED;
            PG8_LDB(B1, 1, 1); PG8_STAGE(PG8_SB(1, 0), b3, voffB);
            PG8_BAR; PG8_WAIT_L(0); PG8_MMA(0, 1, At, B1); PG8_BAR;
            PG8_LDA(At, 1, 1); PG8_STAGE(PG8_SA(1, 0), a3, voffA);
            PG8_BAR; PG8_WAIT_L(0); PG8_MMA(1, 0, At, B0); PG8_BAR; PG8_SCHED;
            PG8_STAGE(PG8_SB(1, 1), b3 + hstep, voffB);
            PG8_WAIT_V(6); PG8_BAR; PG8_MMA(1, 1, At, B1); PG8_BAR;
            }
        }
        if constexpr (ALIGN_EPI) { if (wr == 0) PG8_BAR; }
        if constexpr (F8) {
#pragma unroll
            for (int a = 0; a < 2; ++a)
#pragma unroll
                for (int b = 0; b < 2; ++b) {
                    if (a == 0 && b == 0) asm volatile("s_nop 15\n\ts_nop 15" : "+v"(acc[0][0][0][0]), "+v"(acc[0][0][0][1]), "+v"(acc[0][0][1][0]), "+v"(acc[0][0][1][1]), "+v"(acc[0][0][2][0]), "+v"(acc[0][0][2][1]), "+v"(acc[0][0][3][0]), "+v"(acc[0][0][3][1]));
                    else asm volatile("" : "+v"(acc[a][b][0][0]), "+v"(acc[a][b][0][1]), "+v"(acc[a][b][1][0]), "+v"(acc[a][b][1][1]), "+v"(acc[a][b][2][0]), "+v"(acc[a][b][2][1]), "+v"(acc[a][b][3][0]), "+v"(acc[a][b][3][1])); }
        }
        bool run_epi = true;
        if constexpr (Sched::SPLITK) {
            if (cur.part >= 0) {
                const __amdgpu_buffer_rsrc_t prs = __builtin_amdgcn_make_buffer_rsrc((void*)S.pbuf, 0, 64 << 20, 0x00020000);
                const int pofs = __builtin_amdgcn_readfirstlane((cur.tix * cur.sp + cur.part) * 262144);
#pragma unroll
                for (int a = 0; a < 2; ++a)
#pragma unroll
                    for (int b = 0; b < 2; ++b)
#pragma unroll
                        for (int m = 0; m < 4; ++m)
#pragma unroll
                            for (int n = 0; n < 2; ++n)
                                __builtin_amdgcn_raw_buffer_store_b128(__builtin_bit_cast(u32x4, acc[a][b][m][n]), prs, ((((a * 2 + b) * 4 + m) * 2 + n) * 512 + tid) * 16, pofs, 16);
                asm volatile("s_waitcnt vmcnt(0)" ::: "memory");
                PG8_BAR;
                if (tid == 0) { const unsigned old = __hip_atomic_fetch_add(S.pcnt + cur.tix, 1u, __ATOMIC_RELAXED, __HIP_MEMORY_SCOPE_AGENT);
                    if (old == (unsigned)(cur.sp - 1)) __builtin_amdgcn_fence(__ATOMIC_ACQUIRE, "agent");
                    *(volatile PG8_LAS unsigned*)S.lflag = old; }
                asm volatile("s_waitcnt vmcnt(0) lgkmcnt(0)" ::: "memory");
                PG8_BAR;
                const unsigned arrived = *(volatile PG8_LAS unsigned*)S.lflag;
                run_epi = (arrived == (unsigned)(cur.sp - 1));
                if (run_epi) {
                    const int tofs = __builtin_amdgcn_readfirstlane(cur.tix * cur.sp * 262144);
#pragma unroll
                    for (int a = 0; a < 2; ++a)
#pragma unroll
                        for (int b = 0; b < 2; ++b)
#pragma unroll
                            for (int m = 0; m < 4; ++m)
#pragma unroll
                                for (int n = 0; n < 2; ++n)
                                    acc[a][b][m][n] = __builtin_bit_cast(f32x4, __builtin_amdgcn_raw_buffer_load_b128(prs, ((((a * 2 + b) * 4 + m) * 2 + n) * 512 + tid) * 16, tofs, 16));
                    for (int pp = 1; pp < cur.sp; ++pp) { const int qofs = __builtin_amdgcn_readfirstlane(tofs + pp * 262144);
#pragma unroll
                        for (int a = 0; a < 2; ++a)
#pragma unroll
                            for (int b = 0; b < 2; ++b) {
                                f32x4 tp[4][2];
#pragma unroll
                                for (int m = 0; m < 4; ++m)
#pragma unroll
                                    for (int n = 0; n < 2; ++n) tp[m][n] = __builtin_bit_cast(f32x4, __builtin_amdgcn_raw_buffer_load_b128(prs, ((((a * 2 + b) * 4 + m) * 2 + n) * 512 + tid) * 16, qofs, 16));
#pragma unroll
                                for (int m = 0; m < 4; ++m)
#pragma unroll
                                    for (int n = 0; n < 2; ++n) acc[a][b][m][n] += tp[m][n];
                                __builtin_amdgcn_sched_barrier(0); } }
                }
            }
        }
        if constexpr (!Epi::AFTER_DRAIN) { if (run_epi) E(acc, cur, wr, wc, fr, fq); S.done(cur); }
        if (!has_next) break;
#pragma unroll
        for (int a = 0; a < 2; ++a)
#pragma unroll
            for (int b = 0; b < 2; ++b)
#pragma unroll
                for (int m = 0; m < 4; ++m)
#pragma unroll
                    for (int n = 0; n < 2; ++n) acc[a][b][m][n] = (f32x4){0.f, 0.f, 0.f, 0.f};
        cur = nxt; cA = nA; cB = nB; ++ui;
        if constexpr (ALIGN_EPI) { if (wr == 1) PG8_BAR; }
    }
    PG8_WAIT_V(0);
    if constexpr (!ALIGN_EPI) { if (wr == 0) PG8_BAR; }
    PG8_BAR;
#undef PG8_SA
#undef PG8_SB
#undef PG8_STAGE
#undef PG8_LDA
#undef PG8_LDB
#undef PG8_MMA
#undef PG8_WAIT_V
#undef PG8_WAIT_L
#undef PG8_BAR
#undef PG8_SCHED
}
}

constexpr int NWAVES = 8;
constexpr int NB = 8, SEQ = 2048, D = 2048, M = NB * SEQ, DIN = 6144, DG = 1024, DH = 1024, FF = 5632, GU = 2 * FF, NE = 8;
constexpr int MOE_ROWS = 2 * M + NE * 256;
constexpr float EPS = 1e-6f, F_MIN = 1e-6f;

constexpr size_t MiB = 1u << 20;
constexpr size_t WS_CTL = 0, CTL_ZERO_BYTES = 1 * MiB;
constexpr size_t WS_SMALL = 1 * MiB;
constexpr size_t SM_WC = 1 * MiB;
constexpr size_t SM_TOKE = 0, SM_TOKW = 131072, SM_TOKP = 262144, SM_WHIST = 393216, SM_TS = 524288;
constexpr size_t WS_WIN = 4 * MiB;
constexpr size_t WS_WO = WS_WIN + (size_t)2 * DIN * D * 2;
constexpr size_t WS_WGU = WS_WO + (size_t)2 * D * D * 2;
constexpr size_t WS_WD = WS_WGU + (size_t)GU * D * 2;
constexpr size_t WS_EGU = WS_WD + (size_t)D * FF * 2;
constexpr size_t WS_ED = WS_EGU + (size_t)NE * GU * D * 2;
constexpr size_t WS_XN = WS_ED + (size_t)NE * D * FF * 2;
constexpr size_t WS_R = WS_XN + (size_t)M * D * 2;
constexpr size_t WS_Z = WS_R;
constexpr size_t WS_Y = WS_Z + (size_t)M * DIN * 2;
constexpr size_t WS_O = WS_Y + (size_t)M * D * 2;
constexpr size_t WS_H = WS_R;
constexpr size_t WS_XS = WS_R + (size_t)MOE_ROWS * FF * 2;
constexpr size_t WS_XS8 = WS_XS + (size_t)MOE_ROWS * D * 2;
constexpr size_t WS_END = WS_XS8 + (size_t)MOE_ROWS * D;
static_assert(WS_O + (size_t)M * DH * 4 <= WS_XS, "O inside region R");
static_assert(WS_WIN % 256 == 0 && WS_XN % 256 == 0 && WS_R % 256 == 0 && WS_XS % 256 == 0, "alignment");

constexpr int CW_BAR = 4096;

constexpr int RING_OFF = 0, RING_BYTES = 131072;
constexpr int LDSCTL_OFF = 135168, MISC_OFF = LDSCTL_OFF + 320;
constexpr int LDS_BYTES = 147456;

#define GAS __attribute__((address_space(1)))
#define LAS __attribute__((address_space(3)))
typedef unsigned short bf16;
typedef unsigned v4u __attribute__((ext_vector_type(4)));
typedef unsigned v2u __attribute__((ext_vector_type(2)));
typedef float f32x4 __attribute__((ext_vector_type(4)));
typedef float f32x2 __attribute__((ext_vector_type(2)));
typedef int i32x4 __attribute__((ext_vector_type(4)));
typedef int i32x2 __attribute__((ext_vector_type(2)));
#define LDS_WAIT() asm volatile("s_waitcnt lgkmcnt(0)" ::: "memory")
#define VM_WAIT() asm volatile("s_waitcnt vmcnt(0)" ::: "memory")
__device__ __forceinline__ unsigned f2bf(float f) { return (unsigned)__builtin_bit_cast(unsigned short, (__bf16)f); }
__device__ __forceinline__ unsigned pk2(float lo, float hi) { return pg8::cvt_pk_bf16(lo, hi); }
__device__ __forceinline__ float bflo(unsigned p) { return __builtin_bit_cast(float, p << 16); }
__device__ __forceinline__ float bfhi(unsigned p) { return __builtin_bit_cast(float, p & 0xffff0000u); }
__device__ __forceinline__ float sigmoid_f(float x) { return 1.0f / (1.0f + __expf(-x)); }
__device__ __forceinline__ float silu_x(float x) { return x / (1.0f + __expf(-x)); }
__device__ __forceinline__ float gelu_tanh(float x) { const float u = 0.7978845608028654f * (x + 0.044715f * x * x * x); return x / (1.0f + __expf(-2.0f * u)); }
template <int CTRL, int ROW_MASK> __device__ __forceinline__ float dpp_f(float v) { return __builtin_bit_cast(float, __builtin_amdgcn_update_dpp(0, __builtin_bit_cast(int, v), CTRL, ROW_MASK, 0xF, false)); }
__device__ __forceinline__ float row16_sum(float v) {
    v += dpp_f<0xB1, 0xF>(v);
    v += dpp_f<0x4E, 0xF>(v);
    v += dpp_f<0x141, 0xF>(v);
    v += dpp_f<0x140, 0xF>(v);
    return v;
}
__device__ __forceinline__ float wave_sum(float v) {
    v = row16_sum(v);
    v += dpp_f<0x142, 0xA>(v);
    v += dpp_f<0x143, 0xC>(v);
    return __builtin_bit_cast(float, __builtin_amdgcn_readlane(__builtin_bit_cast(int, v), 63));
}
__device__ __forceinline__ int wave_sum_i(int v) {
#pragma unroll
    for (int o = 1; o < 64; o <<= 1) v += __shfl_xor(v, o);
    return v;
}

#define XB_TMO      128
#define XB_XCNT(j)  (256  + 64 * (j))
#define XB_XSUB(j)  (1280 + 64 * (j))
#define XB_XGEN(j)  (2304 + 64 * (j))
#define XB_TOP      3328
#define XB_TOPGEN   3392
#define XCD_BAR_WORDS 3456
#define XB_SPIN_CAP (1u << 22)
__device__ __forceinline__ unsigned xb_ld(unsigned* p)              { return __hip_atomic_load(p, __ATOMIC_RELAXED, __HIP_MEMORY_SCOPE_AGENT); }
__device__ __forceinline__ unsigned xb_add(unsigned* p, unsigned v) { return __hip_atomic_fetch_add(p, v, __ATOMIC_RELAXED, __HIP_MEMORY_SCOPE_AGENT); }
__device__ __forceinline__ unsigned xb_xcc_id() { return (unsigned)__builtin_amdgcn_s_getreg((3 << 11) | 20) & 0xFu; }
#define XB_SPIN(cond, bar) do { unsigned _sp = 0; while (cond) { __builtin_amdgcn_s_sleep(1); \
    if ((++_sp & 255u) == 0u) { if (xb_ld(&(bar)[XB_TMO])) break; if (_sp > XB_SPIN_CAP) { atomicAdd(&(bar)[XB_TMO], 1u); break; } } } } while (0)
struct XcdBarrier { unsigned* bar; unsigned x; volatile LAS unsigned* st; };
__device__ __forceinline__ XcdBarrier xcd_barrier_post(unsigned* bar, volatile LAS unsigned* st) {
    XcdBarrier b; b.bar = bar; b.x = xb_xcc_id(); b.st = st;
    if (threadIdx.x == 0) (void)xb_add(&bar[XB_XCNT(b.x)], 1u);
    return b;
}
__device__ __forceinline__ void xcd_barrier_complete(unsigned* bar, unsigned x, unsigned& nloc, unsigned& nx) {
    const unsigned G = gridDim.x * gridDim.y * gridDim.z;
    unsigned sum, cnt, mine, sp = 0u;
    for (;;) {
        sum = 0u; cnt = 0u; mine = 0u;
#pragma unroll
        for (unsigned j = 0; j < 16; ++j) { const unsigned c = xb_ld(&bar[XB_XCNT(j)]); sum += c; cnt += (c > 0u) ? 1u : 0u; mine = (j == x) ? c : mine; }
        if (sum == G) break;
        __builtin_amdgcn_s_sleep(1);
        if ((++sp & 255u) == 0u) { if (xb_ld(&bar[XB_TMO])) break; if (sp > XB_SPIN_CAP) { atomicAdd(&bar[XB_TMO], 1u); break; } }
    }
    nloc = mine > 0u ? mine : 1u; nx = cnt > 0u ? cnt : 1u;
}
__device__ __forceinline__ void xcd_barrier(const XcdBarrier& b) {
    asm volatile("s_waitcnt vmcnt(0)" ::: "memory");
    __syncthreads();
    if (threadIdx.x == 0) {
        unsigned* bar = b.bar;
        __builtin_amdgcn_s_waitcnt(0);
        unsigned nloc = b.st[0], nx = b.st[1];
        if (nloc == 0u) { xcd_barrier_complete(bar, b.x, nloc, nx); b.st[0] = nloc; b.st[1] = nx; }
        const unsigned old = xb_add(&bar[XB_XSUB(b.x)], 1u);
        const unsigned gen = old / nloc;
        if (old + 1u == (gen + 1u) * nloc) {
            __builtin_amdgcn_fence(__ATOMIC_RELEASE, "agent");
            asm volatile("s_waitcnt vmcnt(0)" ::: "memory");
            const unsigned og = xb_add(&bar[XB_TOP], 1u);
            const unsigned tg = og / nx;
            if (og + 1u == (tg + 1u) * nx) xb_add(&bar[XB_TOPGEN], 1u);
            else XB_SPIN(xb_ld(&bar[XB_TOPGEN]) == tg, bar);
            __builtin_amdgcn_fence(__ATOMIC_ACQUIRE, "agent");
            xb_add(&bar[XB_XGEN(b.x)], 1u);
            asm volatile("s_waitcnt vmcnt(0)" ::: "memory");
        } else {
            XB_SPIN(xb_ld(&bar[XB_XGEN(b.x)]) == gen, bar);
            __builtin_amdgcn_fence(__ATOMIC_ACQUIRE, "agent");
            asm volatile("s_waitcnt vmcnt(0)" ::: "memory");
        }
    }
    __syncthreads();
}

struct Frame {
    LAS unsigned char* lds;
    int tid, lane, wave, G, gw, NGW;
    unsigned char* ws;
};

__device__ __forceinline__ void transpose_item(const float* W, int K, int N, bf16* WT, int mode, LAS float* scr, int item, int lane) {
    const int nblk = N / 32, kb = item / nblk, nb = item % nblk, k0 = 64 * kb, n0 = 32 * nb;
    const int kr = lane >> 3, nc = lane & 7;
    f32x4 v[8];
#pragma unroll
    for (int i = 0; i < 8; ++i) v[i] = *(const f32x4*)(W + (size_t)(k0 + 8 * i + kr) * N + n0 + 4 * nc);
#pragma unroll
    for (int i = 0; i < 8; ++i) { LAS float* d = scr + (8 * i + kr) * 33 + 4 * nc; d[0] = v[i].x; d[1] = v[i].y; d[2] = v[i].z; d[3] = v[i].w; }
    LDS_WAIT(); asm volatile("" ::: "memory");
    const int c = lane & 7;
    const int rbase = (mode == 0) ? n0 : (256 * (n0 >> 7) + (n0 & 127) + (mode == 2 ? 128 : 0));
#pragma unroll
    for (int j = 0; j < 4; ++j) { const int n = (lane >> 3) + 8 * j; const LAS float* s = scr + (8 * c) * 33 + n;
        v4u o; o.x = pk2(s[0 * 33], s[1 * 33]); o.y = pk2(s[2 * 33], s[3 * 33]); o.z = pk2(s[4 * 33], s[5 * 33]); o.w = pk2(s[6 * 33], s[7 * 33]);
        *(v4u*)(WT + (size_t)(rbase + n) * K + k0 + 8 * c) = o; }
    LDS_WAIT(); asm volatile("" ::: "memory");
}
__device__ __forceinline__ void conv_matrix(Frame& F, const float* W, int K, int N, bf16* WT, int mode) {
    LAS float* scr = (LAS float*)(F.lds + RING_OFF + F.wave * 16384);
    const int nitems = (K / 64) * (N / 32);
    for (int it = F.gw; it < nitems; it += F.NGW) transpose_item(W, K, N, WT, mode, scr, it, F.lane);
}
__device__ __forceinline__ void transpose_item8(const float* W, int K, int N, unsigned char* WT, int mode, float scale, LAS float* scr, int item, int lane) {
    const int nblk = N / 32, kb = item / nblk, nb = item % nblk, k0 = 64 * kb, n0 = 32 * nb;
    const int kr = lane >> 3, nc = lane & 7;
    f32x4 v[8];
#pragma unroll
    for (int i = 0; i < 8; ++i) v[i] = *(const f32x4*)(W + (size_t)(k0 + 8 * i + kr) * N + n0 + 4 * nc);
#pragma unroll
    for (int i = 0; i < 8; ++i) { LAS float* d = scr + (8 * i + kr) * 33 + 4 * nc; d[0] = v[i].x; d[1] = v[i].y; d[2] = v[i].z; d[3] = v[i].w; }
    LDS_WAIT(); asm volatile("" ::: "memory");
    const int c = lane & 7;
    const int rbase = (mode == 0) ? n0 : (256 * (n0 >> 7) + (n0 & 127) + (mode == 2 ? 128 : 0));
#pragma unroll
    for (int j = 0; j < 4; ++j) { const int n = (lane >> 3) + 8 * j; const LAS float* s = scr + (8 * c) * 33 + n;
        v2u o; o.x = pg8::pk4_fp8(s[0 * 33] * scale, s[1 * 33] * scale, s[2 * 33] * scale, s[3 * 33] * scale); o.y = pg8::pk4_fp8(s[4 * 33] * scale, s[5 * 33] * scale, s[6 * 33] * scale, s[7 * 33] * scale);
        *(v2u*)(WT + (size_t)(rbase + n) * K + k0 + 8 * c) = o; }
    LDS_WAIT(); asm volatile("" ::: "memory");
}
constexpr int CONV_CH = 8, CW_CONV = 8192;
static_assert(((D / 64) * (DIN / 32)) % CONV_CH == 0 && ((D / 64) * (D / 32)) % CONV_CH == 0 && ((D / 64) * (FF / 32)) % CONV_CH == 0 && ((FF / 64) * (D / 32)) % CONV_CH == 0, "conversion chunks must be whole");
constexpr int CW_SK = 16384, CW_GMLP = 24576, NGF = 64;
__device__ __forceinline__ void conv_load(const float* W, int N, int item, int lane, f32x4 (&v)[8]) {
    const int nblk = N / 32, kb = item / nblk, nb = item % nblk, k0 = 64 * kb, n0 = 32 * nb, kr = lane >> 3, nc = lane & 7;
#pragma unroll
    for (int i = 0; i < 8; ++i) v[i] = *(const f32x4*)(W + (size_t)(k0 + 8 * i + kr) * N + n0 + 4 * nc);
}
__device__ __forceinline__ void conv_proc(int K, int N, void* WT, int mode, float scale8, LAS float* scr, int item, int lane, const f32x4 (&v)[8]) {
    const int nblk = N / 32, kb = item / nblk, nb = item % nblk, k0 = 64 * kb, n0 = 32 * nb, kr = lane >> 3, nc = lane & 7;
#pragma unroll
    for (int i = 0; i < 8; ++i) { LAS float* d = scr + (8 * i + kr) * 33 + 4 * nc; d[0] = v[i].x; d[1] = v[i].y; d[2] = v[i].z; d[3] = v[i].w; }
    LDS_WAIT(); asm volatile("" ::: "memory");
    const int c = lane & 7;
    const int rbase = (mode == 0) ? n0 : (256 * (n0 >> 7) + (n0 & 127) + (mode == 2 ? 128 : 0));
#pragma unroll
    for (int j = 0; j < 4; ++j) { const int n = (lane >> 3) + 8 * j; const LAS float* s = scr + (8 * c) * 33 + n;
        if (scale8 != 0.f) { v2u o; o.x = pg8::pk4_fp8(s[0 * 33] * scale8, s[1 * 33] * scale8, s[2 * 33] * scale8, s[3 * 33] * scale8); o.y = pg8::pk4_fp8(s[4 * 33] * scale8, s[5 * 33] * scale8, s[6 * 33] * scale8, s[7 * 33] * scale8);
            *(v2u*)((unsigned char*)WT + (size_t)(rbase + n) * K + k0 + 8 * c) = o; }
        else { v4u o; o.x = pk2(s[0 * 33], s[1 * 33]); o.y = pk2(s[2 * 33], s[3 * 33]); o.z = pk2(s[4 * 33], s[5 * 33]); o.w = pk2(s[6 * 33], s[7 * 33]);
            *(v4u*)((bf16*)WT + (size_t)(rbase + n) * K + k0 + 8 * c) = o; } }
    LDS_WAIT(); asm volatile("" ::: "memory");
}
__device__ __forceinline__ void conv_queue(Frame& F, int job, const float* W, int K, int N, void* WT, int mode, float scale8 = 0.f) {
    LAS float* scr = (LAS float*)(F.lds + RING_OFF + F.wave * 16384);
    unsigned* ctr = (unsigned*)(F.ws + WS_CTL) + CW_CONV + 64 * job;
    const int nitems = (K / 64) * (N / 32), nch = nitems / CONV_CH;
    for (;;) {
        unsigned c = 0; if (F.lane == 0) c = __hip_atomic_fetch_add(ctr, 1u, __ATOMIC_RELAXED, __HIP_MEMORY_SCOPE_AGENT);
        c = __builtin_amdgcn_readfirstlane(c);
        if ((int)c >= nch) break;
        const int i0 = (int)c * CONV_CH, ilast = i0 + CONV_CH - 1;
        f32x4 va[8], vb[8];
        conv_load(W, N, i0, F.lane, va);
#pragma unroll 1
        for (int it = i0; it < i0 + CONV_CH; it += 2) {
            conv_load(W, N, it + 1, F.lane, vb);
            conv_proc(K, N, WT, mode, scale8, scr, it, F.lane, va);
            conv_load(W, N, it + 2 < ilast ? it + 2 : ilast, F.lane, va);
            conv_proc(K, N, WT, mode, scale8, scr, it + 1, F.lane, vb);
        }
    }
}

__device__ __forceinline__ void norm_row(const float* xrow, const float* gain, int lane, f32x4 (&v)[8]) {
    const f32x4* xr = (const f32x4*)xrow + lane; float s = 0.f;
#pragma unroll
    for (int j = 0; j < 8; ++j) { v[j] = xr[64 * j]; s += (v[j].x * v[j].x + v[j].y * v[j].y) + (v[j].z * v[j].z + v[j].w * v[j].w); }
    const float rstd = 1.0f / sqrtf(wave_sum(s) * (1.0f / D) + EPS);
    const f32x4* gr = (const f32x4*)gain + lane;
#pragma unroll
    for (int j = 0; j < 8; ++j) v[j] = v[j] * rstd * gr[64 * j];
}
__device__ __forceinline__ void store_row_bf16(bf16* orow, int lane, const f32x4 (&v)[8]) {
    v2u* o8 = (v2u*)orow + lane;
#pragma unroll
    for (int j = 0; j < 8; ++j) { v2u w; w.x = pk2(v[j].x, v[j].y); w.y = pk2(v[j].z, v[j].w); o8[64 * j] = w; }
}


__device__ __forceinline__ void norm_row_b(const bf16* xrow, const float* gain, int lane, f32x4 (&v)[8]) {
    const v4u* xr = (const v4u*)xrow + lane; float s = 0.f;
#pragma unroll
    for (int j = 0; j < 4; ++j) { const v4u t = xr[64 * j]; v[2 * j] = (f32x4){bflo(t.x), bfhi(t.x), bflo(t.y), bfhi(t.y)}; v[2 * j + 1] = (f32x4){bflo(t.z), bfhi(t.z), bflo(t.w), bfhi(t.w)}; }
#pragma unroll
    for (int j = 0; j < 8; ++j) s += (v[j].x * v[j].x + v[j].y * v[j].y) + (v[j].z * v[j].z + v[j].w * v[j].w);
    const float rstd = 1.0f / sqrtf(wave_sum(s) * (1.0f / D) + EPS);
    const f32x4* gr = (const f32x4*)gain + 2 * lane;
#pragma unroll
    for (int j = 0; j < 4; ++j) { v[2 * j] = v[2 * j] * rstd * gr[128 * j]; v[2 * j + 1] = v[2 * j + 1] * rstd * gr[128 * j + 1]; }
}
__device__ __forceinline__ void load_raw_b(const bf16* xrow, int lane, v4u (&t)[4]) { const v4u* xr = (const v4u*)xrow + lane;
#pragma unroll
    for (int j = 0; j < 4; ++j) t[j] = xr[64 * j]; }
__device__ __forceinline__ void load_gain_b(const float* gain, int lane, f32x4 (&g)[8]) { const f32x4* gr = (const f32x4*)gain + 2 * lane;
#pragma unroll
    for (int j = 0; j < 4; ++j) { g[2 * j] = gr[128 * j]; g[2 * j + 1] = gr[128 * j + 1]; } }
__device__ __forceinline__ void norm_raw_b(const v4u (&t)[4], const f32x4 (&g)[8], f32x4 (&v)[8]) {
    float s = 0.f;
#pragma unroll
    for (int j = 0; j < 4; ++j) { v[2 * j] = (f32x4){bflo(t[j].x), bfhi(t[j].x), bflo(t[j].y), bfhi(t[j].y)}; v[2 * j + 1] = (f32x4){bflo(t[j].z), bfhi(t[j].z), bflo(t[j].w), bfhi(t[j].w)}; }
#pragma unroll
    for (int j = 0; j < 8; ++j) s += (v[j].x * v[j].x + v[j].y * v[j].y) + (v[j].z * v[j].z + v[j].w * v[j].w);
    const float rstd = 1.0f / sqrtf(wave_sum(s) * (1.0f / D) + EPS);
#pragma unroll
    for (int j = 0; j < 8; ++j) v[j] = v[j] * rstd * g[j];
}
__device__ __forceinline__ void load_raw_f(const float* xrow, int lane, f32x4 (&t)[8]) { const f32x4* xr = (const f32x4*)xrow + lane;
#pragma unroll
    for (int j = 0; j < 8; ++j) t[j] = xr[64 * j]; }
__device__ __forceinline__ void norm_raw_f(const f32x4 (&t)[8], const f32x4 (&g)[8], f32x4 (&v)[8]) {
    float s = 0.f;
#pragma unroll
    for (int j = 0; j < 8; ++j) s += (t[j].x * t[j].x + t[j].y * t[j].y) + (t[j].z * t[j].z + t[j].w * t[j].w);
    const float rstd = 1.0f / sqrtf(wave_sum(s) * (1.0f / D) + EPS);
#pragma unroll
    for (int j = 0; j < 8; ++j) v[j] = t[j] * rstd * g[j];
}
__device__ __forceinline__ void store_row_bf16_b(bf16* orow, int lane, const f32x4 (&v)[8]) {
    v4u* o = (v4u*)orow + lane;
#pragma unroll
    for (int j = 0; j < 4; ++j) { v4u w; w.x = pk2(v[2 * j].x, v[2 * j].y); w.y = pk2(v[2 * j].z, v[2 * j].w); w.z = pk2(v[2 * j + 1].x, v[2 * j + 1].y); w.w = pk2(v[2 * j + 1].z, v[2 * j + 1].w); o[64 * j] = w; }
}

typedef short bf16x8v __attribute__((ext_vector_type(8)));
typedef short s16x4 __attribute__((ext_vector_type(4)));
constexpr int RS = 272;
__device__ __forceinline__ unsigned nat_base(unsigned lane) { return (lane & 15u) * RS + (lane >> 4) * 16u; }
__device__ __forceinline__ constexpr unsigned nat_off(unsigned rb, unsigned s) { return rb * 16u * RS + s * 64u; }
__device__ __forceinline__ unsigned tr_base(unsigned lane) { return (8u * (lane >> 4) + ((lane & 15u) >> 2)) * RS + (lane & 3u) * 8u; }
__device__ __forceinline__ constexpr unsigned tr_off(unsigned c, unsigned ks, unsigned t) { return (32u * ks + 4u * t) * RS + 32u * c; }
__device__ __forceinline__ bf16x8v tr_frag(LAS unsigned char* p, unsigned c, unsigned ks) {
    const s16x4 a = __builtin_amdgcn_ds_read_tr16_b64_v4i16((LAS s16x4*)(p + tr_off(c, ks, 0)));
    const s16x4 b = __builtin_amdgcn_ds_read_tr16_b64_v4i16((LAS s16x4*)(p + tr_off(c, ks, 1)));
    return __builtin_shufflevector(a, b, 0, 1, 2, 3, 4, 5, 6, 7);
}
__device__ __forceinline__ f32x4 mfma16(bf16x8v a, bf16x8v b, f32x4 c) { return __builtin_amdgcn_mfma_f32_16x16x32_bf16(a, b, c, 0, 0, 0); }
__device__ __forceinline__ f32x4 zero4() { f32x4 z = (f32x4){0.f, 0.f, 0.f, 0.f}; asm volatile("" : "+v"(z)); return z; }
__device__ __forceinline__ bf16x8v pack8(f32x4 a, f32x4 b) { v4u w; w.x = pg8::cvt_pk_bf16(a[0], a[1]); w.y = pg8::cvt_pk_bf16(a[2], a[3]); w.z = pg8::cvt_pk_bf16(b[0], b[1]); w.w = pg8::cvt_pk_bf16(b[2], b[3]); return __builtin_bit_cast(bf16x8v, w); }

__device__ __forceinline__ void gmlp_unit(Frame& F, const bf16* Z, bf16* Y, const bf16* Wc, const float* ln_w, const float* ln_b, const float* b_s, const float* out_w, int u) {
    const int h = u & 7, n = (u >> 3) & 15, b = u >> 7; const size_t row0 = (size_t)b * SEQ + n * 128;
    LAS unsigned char* VT = F.lds; LAS unsigned char* WT = F.lds + 128 * RS;
    const int lane = F.lane, w = F.wave, g = lane >> 4, lr = lane & 15;
    {
        const f32x2 lw = ((const f32x2*)(ln_w + h * 128))[lane], lb = ((const f32x2*)(ln_b + h * 128))[lane];
        unsigned pk[16];
#pragma unroll
        for (int i = 0; i < 16; ++i) pk[i] = ((const unsigned*)(Z + (row0 + 16 * w + i) * DIN + DG + h * 128))[lane];
#pragma unroll
        for (int i = 0; i < 16; ++i) { const pg8::f32x2c gv2 = pg8::gelu_2((pg8::f32x2c){bflo(pk[i]), bfhi(pk[i])}); const float a = gv2.x, c = gv2.y;
            const float mu = wave_sum(a + c) * (1.0f / 128.0f); const float da = a - mu, dc = c - mu;
            const float var = wave_sum(da * da + dc * dc) * (1.0f / 128.0f); const float rs = 1.0f / sqrtf(var + EPS);
            *(LAS unsigned*)(VT + (16 * w + i) * RS + lane * 4) = pk2(da * rs * lw.x + lb.x, dc * rs * lw.y + lb.y); }
        v4u wt4[4];
#pragma unroll
        for (int i = 0; i < 4; ++i) { const int nn = F.tid + 512 * i, row = nn >> 4, ch = nn & 15; wt4[i] = *(const v4u*)(Wc + (size_t)h * 16384 + row * 128 + ch * 8); }
#pragma unroll
        for (int i = 0; i < 4; ++i) { const int nn = F.tid + 512 * i, row = nn >> 4, ch = nn & 15; *(LAS v4u*)(WT + row * RS + ch * 16) = wt4[i]; }
    }
    __syncthreads();
    f32x4 acc[8];
#pragma unroll
    for (int ct = 0; ct < 8; ++ct) acc[ct] = zero4();
    LAS unsigned char* vtr = VT + tr_base(lane); LAS unsigned char* wnb = WT + nat_base(lane) + w * 16 * RS;
#pragma unroll
    for (int ks = 0; ks < 4; ++ks) {
        const bf16x8v Bf = *(const LAS bf16x8v*)(wnb + nat_off(0, ks));
#pragma unroll
        for (int ct = 0; ct < 8; ++ct) { const bf16x8v Af = tr_frag(vtr, ct, ks); acc[ct] = mfma16(Af, Bf, acc[ct]); }
    }
    const int t = 16 * w + lr; const size_t row = row0 + t; const float bs = b_s[h * 128 + t];
    float ss = 0.f;
#pragma unroll
    for (int ct = 0; ct < 8; ++ct) { const v2u up = *(const v2u*)(Z + row * DIN + h * 128 + 16 * ct + 4 * g);
        const pg8::f32x2c ua = pg8::gelu_2((pg8::f32x2c){bflo(up.x), bfhi(up.x)}), ub = pg8::gelu_2((pg8::f32x2c){bflo(up.y), bfhi(up.y)});
        f32x4 y; y[0] = ua.x * (acc[ct][0] + bs); y[1] = ua.y * (acc[ct][1] + bs); y[2] = ub.x * (acc[ct][2] + bs); y[3] = ub.y * (acc[ct][3] + bs);
        acc[ct] = y; ss += (y[0] * y[0] + y[1] * y[1]) + (y[2] * y[2] + y[3] * y[3]); }
    f32x4 ow[8];
#pragma unroll
    for (int ct = 0; ct < 8; ++ct) ow[ct] = *(const f32x4*)(out_w + h * 128 + 16 * ct + 4 * g);
    ss += __shfl_xor(ss, 16); ss += __shfl_xor(ss, 32);
    const float rs = __builtin_amdgcn_rsqf(ss * (1.0f / 128.0f) + EPS);
#pragma unroll
    for (int ct = 0; ct < 8; ++ct) { v2u o;
        o.x = pk2(acc[ct][0] * rs * ow[ct][0], acc[ct][1] * rs * ow[ct][1]); o.y = pk2(acc[ct][2] * rs * ow[ct][2], acc[ct][3] * rs * ow[ct][3]);
        *(v2u*)(Y + row * D + h * 128 + 16 * ct + 4 * g) = o; }
    __syncthreads();
}

__device__ __forceinline__ void hgrn_item(Frame& F, const bf16* Z, bf16* Y, const float* out_w, int b, int h) {
    LAS unsigned char* Lb = F.lds;
    constexpr int QT = 0, KT = 64 * RS, IT = 128 * RS, PT = 192 * RS, EMo = PT + 64 * 144, ELo = EMo + 512, ELMo = ELo + 512, SEGo = ELMo + 512, NSo = SEGo + 4096, OTo = NSo + 2048, OWo = OTo + 64 * RS;
    static_assert(OWo + 512 <= RING_BYTES, "hgrn LDS map");
    const int lane = F.lane, w = F.wave, g = lane >> 4, lr = lane & 15, dp = lane, seg = w;
    f32x4 Sacc[8];
#pragma unroll
    for (int i = 0; i < 8; ++i) Sacc[i] = zero4();
    LAS unsigned char* q_nat = Lb + QT + nat_base(lane); LAS unsigned char* k_nat = Lb + KT + nat_base(lane);
    LAS unsigned char* k_tr = Lb + KT + tr_base(lane); LAS unsigned char* i_tr = Lb + IT + tr_base(lane);
    LAS unsigned char* p_rd = Lb + PT + lr * 144 + g * 16; LAS unsigned char* p_wr = Lb + PT + lr * 144 + g * 8;
    LAS unsigned char* q_in = Lb + QT + lr * RS + g * 8;
    unsigned rq[8], rg[8]; v4u ri[2];
    const __amdgpu_buffer_rsrc_t zrs = __builtin_amdgcn_make_buffer_rsrc((void*)Z, 0, (int)((size_t)M * DIN * 2), 0x00020000);
    const int vq = (2 * DG + h * 128 + 2 * dp) * 2;
    int vi[2];
#pragma unroll
    for (int i = 0; i < 2; ++i) { const int nn = F.tid + 512 * i, row = nn >> 4, ch = nn & 15; vi[i] = row * (DIN * 2) + (2 * DG + 2 * DH + h * 128 + ch * 8) * 2; }
#define HGRN_LOAD_G(cc) do { const int _s0 = __builtin_amdgcn_readfirstlane((int)(((size_t)b * SEQ + (size_t)(cc) * 64) * (DIN * 2))); \
        _Pragma("unroll") for (int r = 0; r < 8; ++r) rg[r] = (unsigned)__builtin_amdgcn_raw_buffer_load_b32(zrs, vq + DH * 2, _s0 + (8 * seg + r) * (DIN * 2), 0); } while (0)
#define HGRN_LOAD_Q(cc) do { const int _s0 = __builtin_amdgcn_readfirstlane((int)(((size_t)b * SEQ + (size_t)(cc) * 64) * (DIN * 2))); \
        _Pragma("unroll") for (int r = 0; r < 8; ++r) rq[r] = (unsigned)__builtin_amdgcn_raw_buffer_load_b32(zrs, vq, _s0 + (8 * seg + r) * (DIN * 2), 0); } while (0)
    if (F.tid < 32) *(LAS f32x4*)(Lb + OWo + F.tid * 16) = *(const f32x4*)(out_w + h * 128 + F.tid * 4);
    HGRN_LOAD_G(0); HGRN_LOAD_Q(0);
#define HGRN_OUTPUT(cc) do { const size_t _r0 = (size_t)b * SEQ + (size_t)(cc) * 64; \
        _Pragma("unroll") for (int i = 0; i < 2; ++i) { const int nn = F.tid + 512 * i, t = nn >> 4, ch = nn & 15; \
            const f32x4 n0 = *(const LAS f32x4*)(Lb + NSo + t * 32), n1 = *(const LAS f32x4*)(Lb + NSo + t * 32 + 16); \
            const float ssum = ((n0[0] + n0[1]) + (n0[2] + n0[3])) + ((n1[0] + n1[1]) + (n1[2] + n1[3])); \
            const float rs = __builtin_amdgcn_rsqf(ssum * (1.0f / 128.0f) + EPS); \
            const v4u ov = *(const LAS v4u*)(Lb + OTo + t * RS + ch * 16); \
            const v4u gv = gvc[i]; \
            const f32x4 w0 = *(const LAS f32x4*)(Lb + OWo + ch * 32), w1 = *(const LAS f32x4*)(Lb + OWo + ch * 32 + 16); \
            v4u yv; \
            yv.x = pk2(bflo(ov.x) * rs * w0[0] * bflo(gv.x), bfhi(ov.x) * rs * w0[1] * bfhi(gv.x)); yv.y = pk2(bflo(ov.y) * rs * w0[2] * bflo(gv.y), bfhi(ov.y) * rs * w0[3] * bfhi(gv.y)); \
            yv.z = pk2(bflo(ov.z) * rs * w1[0] * bflo(gv.z), bfhi(ov.z) * rs * w1[1] * bfhi(gv.z)); yv.w = pk2(bflo(ov.w) * rs * w1[2] * bflo(gv.w), bfhi(ov.w) * rs * w1[3] * bfhi(gv.w)); \
            *(v4u*)(Y + (_r0 + t) * D + DG + h * 128 + ch * 8) = yv; } } while (0)
    v4u gvc[2];
    for (int c = 0; c < SEQ / 64; ++c) {
        const size_t r0 = (size_t)b * SEQ + c * 64;
        float pre0 = 0.f, pre1 = 0.f, mid0 = 0.f, mid1 = 0.f, tot0 = 0.f, tot1 = 0.f;
        {
            const int s0c = __builtin_amdgcn_readfirstlane((int)(r0 * (DIN * 2)));
            float s0 = 0.f, s1 = 0.f;
#pragma unroll
            for (int r = 0; r < 8; ++r) { s0 += bflo(rg[r]); s1 += bfhi(rg[r]); }
            *(LAS f32x2*)(Lb + SEGo + (seg * 128 + 2 * dp) * 4) = (f32x2){s0, s1};
#pragma unroll
            for (int i = 0; i < 2; ++i) ri[i] = __builtin_bit_cast(v4u, __builtin_amdgcn_raw_buffer_load_b128(zrs, vi[i], s0c, 0));
            __syncthreads();
            if (c > 0) HGRN_OUTPUT(c - 1);
#pragma unroll
            for (int i = 0; i < 2; ++i) gvc[i] = __builtin_bit_cast(v4u, __builtin_amdgcn_raw_buffer_load_b128(zrs, vi[i] + DH * 2, s0c, 0));
#pragma unroll
            for (int sg = 0; sg < 8; ++sg) { const f32x2 t = *(const LAS f32x2*)(Lb + SEGo + (sg * 128 + 2 * dp) * 4);
                if (sg < seg) { pre0 += t.x; pre1 += t.y; } if (sg < 4) { mid0 += t.x; mid1 += t.y; } tot0 += t.x; tot1 += t.y; }
            float aa0 = pre0, aa1 = pre1;
#pragma unroll
            for (int r = 0; r < 8; ++r) {
                const float g0 = bflo(rg[r]), g1 = bfhi(rg[r]); aa0 += g0; aa1 += g1;
                const float k0 = 1.0f - __expf(g0), k1 = 1.0f - __expf(g1);
                const float q0 = bflo(rq[r]) * __expf(aa0 - mid0), q1 = bfhi(rq[r]) * __expf(aa1 - mid1);
                const float kk0 = k0 * __expf(mid0 - aa0), kk1 = k1 * __expf(mid1 - aa1);
                const unsigned o = (8 * seg + r) * RS + dp * 4;
                *(LAS unsigned*)(Lb + QT + o) = pk2(q0, q1); *(LAS unsigned*)(Lb + KT + o) = pk2(kk0, kk1);
                if (r & 1) __builtin_amdgcn_sched_barrier(0);
            }
#pragma unroll
            for (int i = 0; i < 2; ++i) { const int nn = F.tid + 512 * i, row = nn >> 4, ch = nn & 15; *(LAS v4u*)(Lb + IT + row * RS + ch * 16) = ri[i]; }
            if (seg == 0) { *(LAS f32x2*)(Lb + EMo + 8 * dp) = (f32x2){__expf(mid0), __expf(mid1)}; *(LAS f32x2*)(Lb + ELo + 8 * dp) = (f32x2){__expf(tot0), __expf(tot1)};
                *(LAS f32x2*)(Lb + ELMo + 8 * dp) = (f32x2){__expf(tot0 - mid0), __expf(tot1 - mid1)}; }
            if (c + 1 < SEQ / 64) { HGRN_LOAD_G(c + 1); HGRN_LOAD_Q(c + 1); }
        }
        __syncthreads();
#pragma unroll
        for (int it = 0; it < 2; ++it) { const int idx = w + 8 * it, tt = idx >> 2, st = idx & 3;
            f32x4 d = zero4();
#pragma unroll
            for (int ks = 0; ks < 4; ++ks) { const bf16x8v Af = *(const LAS bf16x8v*)(k_nat + st * 16 * RS + nat_off(0, ks)); const bf16x8v Bf = *(const LAS bf16x8v*)(q_nat + tt * 16 * RS + nat_off(0, ks));
                d = mfma16(Af, Bf, d); }
            const int sdiff = 16 * (st - tt) + 4 * g - lr;
#pragma unroll
            for (int r = 0; r < 4; ++r) d[r] = (sdiff + r > 0) ? 0.f : d[r];
            v2u pk; pk.x = pk2(d[0], d[1]); pk.y = pk2(d[2], d[3]);
            *(LAS v2u*)(p_wr + tt * 16 * 144 + st * 32) = pk;
        }
        __syncthreads();
        bf16x8v If[2];
#pragma unroll
        for (int ks = 0; ks < 2; ++ks) If[ks] = tr_frag(i_tr + w * 32, 0, ks);
        f32x4 acc[4];
#pragma unroll
        for (int tt = 0; tt < 4; ++tt) acc[tt] = zero4();
#pragma unroll
        for (int tt = 0; tt < 4; ++tt)
#pragma unroll
            for (int ks = 0; ks < 2; ++ks) if (32 * ks <= 16 * tt + 15) { const bf16x8v Af = *(const LAS bf16x8v*)(p_rd + tt * 16 * 144 + ks * 64);
                acc[tt] = mfma16(Af, If[ks], acc[tt]); }
        __builtin_amdgcn_sched_barrier(0);
#pragma unroll
        for (int kk = 0; kk < 4; ++kk) {
            const f32x4 em0 = *(const LAS f32x4*)(Lb + EMo + (32 * kk + 4 * g) * 4), em1 = *(const LAS f32x4*)(Lb + EMo + (32 * kk + 16 + 4 * g) * 4);
            const bf16x8v Bf = pack8(Sacc[2 * kk] * em0, Sacc[2 * kk + 1] * em1);
#pragma unroll
            for (int tt = 0; tt < 4; ++tt) {
                const v2u x0 = *(const LAS v2u*)(q_in + tt * 16 * RS + kk * 64), x1 = *(const LAS v2u*)(q_in + tt * 16 * RS + kk * 64 + 32);
                v4u xa; xa.x = x0.x; xa.y = x0.y; xa.z = x1.x; xa.w = x1.y;
                acc[tt] = mfma16(__builtin_bit_cast(bf16x8v, xa), Bf, acc[tt]); }
            __builtin_amdgcn_sched_barrier(0);
        }
#pragma unroll
        for (int dt = 0; dt < 8; ++dt) { f32x4 La = zero4();
#pragma unroll
            for (int ks = 0; ks < 2; ++ks) { const bf16x8v Af = tr_frag(k_tr, dt, ks); La = mfma16(Af, If[ks], La); }
            const f32x4 el = *(const LAS f32x4*)(Lb + ELo + (16 * dt + 4 * g) * 4), elm = *(const LAS f32x4*)(Lb + ELMo + (16 * dt + 4 * g) * 4);
            Sacc[dt] = el * Sacc[dt] + elm * La;
            __builtin_amdgcn_sched_barrier(0); }
#pragma unroll
        for (int tt = 0; tt < 4; ++tt)
#pragma unroll
            for (int r = 0; r < 4; ++r) { const float p = row16_sum(acc[tt][r] * acc[tt][r]);
                if (lr == 0) *(LAS float*)(Lb + NSo + ((16 * tt + 4 * g + r) * 8 + w) * 4) = p;
                *(LAS unsigned short*)(Lb + OTo + (16 * tt + 4 * g + r) * RS + (16 * w + lr) * 2) = (unsigned short)f2bf(acc[tt][r]); }
    }
    __syncthreads();
    HGRN_OUTPUT(SEQ / 64 - 1);
#undef HGRN_LOAD_G
#undef HGRN_LOAD_Q
#undef HGRN_OUTPUT
    __syncthreads();
}

struct Args { const float* in[20]; float* out; unsigned char* ws; int ph_lo, ph_hi; };
constexpr int NPHASE = 17;

#define IN(k) (lo <= (k) && (k) < hi)
#define SEAM(k) do { if (IN(k) && IN((k) + 1)) xcd_barrier(bar); } while (0)
template <int l> __device__ __forceinline__ void layer_phases(Frame& F, const Args& args, const XcdBarrier& bar, const int lo, const int hi) {
    unsigned char* ws = F.ws; float* out = args.out;
    bf16* XN = (bf16*)(ws + WS_XN); bf16* Z = (bf16*)(ws + WS_Z); bf16* Y = (bf16*)(ws + WS_Y); float* O = (float*)(ws + WS_O); bf16* H = (bf16*)(ws + WS_H);
        const int pb = 1 + 7 * l;
        bf16* XR = (bf16*)(ws + WS_O);
        if (IN(pb + 0)) {
            f32x4 gn[8];
            if constexpr (l == 0) {
#pragma unroll
                for (int j = 0; j < 8; ++j) gn[j] = ((const f32x4*)args.in[1] + F.lane)[64 * j];
                f32x4 rc[8]; if (F.gw < M) load_raw_f(args.in[0] + (size_t)F.gw * D, F.lane, rc);
                for (int m = F.gw; m < M; m += F.NGW) { f32x4 rn[8], v[8];
#pragma unroll
                    for (int j = 0; j < 8; ++j) rn[j] = rc[j];
                    if (m + F.NGW < M) load_raw_f(args.in[0] + (size_t)(m + F.NGW) * D, F.lane, rn);
                    norm_raw_f(rc, gn, v); store_row_bf16(XN + (size_t)m * D, F.lane, v);
#pragma unroll
                    for (int j = 0; j < 8; ++j) rc[j] = rn[j]; }
            } else {
                load_gain_b(args.in[1] + l * D, F.lane, gn);
                v4u rc[4]; if (F.gw < M) load_raw_b(XR + (size_t)F.gw * D, F.lane, rc);
                for (int m = F.gw; m < M; m += F.NGW) { v4u rn[4]; f32x4 v[8];
#pragma unroll
                    for (int j = 0; j < 4; ++j) rn[j] = rc[j];
                    if (m + F.NGW < M) load_raw_b(XR + (size_t)(m + F.NGW) * D, F.lane, rn);
                    norm_raw_b(rc, gn, v); store_row_bf16_b(XN + (size_t)m * D, F.lane, v);
#pragma unroll
                    for (int j = 0; j < 4; ++j) rc[j] = rn[j]; }
            }
        }
        SEAM(pb + 0);
        if (IN(pb + 1)) {
            pg8::Gemm g{XN, (bf16*)(ws + WS_WIN) + (size_t)l * DIN * D, 2 * D}; pg8::StaticOrder S; S.init(M, DIN, F.G, (int)blockIdx.x);
            pg8::EpiZ E{Z, DIN, args.in[8], l};
            pg8::gemm_phase<pg8::EpiZ, pg8::StaticOrder, true, true>(F.lds + RING_OFF, g, S, E);
        }
        SEAM(pb + 1);
        if (IN(pb + 2)) for (int rep = 0; rep < REP_MIX; ++rep) {
            const int nh = (F.G >= 128) ? 64 : 0;
            if (nh == 0 || (int)blockIdx.x < nh) for (int it = blockIdx.x; it < NB * 8; it += (nh ? nh : F.G)) hgrn_item(F, Z, Y, args.in[9] + l * DH, it >> 3, it & 7);
        }
        auto gmlp_pull = [&]() {
            unsigned* gctr = (unsigned*)(ws + WS_CTL) + CW_GMLP + 64 * l; volatile LAS unsigned* gw = (volatile LAS unsigned*)(F.lds + MISC_OFF + 96);
            for (;;) {
                __syncthreads();
                if (F.tid == 0) *gw = __hip_atomic_fetch_add(gctr, 1u, __ATOMIC_RELAXED, __HIP_MEMORY_SCOPE_AGENT);
                __syncthreads();
                const int u = (int)*gw;
                if (u >= NB * 16 * 8) break;
                gmlp_unit(F, Z, Y, (const bf16*)(ws + WS_SMALL + SM_WC) + (size_t)l * 8 * 16384, args.in[5] + l * DG, args.in[6] + l * DG, args.in[4] + l * DG, args.in[7] + l * DG, u);
            }
        };
        if (IN(pb + 2)) { const int nh = (F.G >= 128) ? 64 : 0; if ((int)blockIdx.x >= nh && (int)blockIdx.x < nh + NGF) gmlp_pull(); }
        if (IN(pb + 2)) {
            bf16* WIN = (bf16*)(ws + WS_WIN); bf16* WO = (bf16*)(ws + WS_WO); bf16* WGU = (bf16*)(ws + WS_WGU); bf16* WD = (bf16*)(ws + WS_WD); bf16* EGU = (bf16*)(ws + WS_EGU); bf16* ED = (bf16*)(ws + WS_ED);
            if constexpr (l == 0) {
                conv_queue(F, 0, args.in[2] + (size_t)D * DIN, D, DIN, WIN + (size_t)DIN * D, 0); conv_queue(F, 1, args.in[10] + (size_t)D * D, D, D, WO + (size_t)D * D, 0);
                conv_queue(F, 2, args.in[12], D, FF, WGU, 1, (DENSE_F8 == 1 || DENSE_F8 == 3) ? pg8::F8_SW1 : 0.f); conv_queue(F, 3, args.in[13], D, FF, WGU, 2, (DENSE_F8 == 1 || DENSE_F8 == 3) ? pg8::F8_SW1 : 0.f); conv_queue(F, 4, args.in[14], FF, D, WD, 0, (DENSE_F8 == 1 || DENSE_F8 == 2) ? pg8::F8_SW2 : 0.f);
            }
            for (int e = (l == 0 ? 0 : 3); e < (l == 0 ? 3 : NE); ++e) {
                unsigned char* EGU8 = (unsigned char*)(ws + WS_EGU); unsigned char* ED8 = (unsigned char*)(ws + WS_ED);
                conv_queue(F, 8 + 3 * e, args.in[16] + (size_t)e * D * FF, D, FF, EGU8 + (size_t)e * GU * D, 1, pg8::F8_SW1); conv_queue(F, 9 + 3 * e, args.in[17] + (size_t)e * D * FF, D, FF, EGU8 + (size_t)e * GU * D, 2, pg8::F8_SW1);
                conv_queue(F, 10 + 3 * e, args.in[18] + (size_t)e * FF * D, FF, D, ED8 + (size_t)e * D * FF, 0, pg8::F8_SW2); }
            gmlp_pull();
        }
        SEAM(pb + 2);
        if (IN(pb + 3)) {
            pg8::Gemm g{Y, (bf16*)(ws + WS_WO) + (size_t)l * D * D, 2 * D}; pg8::StaticOrder S; S.init(M, D, F.G, (int)blockIdx.x);
            if constexpr (l == 0) { pg8::EpiResidB<true> E{args.in[0], XR, D, 1.0f}; pg8::gemm_phase<pg8::EpiResidB<true>, pg8::StaticOrder, true, true>(F.lds + RING_OFF, g, S, E); }
            else { pg8::EpiResidB<false> E{XR, XR, D, 1.0f}; pg8::gemm_phase<pg8::EpiResidB<false>, pg8::StaticOrder, true, true>(F.lds + RING_OFF, g, S, E); }
        }
        SEAM(pb + 3);
        if (IN(pb + 4)) {
            int hc[8];
#pragma unroll
            for (int e = 0; e < 8; ++e) hc[e] = 0;
            if constexpr (l == 1) {
                f32x4 rv8[8];
#pragma unroll
                for (int j = 0; j < 8; ++j) { const int c = F.tid + j * (NWAVES * 64), k = c >> 1, hh = c & 1; rv8[j] = *(const f32x4*)(args.in[15] + (size_t)k * 8 + 4 * hh); }
#pragma unroll
                for (int j = 0; j < 8; ++j) { const int c = F.tid + j * (NWAVES * 64), k = c >> 1, hh = c & 1;
                    *(LAS f32x4*)(F.lds + ((((k >> 9) * 8 + (k & 7)) * 2 + hh) << 10) + ((k >> 3) & 63) * 16) = rv8[j]; }
                __syncthreads();
            }
            f32x4 gn[8]; load_gain_b(args.in[11] + l * D, F.lane, gn);
            v4u rc[4]; if (F.gw < M) load_raw_b(XR + (size_t)F.gw * D, F.lane, rc);
            for (int m = F.gw; m < M; m += F.NGW) {
                v4u rn[4];
#pragma unroll
                for (int j = 0; j < 4; ++j) rn[j] = rc[j];
                if (m + F.NGW < M) load_raw_b(XR + (size_t)(m + F.NGW) * D, F.lane, rn);
                f32x4 v[8]; norm_raw_b(rc, gn, v);
#pragma unroll
                for (int j = 0; j < 4; ++j) rc[j] = rn[j];
                if constexpr (l == 0) {
                    if constexpr (DENSE_F8 == 3) { v2u* d8 = (v2u*)(ws + WS_XS8 + (size_t)m * D) + F.lane;
#pragma unroll
                        for (int j = 0; j < 4; ++j) { const f32x4 a0 = v[2 * j] * pg8::F8_SX, a1 = v[2 * j + 1] * pg8::F8_SX; v2u q; q.x = pg8::pk4_fp8(a0[0], a0[1], a0[2], a0[3]); q.y = pg8::pk4_fp8(a1[0], a1[1], a1[2], a1[3]); d8[64 * j] = q; } }
                    else store_row_bf16_b(XN + (size_t)m * D, F.lane, v); }
                if constexpr (l == 1) {
                    asm volatile("" ::: "memory");
                    float lg[8];
#pragma unroll
                    for (int e = 0; e < 8; ++e) lg[e] = 0.f;
#pragma unroll
                    for (int j = 0; j < 4; ++j)
#pragma unroll
                        for (int i = 0; i < 8; ++i) { const f32x4 r0 = *(const LAS f32x4*)(F.lds + (((j * 8 + i) * 2) << 10) + F.lane * 16), r1 = *(const LAS f32x4*)(F.lds + (((j * 8 + i) * 2 + 1) << 10) + F.lane * 16); const float hv = v[2 * j + (i >> 2)][i & 3];
                            lg[0] += hv * r0.x; lg[1] += hv * r0.y; lg[2] += hv * r0.z; lg[3] += hv * r0.w; lg[4] += hv * r1.x; lg[5] += hv * r1.y; lg[6] += hv * r1.z; lg[7] += hv * r1.w; }
#pragma unroll
                    for (int e = 0; e < 8; ++e) lg[e] = wave_sum(lg[e]);
                    int e0 = 0; float v0 = lg[0];
#pragma unroll
                    for (int e = 1; e < 8; ++e) if (lg[e] > v0) { v0 = lg[e]; e0 = e; }
                    int e1 = -1; float v1 = -3.0e38f;
#pragma unroll
                    for (int e = 0; e < 8; ++e) if (e != e0 && lg[e] > v1) { v1 = lg[e]; e1 = e; }
                    const float ex = __expf(v1 - v0), w0 = 1.0f / (1.0f + ex), w1 = ex / (1.0f + ex);
                    if (F.lane == 0) { *(i32x2*)(((int*)(ws + WS_SMALL + SM_TOKE)) + 2 * m) = (i32x2){e0, e1}; *(f32x2*)(((float*)(ws + WS_SMALL + SM_TOKW)) + 2 * m) = (f32x2){w0, w1}; }
#pragma unroll
                    for (int e = 0; e < 8; ++e) hc[e] += (e == e0 ? 1 : 0) + (e == e1 ? 1 : 0);
                }
            }
            if (l == 1 && F.lane == 0) { *(i32x4*)(((int*)(ws + WS_SMALL + SM_WHIST)) + 8 * F.gw) = (i32x4){hc[0], hc[1], hc[2], hc[3]}; *(i32x4*)(((int*)(ws + WS_SMALL + SM_WHIST)) + 8 * F.gw + 4) = (i32x4){hc[4], hc[5], hc[6], hc[7]}; }
        }
        SEAM(pb + 4);
        if constexpr (l == 0) {
            if (IN(6)) {
                pg8::StaticOrder S; S.init(M, GU, F.G, (int)blockIdx.x);
                if constexpr (DENSE_F8 == 1) { pg8::Gemm g{ws + WS_XS8, ws + WS_WGU, D}; pg8::EpiSwiglu8 E{(unsigned char*)H, FF, pg8::F8_INV1};
                    pg8::gemm_phase<pg8::EpiSwiglu8, pg8::StaticOrder, true, true, true>(F.lds + RING_OFF, g, S, E); }
                else if constexpr (DENSE_F8 == 2) { pg8::Gemm g{XN, (bf16*)(ws + WS_WGU), 2 * D}; pg8::EpiSwiglu8 E{(unsigned char*)H, FF, 1.0f};
                    pg8::gemm_phase<pg8::EpiSwiglu8, pg8::StaticOrder, true, true>(F.lds + RING_OFF, g, S, E); }
                else if constexpr (DENSE_F8 == 3) { pg8::Gemm g{ws + WS_XS8, ws + WS_WGU, D}; pg8::EpiSwiglu E{H, FF, pg8::F8_INV1};
                    pg8::gemm_phase<pg8::EpiSwiglu, pg8::StaticOrder, true, true, true>(F.lds + RING_OFF, g, S, E); }
                else { pg8::Gemm g{XN, (bf16*)(ws + WS_WGU), 2 * D}; pg8::EpiSwiglu E{H, FF, 1.0f};
                    pg8::gemm_phase<pg8::EpiSwiglu, pg8::StaticOrder, true, true>(F.lds + RING_OFF, g, S, E); }
            }
            SEAM(6);
            if (IN(7)) {
                pg8::StaticOrder S; S.init(M, D, F.G, (int)blockIdx.x);
                if constexpr (DENSE_F8 == 1 || DENSE_F8 == 2) { pg8::Gemm g{H, ws + WS_WD, FF}; pg8::EpiResidB<false> E{XR, XR, D, pg8::F8_INV2};
                    pg8::gemm_phase<pg8::EpiResidB<false>, pg8::StaticOrder, true, true, true>(F.lds + RING_OFF, g, S, E); }
                else { pg8::Gemm g{H, (bf16*)(ws + WS_WD), 2 * FF}; pg8::EpiResidB<false> E{XR, XR, D, 1.0f};
                    pg8::gemm_phase<pg8::EpiResidB<false>, pg8::StaticOrder, true, true>(F.lds + RING_OFF, g, S, E); }
            }
            SEAM(7);
        }
}

__global__ void __launch_bounds__(NWAVES * 64, 2) trunk_fwd(Args args) {
    extern __shared__ __attribute__((aligned(16))) unsigned char lds[];
    Frame F;
    F.lds = (LAS unsigned char*)lds;
    F.tid = threadIdx.x; F.lane = F.tid & 63; F.wave = __builtin_amdgcn_readfirstlane(F.tid >> 6);
    F.G = gridDim.x; F.gw = blockIdx.x * NWAVES + F.wave; F.NGW = F.G * NWAVES; F.ws = args.ws;
    unsigned char* ws = args.ws;
    for (int u = F.tid; u < (LDS_BYTES - LDSCTL_OFF) / 4; u += NWAVES * 64) ((LAS unsigned*)(F.lds + LDSCTL_OFF))[u] = 0u;
    __syncthreads();
    volatile LAS unsigned* MISC = (volatile LAS unsigned*)(F.lds + MISC_OFF);
    const int lo = args.ph_lo, hi = args.ph_hi;
    XcdBarrier bar; bar.bar = (unsigned*)(ws + WS_CTL) + CW_BAR; bar.x = 0; bar.st = nullptr;
    if (hi - lo > 1) bar = xcd_barrier_post((unsigned*)(ws + WS_CTL) + CW_BAR, MISC + 8);

    float* out = args.out;
    bf16* XN = (bf16*)(ws + WS_XN); bf16* H = (bf16*)(ws + WS_H); bf16* XS = (bf16*)(ws + WS_XS);
    int* TOKE = (int*)(ws + WS_SMALL + SM_TOKE); float* TOKW = (float*)(ws + WS_SMALL + SM_TOKW); int* TOKP = (int*)(ws + WS_SMALL + SM_TOKP);
    int* WHIST = (int*)(ws + WS_SMALL + SM_WHIST); int* MTS = (int*)(ws + WS_SMALL + SM_TS);

    if (IN(0)) for (int rep = 0; rep < REP_CONV; ++rep) {
        bf16* WIN = (bf16*)(ws + WS_WIN); bf16* WO = (bf16*)(ws + WS_WO); bf16* WGU = (bf16*)(ws + WS_WGU); bf16* WD = (bf16*)(ws + WS_WD);
        bf16* EGU = (bf16*)(ws + WS_EGU); bf16* ED = (bf16*)(ws + WS_ED);
        { bf16* WC = (bf16*)(ws + WS_SMALL + SM_WC); const float* wsp = args.in[3];
            for (int i = blockIdx.x * (NWAVES * 64) + F.tid; i < 8 * 16384; i += F.G * NWAVES * 64) { const int t = (i >> 6) & 127, sx = 2 * (i & 63); const f32x2 wv = *(const f32x2*)(wsp + 2 * i); ((unsigned*)WC)[i] = pk2(sx <= t ? wv.x : 0.f, sx + 1 <= t ? wv.y : 0.f); } }
        conv_matrix(F, args.in[2], D, DIN, WIN, 0); conv_matrix(F, args.in[10], D, D, WO, 0);
    }

    layer_phases<0>(F, args, bar, lo, hi);
    layer_phases<1>(F, args, bar, lo, hi);

    if (IN(13)) {
        int pre[8], tot[8];
#pragma unroll
        for (int e = 0; e < 8; ++e) { pre[e] = 0; tot[e] = 0; }
        for (int w = F.lane; w < F.NGW; w += 64) { const i32x4 a = *(const i32x4*)(WHIST + 8 * w), b = *(const i32x4*)(WHIST + 8 * w + 4); const int hv[8] = {a.x, a.y, a.z, a.w, b.x, b.y, b.z, b.w};
#pragma unroll
            for (int e = 0; e < 8; ++e) { tot[e] += hv[e]; pre[e] += (w < F.gw) ? hv[e] : 0; } }
        int base[8], ts[9]; ts[0] = 0;
#pragma unroll
        for (int e = 0; e < 8; ++e) { tot[e] = wave_sum_i(tot[e]); pre[e] = wave_sum_i(pre[e]); ts[e + 1] = ts[e] + ((tot[e] + 255) >> 8); base[e] = ts[e] * 256 + pre[e]; }
        if (F.gw == 0 && F.lane == 0) {
#pragma unroll
            for (int e = 0; e < 9; ++e) MTS[e] = ts[e]; }
        f32x4 gn[8]; load_gain_b(args.in[11] + D, F.lane, gn);
        v4u rc[4]; if (F.gw < M) load_raw_b((const bf16*)(ws + WS_O) + (size_t)F.gw * D, F.lane, rc);
        for (int m = F.gw; m < M; m += F.NGW) {
            v4u rn[4];
#pragma unroll
            for (int j = 0; j < 4; ++j) rn[j] = rc[j];
            if (m + F.NGW < M) load_raw_b((const bf16*)(ws + WS_O) + (size_t)(m + F.NGW) * D, F.lane, rn);
            const i32x2 ee = *(const i32x2*)(TOKE + 2 * m); int p0 = 0, p1 = 0;
#pragma unroll
            for (int e = 0; e < 8; ++e) { if (ee.x == e) { p0 = base[e]; base[e] += 1; } if (ee.y == e) { p1 = base[e]; base[e] += 1; } }
            if (F.lane == 0) *(i32x2*)(TOKP + 2 * m) = (i32x2){p0, p1};
            unsigned char* XS8 = (unsigned char*)(ws + WS_XS8);
            f32x4 v[8]; norm_raw_b(rc, gn, v);
#pragma unroll
            for (int j = 0; j < 4; ++j) rc[j] = rn[j];
            v2u* d0 = (v2u*)(XS8 + (size_t)p0 * D) + F.lane; v2u* d1 = (v2u*)(XS8 + (size_t)p1 * D) + F.lane;
#pragma unroll
            for (int j = 0; j < 4; ++j) { const f32x4 a0 = v[2 * j] * pg8::F8_SX, a1 = v[2 * j + 1] * pg8::F8_SX; v2u q;
                q.x = pg8::pk4_fp8(a0[0], a0[1], a0[2], a0[3]); q.y = pg8::pk4_fp8(a1[0], a1[1], a1[2], a1[3]);
                d0[64 * j] = q; d1[64 * j] = q; }
        }
    }
    SEAM(13);
    if (IN(14)) for (int rep = 0; rep < REP_G16; ++rep) {
        pg8::MoeOrder S; S.G = F.G; S.c = (int)blockIdx.x; S.nN = GU / 256;
#pragma unroll
        for (int e = 0; e < 9; ++e) S.ts[e] = __builtin_amdgcn_readfirstlane(MTS[e]);
        pg8::Gemm g{ws + WS_XS8, ws + WS_EGU, D}; pg8::EpiSwiglu8 E{(unsigned char*)H, FF, pg8::F8_INV1};
        pg8::gemm_phase<pg8::EpiSwiglu8, pg8::MoeOrder, false, true, true>(F.lds + RING_OFF, g, S, E);
    }
    SEAM(14);
    if (IN(15)) {
        pg8::MoeOrderT<true> S; S.G = F.G; S.c = (int)blockIdx.x; S.nN = D / 256;
#pragma unroll
        for (int e = 0; e < 9; ++e) S.ts[e] = __builtin_amdgcn_readfirstlane(MTS[e]);
        S.ntk = FF / 128; S.pbuf = (float*)(ws + WS_XN); S.pcnt = (unsigned*)(ws + WS_CTL) + CW_SK; S.lflag = (LAS unsigned*)(F.lds + MISC_OFF + 64);
        pg8::Gemm g{H, ws + WS_ED, FF}; pg8::EpiStoreBf16s E{XS, D, pg8::F8_INV2};
        pg8::gemm_phase<pg8::EpiStoreBf16s, pg8::MoeOrderT<true>, true, true, true>(F.lds + RING_OFF, g, S, E);
    }
    SEAM(15);
    if (IN(16)) {
        const bf16* XR = (const bf16*)(ws + WS_O);
        f32x4 gn[8]; load_gain_b(args.in[19], F.lane, gn);
#define COMB_LOAD(slot, r) do { load_raw_b(XR + (size_t)(F.gw + (r) * F.NGW) * D, F.lane, xs[slot]); load_raw_b(XS + (size_t)pp8[r].x * D, F.lane, as[slot]); load_raw_b(XS + (size_t)pp8[r].y * D, F.lane, bs[slot]); } while (0)
#define COMB_ROW(slot, r) do { const f32x2 ww = ww8[r]; f32x4 v[8]; float s = 0.f; \
            _Pragma("unroll") for (int j = 0; j < 4; ++j) { const v4u px = xs[slot][j], pa = as[slot][j], pb2 = bs[slot][j]; \
                v[2 * j] = (f32x4){bflo(px.x) + ww.x * bflo(pa.x) + ww.y * bflo(pb2.x), bfhi(px.x) + ww.x * bfhi(pa.x) + ww.y * bfhi(pb2.x), bflo(px.y) + ww.x * bflo(pa.y) + ww.y * bflo(pb2.y), bfhi(px.y) + ww.x * bfhi(pa.y) + ww.y * bfhi(pb2.y)}; \
                v[2 * j + 1] = (f32x4){bflo(px.z) + ww.x * bflo(pa.z) + ww.y * bflo(pb2.z), bfhi(px.z) + ww.x * bfhi(pa.z) + ww.y * bfhi(pb2.z), bflo(px.w) + ww.x * bflo(pa.w) + ww.y * bflo(pb2.w), bfhi(px.w) + ww.x * bfhi(pa.w) + ww.y * bfhi(pb2.w)}; } \
            _Pragma("unroll") for (int j = 0; j < 8; ++j) s += (v[j].x * v[j].x + v[j].y * v[j].y) + (v[j].z * v[j].z + v[j].w * v[j].w); \
            const float rstd = __builtin_amdgcn_rsqf(wave_sum(s) * (1.0f / D) + EPS); \
            f32x4* orow = (f32x4*)(out + (size_t)(F.gw + (r) * F.NGW) * D) + 2 * F.lane; \
            _Pragma("unroll") for (int j = 0; j < 4; ++j) { orow[128 * j] = v[2 * j] * rstd * gn[2 * j]; orow[128 * j + 1] = v[2 * j + 1] * rstd * gn[2 * j + 1]; } } while (0)
        if (F.NGW * 8 == M) {
            i32x2 pp8[8]; f32x2 ww8[8];
#pragma unroll
            for (int r = 0; r < 8; ++r) { pp8[r] = *(const i32x2*)(TOKP + 2 * (F.gw + r * F.NGW)); ww8[r] = *(const f32x2*)(TOKW + 2 * (F.gw + r * F.NGW)); }
            v4u xs[2][4], as[2][4], bs[2][4];
            COMB_LOAD(0, 0);
            COMB_LOAD(1, 1); COMB_ROW(0, 0); COMB_LOAD(0, 2); COMB_ROW(1, 1); COMB_LOAD(1, 3); COMB_ROW(0, 2); COMB_LOAD(0, 4); COMB_ROW(1, 3);
            COMB_LOAD(1, 5); COMB_ROW(0, 4); COMB_LOAD(0, 6); COMB_ROW(1, 5); COMB_LOAD(1, 7); COMB_ROW(0, 6); COMB_ROW(1, 7);
        } else {
#undef COMB_LOAD
#undef COMB_ROW
        v4u xc[4], ac[4], bc[4]; i32x2 ppn = (i32x2){0, 0}; f32x2 wwc = (f32x2){0.f, 0.f}, wwn = (f32x2){0.f, 0.f};
        if (F.gw < M) { const i32x2 pp = *(const i32x2*)(TOKP + 2 * F.gw); wwc = *(const f32x2*)(TOKW + 2 * F.gw);
            load_raw_b(XR + (size_t)F.gw * D, F.lane, xc); load_raw_b(XS + (size_t)pp.x * D, F.lane, ac); load_raw_b(XS + (size_t)pp.y * D, F.lane, bc); }
        if (F.gw + F.NGW < M) { ppn = *(const i32x2*)(TOKP + 2 * (F.gw + F.NGW)); wwn = *(const f32x2*)(TOKW + 2 * (F.gw + F.NGW)); }
        for (int m = F.gw; m < M; m += F.NGW) {
            v4u xn[4], an[4], bn[4]; i32x2 ppnn = ppn; f32x2 wwnn = wwn;
#pragma unroll
            for (int j = 0; j < 4; ++j) { xn[j] = xc[j]; an[j] = ac[j]; bn[j] = bc[j]; }
            if (m + F.NGW < M) { load_raw_b(XR + (size_t)(m + F.NGW) * D, F.lane, xn); load_raw_b(XS + (size_t)ppn.x * D, F.lane, an); load_raw_b(XS + (size_t)ppn.y * D, F.lane, bn); }
            if (m + 2 * F.NGW < M) { ppnn = *(const i32x2*)(TOKP + 2 * (m + 2 * F.NGW)); wwnn = *(const f32x2*)(TOKW + 2 * (m + 2 * F.NGW)); }
            const f32x2 ww = wwc;
            f32x4 v[8]; float s = 0.f;
#pragma unroll
            for (int j = 0; j < 4; ++j) { const v4u px = xc[j], pa = ac[j], pb2 = bc[j];
                v[2 * j] = (f32x4){bflo(px.x) + ww.x * bflo(pa.x) + ww.y * bflo(pb2.x), bfhi(px.x) + ww.x * bfhi(pa.x) + ww.y * bfhi(pb2.x), bflo(px.y) + ww.x * bflo(pa.y) + ww.y * bflo(pb2.y), bfhi(px.y) + ww.x * bfhi(pa.y) + ww.y * bfhi(pb2.y)};
                v[2 * j + 1] = (f32x4){bflo(px.z) + ww.x * bflo(pa.z) + ww.y * bflo(pb2.z), bfhi(px.z) + ww.x * bfhi(pa.z) + ww.y * bfhi(pb2.z), bflo(px.w) + ww.x * bflo(pa.w) + ww.y * bflo(pb2.w), bfhi(px.w) + ww.x * bfhi(pa.w) + ww.y * bfhi(pb2.w)}; }
#pragma unroll
            for (int j = 0; j < 8; ++j) s += (v[j].x * v[j].x + v[j].y * v[j].y) + (v[j].z * v[j].z + v[j].w * v[j].w);
            const float rstd = 1.0f / sqrtf(wave_sum(s) * (1.0f / D) + EPS);
            f32x4* orow = (f32x4*)(out + (size_t)m * D) + 2 * F.lane;
#pragma unroll
            for (int j = 0; j < 4; ++j) { orow[128 * j] = v[2 * j] * rstd * gn[2 * j]; orow[128 * j + 1] = v[2 * j + 1] * rstd * gn[2 * j + 1]; }
#pragma unroll
            for (int j = 0; j < 4; ++j) { xc[j] = xn[j]; ac[j] = an[j]; bc[j] = bn[j]; }
            wwc = wwn; ppn = ppnn; wwn = wwnn;
        }
        }
    }
}

extern "C" void kernel_launch(void* const* d_in, const int* in_sizes, int n_in, void* d_out, int out_size, void* d_ws, size_t ws_size, hipStream_t stream) {
    static int grid = 0;
    if (grid == 0) {
        if (n_in != 20 || in_sizes[0] != M * D || out_size != M * D || ws_size < WS_END) { fprintf(stderr, "kernel_launch: unexpected shapes / workspace (n_in %d, ws %zu, need %zu); nothing launched\n", n_in, ws_size, (size_t)WS_END); grid = -1; return; }
        int dev = 0, cus = 0, per_cu = 0;
        if (hipGetDevice(&dev) != hipSuccess || hipDeviceGetAttribute(&cus, hipDeviceAttributeMultiprocessorCount, dev) != hipSuccess) { grid = -1; return; }
        if (hipFuncSetAttribute((const void*)trunk_fwd, hipFuncAttributeMaxDynamicSharedMemorySize, LDS_BYTES) != hipSuccess) { fprintf(stderr, "kernel_launch: hipFuncSetAttribute failed\n"); grid = -1; return; }
        if (hipOccupancyMaxActiveBlocksPerMultiprocessor(&per_cu, (const void*)trunk_fwd, NWAVES * 64, LDS_BYTES) != hipSuccess || per_cu < 1) fprintf(stderr, "kernel_launch: occupancy query reports %d\n", per_cu);
        (void)hipGetLastError();
        grid = cus;
    }
    if (grid < 0) return;
    if (hipMemsetAsync((char*)d_ws + WS_CTL, 0, CTL_ZERO_BYTES, stream) != hipSuccess) return;
    Args a{};
    for (int i = 0; i < 20; ++i) a.in[i] = (const float*)d_in[i];
    a.out = (float*)d_out; a.ws = (unsigned char*)d_ws;
#if MK_ONE_LAUNCH
    a.ph_lo = 0; a.ph_hi = NPHASE;
    hipLaunchKernelGGL(trunk_fwd, dim3(grid), dim3(NWAVES * 64), LDS_BYTES, stream, a);
#else
    for (int p = 0; p < NPHASE; ++p) {
        a.ph_lo = p; a.ph_hi = p + 1;
        hipLaunchKernelGGL(trunk_fwd, dim3(grid), dim3(NWAVES * 64), LDS_BYTES, stream, a);
    }
#endif
}
```

```cpp
#include <hip/hip_runtime.h>
#include <cstdio>
#include <cstdint>

#ifndef REP_CONV
#define REP_CONV 1
#endif
#ifndef REP_MIX
#define REP_MIX 1
#endif
#ifndef REP_G16
#define REP_G16 1
#endif
#ifndef DENSE_F8
#define DENSE_F8 3
#endif
#ifndef MK_ONE_LAUNCH
#define MK_ONE_LAUNCH 1
#endif

namespace pg8 {
#define PG8_LAS __attribute__((address_space(3)))
typedef unsigned short bf16_t;
typedef short bf16x8 __attribute__((ext_vector_type(8)));
typedef float f32x4 __attribute__((ext_vector_type(4)));
typedef unsigned u32x4 __attribute__((ext_vector_type(4)));
constexpr int BM = 256, BK = 64, HALF = 128, HTB = HALF * BK * 2, STAGE_BYTES = 8 * HTB, NXCD = 8, WGM = 8;

__host__ __device__ __forceinline__ int lds_byte(int r, int c) { const int st = (r >> 4) * 2 + (c >> 5), rr = r & 15, cc = c & 31, ob = rr * 64 + cc * 2; return st * 1024 + (ob ^ (((ob >> 9) & 1) << 5)); }
__host__ __device__ __forceinline__ void stage_rc(int b, int& R, int& C) { const int st = b / 1024, sb = b % 1024, swz = sb ^ (((sb >> 9) & 1) << 5); R = (st >> 1) * 16 + swz / 64; C = (st & 1) * 32 + (swz % 64) / 2; }
__host__ __device__ __forceinline__ int perm32(int rho) { const int n = rho >> 4, i = rho & 15; return 8 * (i >> 2) + 4 * n + (i & 3); }

struct Unit { int pm, pn, po; int kt0, knt, part, tix, sp; };
struct Gemm { const void* A; const void* Bt; int Kb; };

struct StaticOrder {
    static constexpr bool SPLITK = false;
    int nM, nN, nwg, G, c;
    __host__ __device__ void init(int M, int N, int G_, int c_) { nM = M / BM; nN = N / BM; nwg = nM * nN; G = G_; c = c_; }
    __host__ __device__ bool next(int i, Unit& u) const {
        const long L = (long)i * G + c; if (L >= nwg) return false;
        int wgid = (int)L; { const int q = nwg / NXCD, r = nwg % NXCD, xcd = wgid % NXCD, off = wgid / NXCD; wgid = (xcd < r ? xcd * (q + 1) : r * (q + 1) + (xcd - r) * q) + off; }
        const int nig = WGM * nN, gid = wgid / nig, fm = gid * WGM, gsz = (nM - fm) < WGM ? (nM - fm) : WGM;
        u.pm = fm + ((wgid % nig) % gsz); u.pn = (wgid % nig) / gsz; u.po = u.pn; return true;
    }
    __device__ __forceinline__ void a_ready(const Unit&) const {}
    __device__ __forceinline__ void done(const Unit&) const {}
};
template <bool SK> struct MoeOrderT {
    static constexpr bool SPLITK = SK;
    int G, c, nN; int ts[9];
    int ntk; float* pbuf; unsigned* pcnt; PG8_LAS unsigned* lflag;
    __device__ __forceinline__ void locate(int L, Unit& u) const {
        int e = 0;
#pragma unroll
        for (int j = 1; j < 8; ++j) e = (L >= ts[j] * nN) ? j : e;
        int tse = ts[0], tsn = ts[1];
#pragma unroll
        for (int j = 1; j < 8; ++j) { tse = (e == j) ? ts[j] : tse; tsn = (e == j) ? ts[j + 1] : tsn; }
        const int l = L - tse * nN, te = tsn - tse;
        const int cg = l / (te * 4), rem = l - cg * (te * 4), pr = rem >> 2;
        u.pm = tse + pr; u.po = cg * 4 + (rem & 3); u.pn = e * nN + u.po;
    }
    __device__ __forceinline__ int unit_index(int i) const { const int per = G >> 3; return ((G & 7) == 0) ? (i * 8 + (c & 7)) * per + (c >> 3) : i * G + c; }
    __device__ __forceinline__ int nsplit(int T) const { int sp = 1; if (SK && T > 0) { sp = G / T; sp = sp > 4 ? 4 : sp; } return sp; }
    __device__ __forceinline__ bool next(int i, Unit& u) const {
        const int total = ts[8] * nN;
        if constexpr (SK) {
            const int R = total / G, T = total - R * G, sp = nsplit(T);
            if (i >= R && sp > 1) {
                if (i > R || c >= T * sp) return false;
                const int part = c / T, tix = c - part * T, pairs = ntk >> 1, base = pairs / sp, extra = pairs - base * sp;
                locate(R * G + tix, u);
                u.part = part; u.tix = tix; u.sp = sp; u.kt0 = 2 * (part * base + (part < extra ? part : extra)); u.knt = 2 * (base + (part < extra ? 1 : 0)); return true;
            }
            u.part = -1; u.tix = 0; u.sp = 1; u.kt0 = 0; u.knt = ntk;
        }
        const int L = unit_index(i); if (L >= total) return false;
        locate(L, u); return true;
    }
    __device__ __forceinline__ void a_ready(const Unit&) const {}
    __device__ __forceinline__ void done(const Unit&) const {}
};
typedef MoeOrderT<false> MoeOrder;


typedef float f32x2c __attribute__((ext_vector_type(2)));
typedef __bf16 bf16x2c __attribute__((ext_vector_type(2)));
__device__ __forceinline__ unsigned cvt_pk_bf16(float lo, float hi) { const f32x2c v = {lo, hi}; return __builtin_bit_cast(unsigned, __builtin_convertvector(v, bf16x2c)); }

struct EpiStoreBf16 {
    static constexpr bool PERM = true, AFTER_DRAIN = false;
    bf16_t* O; int ldc;
    __device__ __forceinline__ void operator()(const f32x4 (&acc)[2][2][4][2], const Unit& u, int wr, int wc, int fr, int fq) const {
        const int row0 = u.pm * BM + wr * 64 + fr, col0 = u.po * BM + wc * 32 + 8 * fq;
#pragma unroll
        for (int ai = 0; ai < 2; ++ai)
#pragma unroll
            for (int m = 0; m < 4; ++m) { bf16_t* rowp = O + (size_t)(row0 + ai * HALF + m * 16) * ldc + col0;
#pragma unroll
                for (int bj = 0; bj < 2; ++bj) { const f32x4 v0 = acc[ai][bj][m][0], v1 = acc[ai][bj][m][1];
                    u32x4 w; w.x = cvt_pk_bf16(v0[0], v0[1]); w.y = cvt_pk_bf16(v0[2], v0[3]); w.z = cvt_pk_bf16(v1[0], v1[1]); w.w = cvt_pk_bf16(v1[2], v1[3]);
                    *(u32x4*)(rowp + bj * HALF) = w; } }
    }
};
struct EpiResid {
    static constexpr bool PERM = false, AFTER_DRAIN = false;
    const float* base; float* out; int ldc; float scale;
    __device__ __forceinline__ void operator()(const f32x4 (&acc)[2][2][4][2], const Unit& u, int wr, int wc, int fr, int fq) const {
        const int row0 = u.pm * BM + wr * 64 + fr, col0 = u.po * BM + wc * 32 + 4 * fq;
#pragma unroll
        for (int ai = 0; ai < 2; ++ai)
#pragma unroll
            for (int m = 0; m < 4; ++m) { const size_t off = (size_t)(row0 + ai * HALF + m * 16) * ldc + col0;
#pragma unroll
                for (int bj = 0; bj < 2; ++bj)
#pragma unroll
                    for (int n = 0; n < 2; ++n) { const f32x4 b = *(const f32x4*)(base + off + bj * HALF + n * 16); *(f32x4*)(out + off + bj * HALF + n * 16) = b + acc[ai][bj][m][n] * scale; }
                asm volatile("" ::: "memory"); }
    }
};
template <bool BASE_F32> struct EpiResidB {
    static constexpr bool PERM = true, AFTER_DRAIN = false;
    const void* base; bf16_t* out; int ldc; float scale;
    __device__ __forceinline__ void operator()(const f32x4 (&acc)[2][2][4][2], const Unit& u, int wr, int wc, int fr, int fq) const {
        const int row0 = u.pm * BM + wr * 64 + fr, col0 = u.po * BM + wc * 32 + 8 * fq;
        if constexpr (!BASE_F32) {
            u32x4 t[2][4][2];
#pragma unroll
            for (int ai = 0; ai < 2; ++ai)
#pragma unroll
                for (int m = 0; m < 4; ++m)
#pragma unroll
                    for (int bj = 0; bj < 2; ++bj) t[ai][m][bj] = *(const u32x4*)((const bf16_t*)base + (size_t)(row0 + ai * HALF + m * 16) * ldc + col0 + bj * HALF);
#pragma unroll
            for (int ai = 0; ai < 2; ++ai)
#pragma unroll
                for (int m = 0; m < 4; ++m)
#pragma unroll
                    for (int bj = 0; bj < 2; ++bj) { const u32x4 q = t[ai][m][bj];
                        const f32x4 b0 = (f32x4){__builtin_bit_cast(float, q.x << 16), __builtin_bit_cast(float, q.x & 0xffff0000u), __builtin_bit_cast(float, q.y << 16), __builtin_bit_cast(float, q.y & 0xffff0000u)};
                        const f32x4 b1 = (f32x4){__builtin_bit_cast(float, q.z << 16), __builtin_bit_cast(float, q.z & 0xffff0000u), __builtin_bit_cast(float, q.w << 16), __builtin_bit_cast(float, q.w & 0xffff0000u)};
                        const f32x4 v0 = b0 + acc[ai][bj][m][0] * scale, v1 = b1 + acc[ai][bj][m][1] * scale;
                        u32x4 w; w.x = cvt_pk_bf16(v0[0], v0[1]); w.y = cvt_pk_bf16(v0[2], v0[3]); w.z = cvt_pk_bf16(v1[0], v1[1]); w.w = cvt_pk_bf16(v1[2], v1[3]);
                        *(u32x4*)(out + (size_t)(row0 + ai * HALF + m * 16) * ldc + col0 + bj * HALF) = w; }
            return;
        }
#pragma unroll
        for (int ai = 0; ai < 2; ++ai) {
            f32x4 b0[4][2], b1[4][2];
            if constexpr (BASE_F32) {
#pragma unroll
                for (int m = 0; m < 4; ++m)
#pragma unroll
                    for (int bj = 0; bj < 2; ++bj) { const float* bp = (const float*)base + (size_t)(row0 + ai * HALF + m * 16) * ldc + col0 + bj * HALF; b0[m][bj] = *(const f32x4*)bp; b1[m][bj] = *(const f32x4*)(bp + 4); }
            } else {
                u32x4 t[4][2];
#pragma unroll
                for (int m = 0; m < 4; ++m)
#pragma unroll
                    for (int bj = 0; bj < 2; ++bj) t[m][bj] = *(const u32x4*)((const bf16_t*)base + (size_t)(row0 + ai * HALF + m * 16) * ldc + col0 + bj * HALF);
#pragma unroll
                for (int m = 0; m < 4; ++m)
#pragma unroll
                    for (int bj = 0; bj < 2; ++bj) { const u32x4 q = t[m][bj];
                        b0[m][bj] = (f32x4){__builtin_bit_cast(float, q.x << 16), __builtin_bit_cast(float, q.x & 0xffff0000u), __builtin_bit_cast(float, q.y << 16), __builtin_bit_cast(float, q.y & 0xffff0000u)};
                        b1[m][bj] = (f32x4){__builtin_bit_cast(float, q.z << 16), __builtin_bit_cast(float, q.z & 0xffff0000u), __builtin_bit_cast(float, q.w << 16), __builtin_bit_cast(float, q.w & 0xffff0000u)}; }
            }
#pragma unroll
            for (int m = 0; m < 4; ++m)
#pragma unroll
                for (int bj = 0; bj < 2; ++bj) { const f32x4 v0 = b0[m][bj] + acc[ai][bj][m][0] * scale, v1 = b1[m][bj] + acc[ai][bj][m][1] * scale;
                    u32x4 w; w.x = cvt_pk_bf16(v0[0], v0[1]); w.y = cvt_pk_bf16(v0[2], v0[3]); w.z = cvt_pk_bf16(v1[0], v1[1]); w.w = cvt_pk_bf16(v1[2], v1[3]);
                    *(u32x4*)(out + (size_t)(row0 + ai * HALF + m * 16) * ldc + col0 + bj * HALF) = w; }
        }
    }
};
__device__ __forceinline__ float silu_f(float x) { return x * __builtin_amdgcn_rcpf(1.0f + __expf(-x)); }
__device__ __forceinline__ f32x2c exp2_2(f32x2c t) { return (f32x2c){__builtin_amdgcn_exp2f(t.x), __builtin_amdgcn_exp2f(t.y)}; }
__device__ __forceinline__ f32x2c rcp_2(f32x2c t) { return (f32x2c){__builtin_amdgcn_rcpf(t.x), __builtin_amdgcn_rcpf(t.y)}; }
__device__ __forceinline__ f32x2c silu_2(f32x2c x) { return x * rcp_2(exp2_2(x * -1.4426950408889634f) + 1.0f); }
__device__ __forceinline__ f32x2c gelu_2(f32x2c x) { const f32x2c t = x * (x * x * -0.10294322f + -2.3022082f); return x * rcp_2(exp2_2(t) + 1.0f); }
__device__ __forceinline__ unsigned cvt_pk_bf16_2(f32x2c v) { return __builtin_bit_cast(unsigned, __builtin_convertvector(v, bf16x2c)); }
struct EpiSwiglu {
    static constexpr bool PERM = true, AFTER_DRAIN = false;
    bf16_t* O; int ldc; float isc;
    __device__ __forceinline__ void operator()(const f32x4 (&acc)[2][2][4][2], const Unit& u, int wr, int wc, int fr, int fq) const {
        const int row0 = u.pm * BM + wr * 64 + fr, col0 = u.po * HALF + wc * 32 + 8 * fq;
        const float kn = -1.4426950408889634f * isc, invC = 1.0f / (isc * isc);
#pragma unroll
        for (int ai = 0; ai < 2; ++ai)
#pragma unroll
            for (int m = 0; m < 4; ++m) { bf16_t* rowp = O + (size_t)(row0 + ai * HALF + m * 16) * ldc + col0;
                const f32x4 g0 = acc[ai][0][m][0], g1 = acc[ai][0][m][1], u0 = acc[ai][1][m][0], u1 = acc[ai][1][m][1];
                const f32x2c ga = {g0[0], g0[1]}, gb = {g0[2], g0[3]}, gc = {g1[0], g1[1]}, gd = {g1[2], g1[3]};
                const f32x2c ua = {u0[0], u0[1]}, ub = {u0[2], u0[3]}, uc = {u1[0], u1[1]}, ud = {u1[2], u1[3]};
                const f32x2c ha = (ga * ua) * rcp_2(exp2_2(ga * kn) * invC + invC), hb = (gb * ub) * rcp_2(exp2_2(gb * kn) * invC + invC);
                const f32x2c hc = (gc * uc) * rcp_2(exp2_2(gc * kn) * invC + invC), hd = (gd * ud) * rcp_2(exp2_2(gd * kn) * invC + invC);
                u32x4 w; w.x = cvt_pk_bf16_2(ha); w.y = cvt_pk_bf16_2(hb); w.z = cvt_pk_bf16_2(hc); w.w = cvt_pk_bf16_2(hd);
                *(u32x4*)rowp = w; }
    }
};


__device__ __forceinline__ float clamp8(float v) { return __builtin_amdgcn_fmed3f(v, -448.0f, 448.0f); }
__device__ __forceinline__ unsigned pk4_fp8(float a, float b, float c, float d) { int p = __builtin_amdgcn_cvt_pk_fp8_f32(clamp8(a), clamp8(b), 0, false); p = __builtin_amdgcn_cvt_pk_fp8_f32(clamp8(c), clamp8(d), p, true); return (unsigned)p; }
constexpr float F8_SX = 8.0f, F8_SW1 = 256.0f, F8_SH = 4.0f, F8_SW2 = 512.0f;
constexpr float F8_INV1 = 1.0f / (F8_SX * F8_SW1), F8_INV2 = 1.0f / (F8_SH * F8_SW2);
typedef unsigned u32x2 __attribute__((ext_vector_type(2)));
struct EpiSwiglu8 {
    static constexpr bool PERM = true, AFTER_DRAIN = false;
    unsigned char* O; int ldc; float isc;
    __device__ __forceinline__ void operator()(const f32x4 (&acc)[2][2][4][2], const Unit& u, int wr, int wc, int fr, int fq) const {
        const int row0 = u.pm * BM + wr * 64 + fr, col0 = u.po * HALF + wc * 32 + 8 * fq;
        const float kn = -1.4426950408889634f * isc, invC = 1.0f / (isc * isc * F8_SH);
#pragma unroll
        for (int ai = 0; ai < 2; ++ai)
#pragma unroll
            for (int m = 0; m < 4; ++m) { unsigned char* rowp = O + (size_t)(row0 + ai * HALF + m * 16) * ldc + col0;
                const f32x4 g0 = acc[ai][0][m][0], g1 = acc[ai][0][m][1], u0 = acc[ai][1][m][0], u1 = acc[ai][1][m][1];
                const f32x2c ga = {g0[0], g0[1]}, gb = {g0[2], g0[3]}, gc = {g1[0], g1[1]}, gd = {g1[2], g1[3]};
                const f32x2c ua = {u0[0], u0[1]}, ub = {u0[2], u0[3]}, uc = {u1[0], u1[1]}, ud = {u1[2], u1[3]};
                const f32x2c ha = (ga * ua) * rcp_2(exp2_2(ga * kn) * invC + invC), hb = (gb * ub) * rcp_2(exp2_2(gb * kn) * invC + invC);
                const f32x2c hc = (gc * uc) * rcp_2(exp2_2(gc * kn) * invC + invC), hd = (gd * ud) * rcp_2(exp2_2(gd * kn) * invC + invC);
                u32x2 w; w.x = pk4_fp8(ha.x, ha.y, hb.x, hb.y); w.y = pk4_fp8(hc.x, hc.y, hd.x, hd.y);
                *(u32x2*)rowp = w; }
    }
};
struct EpiStoreBf16s {
    static constexpr bool PERM = true, AFTER_DRAIN = false;
    bf16_t* O; int ldc; float scale;
    __device__ __forceinline__ void operator()(const f32x4 (&acc)[2][2][4][2], const Unit& u, int wr, int wc, int fr, int fq) const {
        const int row0 = u.pm * BM + wr * 64 + fr, col0 = u.po * BM + wc * 32 + 8 * fq;
#pragma unroll
        for (int ai = 0; ai < 2; ++ai)
#pragma unroll
            for (int m = 0; m < 4; ++m) { bf16_t* rowp = O + (size_t)(row0 + ai * HALF + m * 16) * ldc + col0;
#pragma unroll
                for (int bj = 0; bj < 2; ++bj) { const f32x4 v0 = acc[ai][bj][m][0] * scale, v1 = acc[ai][bj][m][1] * scale;
                    u32x4 w; w.x = cvt_pk_bf16(v0[0], v0[1]); w.y = cvt_pk_bf16(v0[2], v0[3]); w.z = cvt_pk_bf16(v1[0], v1[1]); w.w = cvt_pk_bf16(v1[2], v1[3]);
                    *(u32x4*)(rowp + bj * HALF) = w; } }
    }
};

__device__ __forceinline__ float gelu_f(float x) { const float u = 0.7978845608028654f * (x + 0.044715f * x * x * x); return x * __builtin_amdgcn_rcpf(1.0f + __expf(-2.0f * u)); }
struct EpiZ {
    static constexpr bool PERM = true, AFTER_DRAIN = false;
    bf16_t* O; int ldc; const float* lbl; int layer;
    __device__ __forceinline__ void operator()(const f32x4 (&acc)[2][2][4][2], const Unit& u, int wr, int wc, int fr, int fq) const {
        const int row0 = u.pm * BM + wr * 64 + fr, col0 = u.po * BM + wc * 32 + 8 * fq, blk = u.po >> 2;
#pragma unroll
        for (int bj = 0; bj < 2; ++bj) {
            float lb[8];
#pragma unroll
            for (int j = 0; j < 8; ++j) lb[j] = 0.f;
            if (blk == 3 && layer == 1) { const int cc = col0 + bj * HALF - 3072;
                const f32x4 a0 = *(const f32x4*)(lbl + cc), a1 = *(const f32x4*)(lbl + cc + 4), b0 = *(const f32x4*)(lbl + 1024 + cc), b1 = *(const f32x4*)(lbl + 1024 + cc + 4);
#pragma unroll
                for (int j = 0; j < 4; ++j) { lb[j] = 1.0f / (1.0f + __expf(a0[j] - b0[j])); lb[4 + j] = 1.0f / (1.0f + __expf(a1[j] - b1[j])); } }
#pragma unroll
            for (int ai = 0; ai < 2; ++ai)
#pragma unroll
                for (int m = 0; m < 4; ++m) { bf16_t* rowp = O + (size_t)(row0 + ai * HALF + m * 16) * ldc + col0 + bj * HALF;
                    const f32x4 q0 = acc[ai][bj][m][0], q1 = acc[ai][bj][m][1];
                    f32x2c v[4] = {{q0[0], q0[1]}, {q0[2], q0[3]}, {q1[0], q1[1]}, {q1[2], q1[3]}};
                    if (blk == 2 || blk == 5) {
#pragma unroll
                        for (int j = 0; j < 4; ++j) v[j] = silu_2(v[j]);
                    } else if (blk == 3) {
#pragma unroll
                        for (int j = 0; j < 4; ++j) { const f32x2c sg = rcp_2(exp2_2(v[j] * -1.4426950408889634f) + 1.0f); const f32x2c lbv = {lb[2 * j], lb[2 * j + 1]}; const f32x2c f = lbv + (1.0f - lbv) * sg;
                            v[j] = (f32x2c){__builtin_amdgcn_logf(__builtin_amdgcn_fmed3f(f.x, 1e-6f, 1.0f)), __builtin_amdgcn_logf(__builtin_amdgcn_fmed3f(f.y, 1e-6f, 1.0f))} * 0.6931471805599453f; }
                    }
                    u32x4 w; w.x = cvt_pk_bf16_2(v[0]); w.y = cvt_pk_bf16_2(v[1]); w.z = cvt_pk_bf16_2(v[2]); w.w = cvt_pk_bf16_2(v[3]);
                    *(u32x4*)rowp = w; }
        }
    }
};

typedef int v8i __attribute__((ext_vector_type(8)));
typedef int v4i __attribute__((ext_vector_type(4)));
template <class Epi, class Sched, bool ALIGN_EPI = false, bool SP2 = false, bool F8 = false>
__device__ __forceinline__ void gemm_phase(PG8_LAS unsigned char* lds, const Gemm g, const Sched& S, const Epi& E) {
    const int tid = threadIdx.x, wid = __builtin_amdgcn_readfirstlane(tid >> 6), lane = tid & 63, wr = wid >> 2, wc = wid & 3, fr = lane & 15, fq = lane >> 4;
    const int Kb = g.Kb, nt = Kb / 128;
    unsigned voffA[2], voffB[2];
#pragma unroll
    for (int i = 0; i < 2; ++i) { int R, C; stage_rc(tid * 16 + i * 8192, R, C); const int Rb = Epi::PERM ? ((R & ~31) + perm32(R & 31)) : R;
        voffA[i] = (unsigned)(R * Kb + C * 2); voffB[i] = (unsigned)(Rb * Kb + C * 2); }
    const size_t kstep = (size_t)(BK * 2);
    const size_t hstep = (size_t)HALF * Kb;
    const size_t tstep = 2 * hstep;
    const unsigned ldsw = (unsigned)wid * 1024u;
    const int aoff = lds_byte(wr * 64 + fr, fq * 8), boff = lds_byte(wc * 32 + fr, fq * 8);
#define PG8_SA(b, h) (((b) * 2 + (h)) * HTB)
#define PG8_SB(b, h) ((4 + (b) * 2 + (h)) * HTB)
#define PG8_STAGE(bufoff, gbase, voff) do { _Pragma("unroll") for (int _i = 0; _i < 2; ++_i) \
        __builtin_amdgcn_global_load_lds((const unsigned*)((const char*)(gbase) + (voff)[_i]), (PG8_LAS unsigned*)(lds + (bufoff) + ldsw + _i * 8192), 16, 0, 0); } while (0)
#define PG8_LDA(dst, b, h) do { if constexpr (F8) { _Pragma("unroll") for (int m = 0; m < 4; ++m) { dst##8[m].lo = *(const PG8_LAS v4i*)(lds + PG8_SA(b, h) + aoff + m * 2048); dst##8[m].hi = *(const PG8_LAS v4i*)(lds + PG8_SA(b, h) + aoff + m * 2048 + 1024); } } \
        else { _Pragma("unroll") for (int m = 0; m < 4; ++m) _Pragma("unroll") for (int k = 0; k < 2; ++k) dst[m][k] = *(const PG8_LAS bf16x8*)(lds + PG8_SA(b, h) + aoff + m * 2048 + k * 1024); } } while (0)
#define PG8_LDB(dst, b, h) do { if constexpr (F8) { _Pragma("unroll") for (int n = 0; n < 2; ++n) { dst##8[n].lo = *(const PG8_LAS v4i*)(lds + PG8_SB(b, h) + boff + n * 2048); dst##8[n].hi = *(const PG8_LAS v4i*)(lds + PG8_SB(b, h) + boff + n * 2048 + 1024); } } \
        else { _Pragma("unroll") for (int n = 0; n < 2; ++n) _Pragma("unroll") for (int k = 0; k < 2; ++k) dst[n][k] = *(const PG8_LAS bf16x8*)(lds + PG8_SB(b, h) + boff + n * 2048 + k * 1024); } } while (0)
#define PG8_MMA(ai, bj, At, Bt) do { __builtin_amdgcn_s_setprio(1); if constexpr (F8) { _Pragma("unroll") for (int m = 0; m < 4; ++m) _Pragma("unroll") for (int n = 0; n < 2; ++n) \
            asm volatile("v_mfma_f32_16x16x128_f8f6f4 %0, %1, %2, %0" : "+v"(acc[ai][bj][m][n]) : "v"(Bt##8[n]), "v"(At##8[m])); } \
        else { _Pragma("unroll") for (int m = 0; m < 4; ++m) _Pragma("unroll") for (int n = 0; n < 2; ++n) _Pragma("unroll") for (int k = 0; k < 2; ++k) \
            acc[ai][bj][m][n] = __builtin_amdgcn_mfma_f32_16x16x32_bf16(Bt[n][k], At[m][k], acc[ai][bj][m][n], 0, 0, 0); } __builtin_amdgcn_s_setprio(0); } while (0)
#define PG8_WAIT_V(n) asm volatile("s_waitcnt vmcnt(" #n ")" ::: "memory")
#define PG8_WAIT_L(n) asm volatile("s_waitcnt lgkmcnt(" #n ")" ::: "memory")
#define PG8_BAR __builtin_amdgcn_s_barrier()
#define PG8_SCHED __builtin_amdgcn_sched_barrier(0)
    Unit cur, nxt; int ui = 0;
    if (!S.next(0, cur)) return;
    f32x4 acc[2][2][4][2];
#pragma unroll
    for (int a = 0; a < 2; ++a)
#pragma unroll
        for (int b = 0; b < 2; ++b)
#pragma unroll
            for (int m = 0; m < 4; ++m)
#pragma unroll
                for (int n = 0; n < 2; ++n) acc[a][b][m][n] = (f32x4){0.f, 0.f, 0.f, 0.f};
    bf16x8 At[4][2], B0[2][2], B1[2][2]; v8i At8[4], B08[2], B18[2];
    const char* cA = (const char*)g.A + (size_t)cur.pm * tstep; const char* cB = (const char*)g.Bt + (size_t)cur.pn * tstep;
    if constexpr (Sched::SPLITK) { cA += (size_t)cur.kt0 * kstep; cB += (size_t)cur.kt0 * kstep; }
    S.a_ready(cur);
    if constexpr (SP2) {
        PG8_STAGE(PG8_SB(0, 0), cB, voffB); PG8_STAGE(PG8_SB(0, 1), cB + hstep, voffB); PG8_STAGE(PG8_SA(0, 0), cA, voffA); PG8_STAGE(PG8_SA(0, 1), cA + hstep, voffA);
        if (wr == 1) PG8_BAR;
        PG8_WAIT_V(2); PG8_BAR;
        PG8_STAGE(PG8_SB(1, 0), cB + kstep, voffB); PG8_STAGE(PG8_SA(1, 0), cA + kstep, voffA); PG8_STAGE(PG8_SB(1, 1), cB + hstep + kstep, voffB);
        PG8_WAIT_V(6); PG8_BAR;
    } else {
        PG8_STAGE(PG8_SB(0, 0), cB, voffB); PG8_STAGE(PG8_SA(0, 0), cA, voffA); PG8_STAGE(PG8_SB(0, 1), cB + hstep, voffB); PG8_STAGE(PG8_SA(0, 1), cA + hstep, voffA);
        if (wr == 1) PG8_BAR;
        PG8_WAIT_V(4); PG8_BAR;
        PG8_STAGE(PG8_SB(1, 0), cB + kstep, voffB); PG8_STAGE(PG8_SA(1, 0), cA + kstep, voffA); PG8_STAGE(PG8_SB(1, 1), cB + hstep + kstep, voffB);
        PG8_WAIT_V(6); PG8_BAR;
    }
    for (;;) {
        const bool has_next = S.next(ui + 1, nxt);
        const char* nA = has_next ? (const char*)g.A + (size_t)nxt.pm * tstep : cA; const char* nB = has_next ? (const char*)g.Bt + (size_t)nxt.pn * tstep : cB;
        if constexpr (Sched::SPLITK) { if (has_next) { nA += (size_t)nxt.kt0 * kstep; nB += (size_t)nxt.kt0 * kstep; } }
        const int ntu = Sched::SPLITK ? cur.knt : nt;
        for (int t = 0; t < ntu; t += 2) {
            const bool last = (t == ntu - 2);
            const char* a1 = cA + (size_t)(t + 1) * kstep;
            const char* a2 = last ? nA : cA + (size_t)(t + 2) * kstep; const char* b2 = last ? nB : cB + (size_t)(t + 2) * kstep;
            const char* a3 = a2 + kstep; const char* b3 = b2 + kstep;
            if (last && has_next) S.a_ready(nxt);
            if constexpr (SP2) {
            PG8_LDB(B0, 0, 0); PG8_LDB(B1, 0, 1); PG8_SCHED; PG8_LDA(At, 0, 0); PG8_STAGE(PG8_SA(1, 1), a1 + hstep, voffA);
            PG8_WAIT_V(8); PG8_WAIT_L(0); PG8_BAR; PG8_MMA(0, 0, At, B0); PG8_MMA(0, 1, At, B1); PG8_BAR; PG8_SCHED;
            PG8_LDA(At, 0, 1); PG8_STAGE(PG8_SB(0, 0), b2, voffB); PG8_STAGE(PG8_SB(0, 1), b2 + hstep, voffB); PG8_STAGE(PG8_SA(0, 0), a2, voffA);
            PG8_WAIT_V(8); PG8_WAIT_L(0); PG8_BAR; PG8_MMA(1, 0, At, B0); PG8_MMA(1, 1, At, B1); PG8_BAR; PG8_SCHED;
            PG8_LDB(B0, 1, 0); PG8_LDB(B1, 1, 1); PG8_SCHED; PG8_LDA(At, 1, 0); PG8_STAGE(PG8_SA(0, 1), a2 + hstep, voffA);
            PG8_WAIT_V(8); PG8_WAIT_L(0); PG8_BAR; PG8_MMA(0, 0, At, B0); PG8_MMA(0, 1, At, B1); PG8_BAR; PG8_SCHED;
            PG8_LDA(At, 1, 1); PG8_STAGE(PG8_SB(1, 0), b3, voffB); PG8_STAGE(PG8_SB(1, 1), b3 + hstep, voffB); PG8_STAGE(PG8_SA(1, 0), a3, voffA);
            PG8_WAIT_V(8); PG8_WAIT_L(0); PG8_BAR; PG8_MMA(1, 0, At, B0); PG8_MMA(1, 1, At, B1); PG8_BAR; PG8_SCHED;
            } else {
            PG8_LDB(B0, 0, 0); PG8_SCHED; PG8_LDA(At, 0, 0); PG8_STAGE(PG8_SA(1, 1), a1 + hstep, voffA);
            PG8_WAIT_L(8); PG8_BAR; PG8_WAIT_L(0); PG8_MMA(0, 0, At, B0); PG8_BAR; PG8_SCHED;
            PG8_LDB(B1, 0, 1); PG8_STAGE(PG8_SB(0, 0), b2, voffB);
            PG8_BAR; PG8_WAIT_L(0); PG8_MMA(0, 1, At, B1); PG8_BAR;
            PG8_LDA(At, 0, 1); PG8_STAGE(PG8_SA(0, 0), a2, voffA);
            PG8_BAR; PG8_WAIT_L(0); PG8_MMA(1, 0, At, B0); PG8_BAR; PG8_SCHED;
            PG8_STAGE(PG8_SB(0, 1), b2 + hstep, voffB);
            PG8_WAIT_V(6); PG8_BAR; PG8_MMA(1, 1, At, B1); PG8_BAR;
            PG8_LDB(B0, 1, 0); PG8_SCHED; PG8_LDA(At, 1, 0); PG8_STAGE(PG8_SA(0, 1), a2 + hstep, voffA);
            PG8_WAIT_L(8); PG8_BAR; PG8_WAIT_L(0); PG8_MMA(0, 0, At, B0); PG8_BAR; PG8_SCHED;
            PG8_LDB(B1, 1, 1); PG8_STAGE(PG8_SB(1, 0), b3, voffB);
            PG8_BAR; PG8_WAIT_L(0); PG8_MMA(0, 1, At, B1); PG8_BAR;
            PG8_LDA(At, 1, 1); PG8_STAGE(PG8_SA(1, 0), a3, voffA);
            PG8_BAR; PG8_WAIT_L(0); PG8_MMA(1, 0, At, B0); PG8_BAR; PG8_SCHED;
            PG8_STAGE(PG8_SB(1, 1), b3 + hstep, voffB);
            PG8_WAIT_V(6); PG8_BAR; PG8_MMA(1, 1, At, B1); PG8_BAR;
            }
        }
        if constexpr (ALIGN_EPI) { if (wr == 0) PG8_BAR; }
        if constexpr (F8) {
#pragma unroll
            for (int a = 0; a < 2; ++a)
#pragma unroll
                for (int b = 0; b < 2; ++b) {
                    if (a == 0 && b == 0) asm volatile("s_nop 15\n\ts_nop 15" : "+v"(acc[0][0][0][0]), "+v"(acc[0][0][0][1]), "+v"(acc[0][0][1][0]), "+v"(acc[0][0][1][1]), "+v"(acc[0][0][2][0]), "+v"(acc[0][0][2][1]), "+v"(acc[0][0][3][0]), "+v"(acc[0][0][3][1]));
                    else asm volatile("" : "+v"(acc[a][b][0][0]), "+v"(acc[a][b][0][1]), "+v"(acc[a][b][1][0]), "+v"(acc[a][b][1][1]), "+v"(acc[a][b][2][0]), "+v"(acc[a][b][2][1]), "+v"(acc[a][b][3][0]), "+v"(acc[a][b][3][1])); }
        }
        bool run_epi = true;
        if constexpr (Sched::SPLITK) {
            if (cur.part >= 0) {
                const __amdgpu_buffer_rsrc_t prs = __builtin_amdgcn_make_buffer_rsrc((void*)S.pbuf, 0, 64 << 20, 0x00020000);
                const int pofs = __builtin_amdgcn_readfirstlane((cur.tix * cur.sp + cur.part) * 262144);
#pragma unroll
                for (int a = 0; a < 2; ++a)
#pragma unroll
                    for (int b = 0; b < 2; ++b)
#pragma unroll
                        for (int m = 0; m < 4; ++m)
#pragma unroll
                            for (int n = 0; n < 2; ++n)
                                __builtin_amdgcn_raw_buffer_store_b128(__builtin_bit_cast(u32x4, acc[a][b][m][n]), prs, ((((a * 2 + b) * 4 + m) * 2 + n) * 512 + tid) * 16, pofs, 16);
                asm volatile("s_waitcnt vmcnt(0)" ::: "memory");
                PG8_BAR;
                if (tid == 0) { const unsigned old = __hip_atomic_fetch_add(S.pcnt + cur.tix, 1u, __ATOMIC_RELAXED, __HIP_MEMORY_SCOPE_AGENT);
                    if (old == (unsigned)(cur.sp - 1)) __builtin_amdgcn_fence(__ATOMIC_ACQUIRE, "agent");
                    *(volatile PG8_LAS unsigned*)S.lflag = old; }
                asm volatile("s_waitcnt vmcnt(0) lgkmcnt(0)" ::: "memory");
                PG8_BAR;
                const unsigned arrived = *(volatile PG8_LAS unsigned*)S.lflag;
                run_epi = (arrived == (unsigned)(cur.sp - 1));
                if (run_epi) {
                    const int tofs = __builtin_amdgcn_readfirstlane(cur.tix * cur.sp * 262144);
#pragma unroll
                    for (int a = 0; a < 2; ++a)
#pragma unroll
                        for (int b = 0; b < 2; ++b)
#pragma unroll
                            for (int m = 0; m < 4; ++m)
#pragma unroll
                                for (int n = 0; n < 2; ++n)
                                    acc[a][b][m][n] = __builtin_bit_cast(f32x4, __builtin_amdgcn_raw_buffer_load_b128(prs, ((((a * 2 + b) * 4 + m) * 2 + n) * 512 + tid) * 16, tofs, 16));
                    for (int pp = 1; pp < cur.sp; ++pp) { const int qofs = __builtin_amdgcn_readfirstlane(tofs + pp * 262144);
#pragma unroll
                        for (int a = 0; a < 2; ++a)
#pragma unroll
                            for (int b = 0; b < 2; ++b) {
                                f32x4 tp[4][2];
#pragma unroll
                                for (int m = 0; m < 4; ++m)
#pragma unroll
                                    for (int n = 0; n < 2; ++n) tp[m][n] = __builtin_bit_cast(f32x4, __builtin_amdgcn_raw_buffer_load_b128(prs, ((((a * 2 + b) * 4 + m) * 2 + n) * 512 + tid) * 16, qofs, 16));
#pragma unroll
                                for (int m = 0; m < 4; ++m)
#pragma unroll
                                    for (int n = 0; n < 2; ++n) acc[a][b][m][n] += tp[m][n];
                                __builtin_amdgcn_sched_barrier(0); } }
                }
            }
        }
        if constexpr (!Epi::AFTER_DRAIN) { if (run_epi) E(acc, cur, wr, wc, fr, fq); S.done(cur); }
        if (!has_next) break;
#pragma unroll
        for (int a = 0; a < 2; ++a)
#pragma unroll
            for (int b = 0; b < 2; ++b)
#pragma unroll
                for (int m = 0; m < 4; ++m)
#pragma unroll
                    for (int n = 0; n < 2; ++n) acc[a][b][m][n] = (f32x4){0.f, 0.f, 0.f, 0.f};
        cur = nxt; cA = nA; cB = nB; ++ui;
        if constexpr (ALIGN_EPI) { if (wr == 1) PG8_BAR; }
    }
    PG8_WAIT_V(0);
    if constexpr (!ALIGN_EPI) { if (wr == 0) PG8_BAR; }
    PG8_BAR;
#undef PG8_SA
#undef PG8_SB
#undef PG8_STAGE
#undef PG8_LDA
#undef PG8_LDB
#undef PG8_MMA
#undef PG8_WAIT_V
#undef PG8_WAIT_L
#undef PG8_BAR
#undef PG8_SCHED
}
}

constexpr int NWAVES = 8;
constexpr int NB = 8, SEQ = 2048, D = 2048, M = NB * SEQ, DIN = 6144, DG = 1024, DH = 1024, FF = 5632, GU = 2 * FF, NE = 8;
constexpr int MOE_ROWS = 2 * M + NE * 256;
constexpr float EPS = 1e-6f, F_MIN = 1e-6f;

constexpr size_t MiB = 1u << 20;
constexpr size_t WS_CTL = 0, CTL_ZERO_BYTES = 1 * MiB;
constexpr size_t WS_SMALL = 1 * MiB;
constexpr size_t SM_WC = 1 * MiB;
constexpr size_t SM_TOKE = 0, SM_TOKW = 131072, SM_TOKP = 262144, SM_WHIST = 393216, SM_TS = 524288;
constexpr size_t WS_WIN = 4 * MiB;
constexpr size_t WS_WO = WS_WIN + (size_t)2 * DIN * D * 2;
constexpr size_t WS_WGU = WS_WO + (size_t)2 * D * D * 2;
constexpr size_t WS_WD = WS_WGU + (size_t)GU * D * 2;
constexpr size_t WS_EGU = WS_WD + (size_t)D * FF * 2;
constexpr size_t WS_ED = WS_EGU + (size_t)NE * GU * D * 2;
constexpr size_t WS_XN = WS_ED + (size_t)NE * D * FF * 2;
constexpr size_t WS_R = WS_XN + (size_t)M * D * 2;
constexpr size_t WS_Z = WS_R;
constexpr size_t WS_Y = WS_Z + (size_t)M * DIN * 2;
constexpr size_t WS_O = WS_Y + (size_t)M * D * 2;
constexpr size_t WS_H = WS_R;
constexpr size_t WS_XS = WS_R + (size_t)MOE_ROWS * FF * 2;
constexpr size_t WS_XS8 = WS_XS + (size_t)MOE_ROWS * D * 2;
constexpr size_t WS_END = WS_XS8 + (size_t)MOE_ROWS * D;
static_assert(WS_O + (size_t)M * DH * 4 <= WS_XS, "O inside region R");
static_assert(WS_WIN % 256 == 0 && WS_XN % 256 == 0 && WS_R % 256 == 0 && WS_XS % 256 == 0, "alignment");

constexpr int CW_BAR = 4096;

constexpr int RING_OFF = 0, RING_BYTES = 131072;
constexpr int LDSCTL_OFF = 135168, MISC_OFF = LDSCTL_OFF + 320;
constexpr int LDS_BYTES = 147456;

#define GAS __attribute__((address_space(1)))
#define LAS __attribute__((address_space(3)))
typedef unsigned short bf16;
typedef unsigned v4u __attribute__((ext_vector_type(4)));
typedef unsigned v2u __attribute__((ext_vector_type(2)));
typedef float f32x4 __attribute__((ext_vector_type(4)));
typedef float f32x2 __attribute__((ext_vector_type(2)));
typedef int i32x4 __attribute__((ext_vector_type(4)));
typedef int i32x2 __attribute__((ext_vector_type(2)));
#define LDS_WAIT() asm volatile("s_waitcnt lgkmcnt(0)" ::: "memory")
#define VM_WAIT() asm volatile("s_waitcnt vmcnt(0)" ::: "memory")
__device__ __forceinline__ unsigned f2bf(float f) { return (unsigned)__builtin_bit_cast(unsigned short, (__bf16)f); }
__device__ __forceinline__ unsigned pk2(float lo, float hi) { return pg8::cvt_pk_bf16(lo, hi); }
__device__ __forceinline__ float bflo(unsigned p) { return __builtin_bit_cast(float, p << 16); }
__device__ __forceinline__ float bfhi(unsigned p) { return __builtin_bit_cast(float, p & 0xffff0000u); }
__device__ __forceinline__ float sigmoid_f(float x) { return 1.0f / (1.0f + __expf(-x)); }
__device__ __forceinline__ float silu_x(float x) { return x / (1.0f + __expf(-x)); }
__device__ __forceinline__ float gelu_tanh(float x) { const float u = 0.7978845608028654f * (x + 0.044715f * x * x * x); return x / (1.0f + __expf(-2.0f * u)); }
template <int CTRL, int ROW_MASK> __device__ __forceinline__ float dpp_f(float v) { return __builtin_bit_cast(float, __builtin_amdgcn_update_dpp(0, __builtin_bit_cast(int, v), CTRL, ROW_MASK, 0xF, false)); }
__device__ __forceinline__ float row16_sum(float v) {
    v += dpp_f<0xB1, 0xF>(v);
    v += dpp_f<0x4E, 0xF>(v);
    v += dpp_f<0x141, 0xF>(v);
    v += dpp_f<0x140, 0xF>(v);
    return v;
}
__device__ __forceinline__ float wave_sum(float v) {
    v = row16_sum(v);
    v += dpp_f<0x142, 0xA>(v);
    v += dpp_f<0x143, 0xC>(v);
    return __builtin_bit_cast(float, __builtin_amdgcn_readlane(__builtin_bit_cast(int, v), 63));
}
__device__ __forceinline__ int wave_sum_i(int v) {
#pragma unroll
    for (int o = 1; o < 64; o <<= 1) v += __shfl_xor(v, o);
    return v;
}

#define XB_TMO      128
#define XB_XCNT(j)  (256  + 64 * (j))
#define XB_XSUB(j)  (1280 + 64 * (j))
#define XB_XGEN(j)  (2304 + 64 * (j))
#define XB_TOP      3328
#define XB_TOPGEN   3392
#define XCD_BAR_WORDS 3456
#define XB_SPIN_CAP (1u << 22)
__device__ __forceinline__ unsigned xb_ld(unsigned* p)              { return __hip_atomic_load(p, __ATOMIC_RELAXED, __HIP_MEMORY_SCOPE_AGENT); }
__device__ __forceinline__ unsigned xb_add(unsigned* p, unsigned v) { return __hip_atomic_fetch_add(p, v, __ATOMIC_RELAXED, __HIP_MEMORY_SCOPE_AGENT); }
__device__ __forceinline__ unsigned xb_xcc_id() { return (unsigned)__builtin_amdgcn_s_getreg((3 << 11) | 20) & 0xFu; }
#define XB_SPIN(cond, bar) do { unsigned _sp = 0; while (cond) { __builtin_amdgcn_s_sleep(1); \
    if ((++_sp & 255u) == 0u) { if (xb_ld(&(bar)[XB_TMO])) break; if (_sp > XB_SPIN_CAP) { atomicAdd(&(bar)[XB_TMO], 1u); break; } } } } while (0)
struct XcdBarrier { unsigned* bar; unsigned x; volatile LAS unsigned* st; };
__device__ __forceinline__ XcdBarrier xcd_barrier_post(unsigned* bar, volatile LAS unsigned* st) {
    XcdBarrier b; b.bar = bar; b.x = xb_xcc_id(); b.st = st;
    if (threadIdx.x == 0) (void)xb_add(&bar[XB_XCNT(b.x)], 1u);
    return b;
}
__device__ __forceinline__ void xcd_barrier_complete(unsigned* bar, unsigned x, unsigned& nloc, unsigned& nx) {
    const unsigned G = gridDim.x * gridDim.y * gridDim.z;
    unsigned sum, cnt, mine, sp = 0u;
    for (;;) {
        sum = 0u; cnt = 0u; mine = 0u;
#pragma unroll
        for (unsigned j = 0; j < 16; ++j) { const unsigned c = xb_ld(&bar[XB_XCNT(j)]); sum += c; cnt += (c > 0u) ? 1u : 0u; mine = (j == x) ? c : mine; }
        if (sum == G) break;
        __builtin_amdgcn_s_sleep(1);
        if ((++sp & 255u) == 0u) { if (xb_ld(&bar[XB_TMO])) break; if (sp > XB_SPIN_CAP) { atomicAdd(&bar[XB_TMO], 1u); break; } }
    }
    nloc = mine > 0u ? mine : 1u; nx = cnt > 0u ? cnt : 1u;
}
__device__ __forceinline__ void xcd_barrier(const XcdBarrier& b) {
    asm volatile("s_waitcnt vmcnt(0)" ::: "memory");
    __syncthreads();
    if (threadIdx.x == 0) {
        unsigned* bar = b.bar;
        __builtin_amdgcn_s_waitcnt(0);
        unsigned nloc = b.st[0], nx = b.st[1];
        if (nloc == 0u) { xcd_barrier_complete(bar, b.x, nloc, nx); b.st[0] = nloc; b.st[1] = nx; }
        const unsigned old = xb_add(&bar[XB_XSUB(b.x)], 1u);
        const unsigned gen = old / nloc;
        if (old + 1u == (gen + 1u) * nloc) {
            __builtin_amdgcn_fence(__ATOMIC_RELEASE, "agent");
            asm volatile("s_waitcnt vmcnt(0)" ::: "memory");
            const unsigned og = xb_add(&bar[XB_TOP], 1u);
            const unsigned tg = og / nx;
            if (og + 1u == (tg + 1u) * nx) xb_add(&bar[XB_TOPGEN], 1u);
            else XB_SPIN(xb_ld(&bar[XB_TOPGEN]) == tg, bar);
            __builtin_amdgcn_fence(__ATOMIC_ACQUIRE, "agent");
            xb_add(&bar[XB_XGEN(b.x)], 1u);
            asm volatile("s_waitcnt vmcnt(0)" ::: "memory");
        } else {
            XB_SPIN(xb_ld(&bar[XB_XGEN(b.x)]) == gen, bar);
            __builtin_amdgcn_fence(__ATOMIC_ACQUIRE, "agent");
            asm volatile("s_waitcnt vmcnt(0)" ::: "memory");
        }
    }
    __syncthreads();
}

struct Frame {
    LAS unsigned char* lds;
    int tid, lane, wave, G, gw, NGW;
    unsigned char* ws;
};

__device__ __forceinline__ void transpose_item(const float* W, int K, int N, bf16* WT, int mode, LAS float* scr, int item, int lane) {
    const int nblk = N / 32, kb = item / nblk, nb = item % nblk, k0 = 64 * kb, n0 = 32 * nb;
    const int kr = lane >> 3, nc = lane & 7;
    f32x4 v[8];
#pragma unroll
    for (int i = 0; i < 8; ++i) v[i] = *(const f32x4*)(W + (size_t)(k0 + 8 * i + kr) * N + n0 + 4 * nc);
#pragma unroll
    for (int i = 0; i < 8; ++i) { LAS float* d = scr + (8 * i + kr) * 33 + 4 * nc; d[0] = v[i].x; d[1] = v[i].y; d[2] = v[i].z; d[3] = v[i].w; }
    LDS_WAIT(); asm volatile("" ::: "memory");
    const int c = lane & 7;
    const int rbase = (mode == 0) ? n0 : (256 * (n0 >> 7) + (n0 & 127) + (mode == 2 ? 128 : 0));
#pragma unroll
    for (int j = 0; j < 4; ++j) { const int n = (lane >> 3) + 8 * j; const LAS float* s = scr + (8 * c) * 33 + n;
        v4u o; o.x = pk2(s[0 * 33], s[1 * 33]); o.y = pk2(s[2 * 33], s[3 * 33]); o.z = pk2(s[4 * 33], s[5 * 33]); o.w = pk2(s[6 * 33], s[7 * 33]);
        *(v4u*)(WT + (size_t)(rbase + n) * K + k0 + 8 * c) = o; }
    LDS_WAIT(); asm volatile("" ::: "memory");
}
__device__ __forceinline__ void conv_matrix(Frame& F, const float* W, int K, int N, bf16* WT, int mode) {
    LAS float* scr = (LAS float*)(F.lds + RING_OFF + F.wave * 16384);
    const int nitems = (K / 64) * (N / 32);
    for (int it = F.gw; it < nitems; it += F.NGW) transpose_item(W, K, N, WT, mode, scr, it, F.lane);
}
__device__ __forceinline__ void transpose_item8(const float* W, int K, int N, unsigned char* WT, int mode, float scale, LAS float* scr, int item, int lane) {
    const int nblk = N / 32, kb = item / nblk, nb = item % nblk, k0 = 64 * kb, n0 = 32 * nb;
    const int kr = lane >> 3, nc = lane & 7;
    f32x4 v[8];
#pragma unroll
    for (int i = 0; i < 8; ++i) v[i] = *(const f32x4*)(W + (size_t)(k0 + 8 * i + kr) * N + n0 + 4 * nc);
#pragma unroll
    for (int i = 0; i < 8; ++i) { LAS float* d = scr + (8 * i + kr) * 33 + 4 * nc; d[0] = v[i].x; d[1] = v[i].y; d[2] = v[i].z; d[3] = v[i].w; }
    LDS_WAIT(); asm volatile("" ::: "memory");
    const int c = lane & 7;
    const int rbase = (mode == 0) ? n0 : (256 * (n0 >> 7) + (n0 & 127) + (mode == 2 ? 128 : 0));
#pragma unroll
    for (int j = 0; j < 4; ++j) { const int n = (lane >> 3) + 8 * j; const LAS float* s = scr + (8 * c) * 33 + n;
        v2u o; o.x = pg8::pk4_fp8(s[0 * 33] * scale, s[1 * 33] * scale, s[2 * 33] * scale, s[3 * 33] * scale); o.y = pg8::pk4_fp8(s[4 * 33] * scale, s[5 * 33] * scale, s[6 * 33] * scale, s[7 * 33] * scale);
        *(v2u*)(WT + (size_t)(rbase + n) * K + k0 + 8 * c) = o; }
    LDS_WAIT(); asm volatile("" ::: "memory");
}
constexpr int CONV_CH = 8, CW_CONV = 8192;
static_assert(((D / 64) * (DIN / 32)) % CONV_CH == 0 && ((D / 64) * (D / 32)) % CONV_CH == 0 && ((D / 64) * (FF / 32)) % CONV_CH == 0 && ((FF / 64) * (D / 32)) % CONV_CH == 0, "conversion chunks must be whole");
constexpr int CW_SK = 16384, CW_GMLP = 24576, NGF = 64;
__device__ __forceinline__ void conv_load(const float* W, int N, int item, int lane, f32x4 (&v)[8]) {
    const int nblk = N / 32, kb = item / nblk, nb = item % nblk, k0 = 64 * kb, n0 = 32 * nb, kr = lane >> 3, nc = lane & 7;
#pragma unroll
    for (int i = 0; i < 8; ++i) v[i] = *(const f32x4*)(W + (size_t)(k0 + 8 * i + kr) * N + n0 + 4 * nc);
}
__device__ __forceinline__ void conv_proc(int K, int N, void* WT, int mode, float scale8, LAS float* scr, int item, int lane, const f32x4 (&v)[8]) {
    const int nblk = N / 32, kb = item / nblk, nb = item % nblk, k0 = 64 * kb, n0 = 32 * nb, kr = lane >> 3, nc = lane & 7;
#pragma unroll
    for (int i = 0; i < 8; ++i) { LAS float* d = scr + (8 * i + kr) * 33 + 4 * nc; d[0] = v[i].x; d[1] = v[i].y; d[2] = v[i].z; d[3] = v[i].w; }
    LDS_WAIT(); asm volatile("" ::: "memory");
    const int c = lane & 7;
    const int rbase = (mode == 0) ? n0 : (256 * (n0 >> 7) + (n0 & 127) + (mode == 2 ? 128 : 0));
#pragma unroll
    for (int j = 0; j < 4; ++j) { const int n = (lane >> 3) + 8 * j; const LAS float* s = scr + (8 * c) * 33 + n;
        if (scale8 != 0.f) { v2u o; o.x = pg8::pk4_fp8(s[0 * 33] * scale8, s[1 * 33] * scale8, s[2 * 33] * scale8, s[3 * 33] * scale8); o.y = pg8::pk4_fp8(s[4 * 33] * scale8, s[5 * 33] * scale8, s[6 * 33] * scale8, s[7 * 33] * scale8);
            *(v2u*)((unsigned char*)WT + (size_t)(rbase + n) * K + k0 + 8 * c) = o; }
        else { v4u o; o.x = pk2(s[0 * 33], s[1 * 33]); o.y = pk2(s[2 * 33], s[3 * 33]); o.z = pk2(s[4 * 33], s[5 * 33]); o.w = pk2(s[6 * 33], s[7 * 33]);
            *(v4u*)((bf16*)WT + (size_t)(rbase + n) * K + k0 + 8 * c) = o; } }
    LDS_WAIT(); asm volatile("" ::: "memory");
}
__device__ __forceinline__ void conv_queue(Frame& F, int job, const float* W, int K, int N, void* WT, int mode, float scale8 = 0.f) {
    LAS float* scr = (LAS float*)(F.lds + RING_OFF + F.wave * 16384);
    unsigned* ctr = (unsigned*)(F.ws + WS_CTL) + CW_CONV + 64 * job;
    const int nitems = (K / 64) * (N / 32), nch = nitems / CONV_CH;
    for (;;) {
        unsigned c = 0; if (F.lane == 0) c = __hip_atomic_fetch_add(ctr, 1u, __ATOMIC_RELAXED, __HIP_MEMORY_SCOPE_AGENT);
        c = __builtin_amdgcn_readfirstlane(c);
        if ((int)c >= nch) break;
        const int i0 = (int)c * CONV_CH, ilast = i0 + CONV_CH - 1;
        f32x4 va[8], vb[8];
        conv_load(W, N, i0, F.lane, va);
#pragma unroll 1
        for (int it = i0; it < i0 + CONV_CH; it += 2) {
            conv_load(W, N, it + 1, F.lane, vb);
            conv_proc(K, N, WT, mode, scale8, scr, it, F.lane, va);
            conv_load(W, N, it + 2 < ilast ? it + 2 : ilast, F.lane, va);
            conv_proc(K, N, WT, mode, scale8, scr, it + 1, F.lane, vb);
        }
    }
}

__device__ __forceinline__ void norm_row(const float* xrow, const float* gain, int lane, f32x4 (&v)[8]) {
    const f32x4* xr = (const f32x4*)xrow + lane; float s = 0.f;
#pragma unroll
    for (int j = 0; j < 8; ++j) { v[j] = xr[64 * j]; s += (v[j].x * v[j].x + v[j].y * v[j].y) + (v[j].z * v[j].z + v[j].w * v[j].w); }
    const float rstd = 1.0f / sqrtf(wave_sum(s) * (1.0f / D) + EPS);
    const f32x4* gr = (const f32x4*)gain + lane;
#pragma unroll
    for (int j = 0; j < 8; ++j) v[j] = v[j] * rstd * gr[64 * j];
}
__device__ __forceinline__ void store_row_bf16(bf16* orow, int lane, const f32x4 (&v)[8]) {
    v2u* o8 = (v2u*)orow + lane;
#pragma unroll
    for (int j = 0; j < 8; ++j) { v2u w; w.x = pk2(v[j].x, v[j].y); w.y = pk2(v[j].z, v[j].w); o8[64 * j] = w; }
}


__device__ __forceinline__ void norm_row_b(const bf16* xrow, const float* gain, int lane, f32x4 (&v)[8]) {
    const v4u* xr = (const v4u*)xrow + lane; float s = 0.f;
#pragma unroll
    for (int j = 0; j < 4; ++j) { const v4u t = xr[64 * j]; v[2 * j] = (f32x4){bflo(t.x), bfhi(t.x), bflo(t.y), bfhi(t.y)}; v[2 * j + 1] = (f32x4){bflo(t.z), bfhi(t.z), bflo(t.w), bfhi(t.w)}; }
#pragma unroll
    for (int j = 0; j < 8; ++j) s += (v[j].x * v[j].x + v[j].y * v[j].y) + (v[j].z * v[j].z + v[j].w * v[j].w);
    const float rstd = 1.0f / sqrtf(wave_sum(s) * (1.0f / D) + EPS);
    const f32x4* gr = (const f32x4*)gain + 2 * lane;
#pragma unroll
    for (int j = 0; j < 4; ++j) { v[2 * j] = v[2 * j] * rstd * gr[128 * j]; v[2 * j + 1] = v[2 * j + 1] * rstd * gr[128 * j + 1]; }
}
__device__ __forceinline__ void load_raw_b(const bf16* xrow, int lane, v4u (&t)[4]) { const v4u* xr = (const v4u*)xrow + lane;
#pragma unroll
    for (int j = 0; j < 4; ++j) t[j] = xr[64 * j]; }
__device__ __forceinline__ void load_gain_b(const float* gain, int lane, f32x4 (&g)[8]) { const f32x4* gr = (const f32x4*)gain + 2 * lane;
#pragma unroll
    for (int j = 0; j < 4; ++j) { g[2 * j] = gr[128 * j]; g[2 * j + 1] = gr[128 * j + 1]; } }
__device__ __forceinline__ void norm_raw_b(const v4u (&t)[4], const f32x4 (&g)[8], f32x4 (&v)[8]) {
    float s = 0.f;
#pragma unroll
    for (int j = 0; j < 4; ++j) { v[2 * j] = (f32x4){bflo(t[j].x), bfhi(t[j].x), bflo(t[j].y), bfhi(t[j].y)}; v[2 * j + 1] = (f32x4){bflo(t[j].z), bfhi(t[j].z), bflo(t[j].w), bfhi(t[j].w)}; }
#pragma unroll
    for (int j = 0; j < 8; ++j) s += (v[j].x * v[j].x + v[j].y * v[j].y) + (v[j].z * v[j].z + v[j].w * v[j].w);
    const float rstd = 1.0f / sqrtf(wave_sum(s) * (1.0f / D) + EPS);
#pragma unroll
    for (int j = 0; j < 8; ++j) v[j] = v[j] * rstd * g[j];
}
__device__ __forceinline__ void load_raw_f(const float* xrow, int lane, f32x4 (&t)[8]) { const f32x4* xr = (const f32x4*)xrow + lane;
#pragma unroll
    for (int j = 0; j < 8; ++j) t[j] = xr[64 * j]; }
__device__ __forceinline__ void norm_raw_f(const f32x4 (&t)[8], const f32x4 (&g)[8], f32x4 (&v)[8]) {
    float s = 0.f;
#pragma unroll
    for (int j = 0; j < 8; ++j) s += (t[j].x * t[j].x + t[j].y * t[j].y) + (t[j].z * t[j].z + t[j].w * t[j].w);
    const float rstd = 1.0f / sqrtf(wave_sum(s) * (1.0f / D) + EPS);
#pragma unroll
    for (int j = 0; j < 8; ++j) v[j] = t[j] * rstd * g[j];
}
__device__ __forceinline__ void store_row_bf16_b(bf16* orow, int lane, const f32x4 (&v)[8]) {
    v4u* o = (v4u*)orow + lane;
#pragma unroll
    for (int j = 0; j < 4; ++j) { v4u w; w.x = pk2(v[2 * j].x, v[2 * j].y); w.y = pk2(v[2 * j].z, v[2 * j].w); w.z = pk2(v[2 * j + 1].x, v[2 * j + 1].y); w.w = pk2(v[2 * j + 1].z, v[2 * j + 1].w); o[64 * j] = w; }
}

typedef short bf16x8v __attribute__((ext_vector_type(8)));
typedef short s16x4 __attribute__((ext_vector_type(4)));
constexpr int RS = 272;
__device__ __forceinline__ unsigned nat_base(unsigned lane) { return (lane & 15u) * RS + (lane >> 4) * 16u; }
__device__ __forceinline__ constexpr unsigned nat_off(unsigned rb, unsigned s) { return rb * 16u * RS + s * 64u; }
__device__ __forceinline__ unsigned tr_base(unsigned lane) { return (8u * (lane >> 4) + ((lane & 15u) >> 2)) * RS + (lane & 3u) * 8u; }
__device__ __forceinline__ constexpr unsigned tr_off(unsigned c, unsigned ks, unsigned t) { return (32u * ks + 4u * t) * RS + 32u * c; }
__device__ __forceinline__ bf16x8v tr_frag(LAS unsigned char* p, unsigned c, unsigned ks) {
    const s16x4 a = __builtin_amdgcn_ds_read_tr16_b64_v4i16((LAS s16x4*)(p + tr_off(c, ks, 0)));
    const s16x4 b = __builtin_amdgcn_ds_read_tr16_b64_v4i16((LAS s16x4*)(p + tr_off(c, ks, 1)));
    return __builtin_shufflevector(a, b, 0, 1, 2, 3, 4, 5, 6, 7);
}
__device__ __forceinline__ f32x4 mfma16(bf16x8v a, bf16x8v b, f32x4 c) { return __builtin_amdgcn_mfma_f32_16x16x32_bf16(a, b, c, 0, 0, 0); }
__device__ __forceinline__ f32x4 zero4() { f32x4 z = (f32x4){0.f, 0.f, 0.f, 0.f}; asm volatile("" : "+v"(z)); return z; }
__device__ __forceinline__ bf16x8v pack8(f32x4 a, f32x4 b) { v4u w; w.x = pg8::cvt_pk_bf16(a[0], a[1]); w.y = pg8::cvt_pk_bf16(a[2], a[3]); w.z = pg8::cvt_pk_bf16(b[0], b[1]); w.w = pg8::cvt_pk_bf16(b[2], b[3]); return __builtin_bit_cast(bf16x8v, w); }

__device__ __forceinline__ void gmlp_unit(Frame& F, const bf16* Z, bf16* Y, const bf16* Wc, const float* ln_w, const float* ln_b, const float* b_s, const float* out_w, int u) {
    const int h = u & 7, n = (u >> 3) & 15, b = u >> 7; const size_t row0 = (size_t)b * SEQ + n * 128;
    LAS unsigned char* VT = F.lds; LAS unsigned char* WT = F.lds + 128 * RS;
    const int lane = F.lane, w = F.wave, g = lane >> 4, lr = lane & 15;
    {
        const f32x2 lw = ((const f32x2*)(ln_w + h * 128))[lane], lb = ((const f32x2*)(ln_b + h * 128))[lane];
        unsigned pk[16];
#pragma unroll
        for (int i = 0; i < 16; ++i) pk[i] = ((const unsigned*)(Z + (row0 + 16 * w + i) * DIN + DG + h * 128))[lane];
#pragma unroll
        for (int i = 0; i < 16; ++i) { const pg8::f32x2c gv2 = pg8::gelu_2((pg8::f32x2c){bflo(pk[i]), bfhi(pk[i])}); const float a = gv2.x, c = gv2.y;
            const float mu = wave_sum(a + c) * (1.0f / 128.0f); const float da = a - mu, dc = c - mu;
            const float var = wave_sum(da * da + dc * dc) * (1.0f / 128.0f); const float rs = 1.0f / sqrtf(var + EPS);
            *(LAS unsigned*)(VT + (16 * w + i) * RS + lane * 4) = pk2(da * rs * lw.x + lb.x, dc * rs * lw.y + lb.y); }
        v4u wt4[4];
#pragma unroll
        for (int i = 0; i < 4; ++i) { const int nn = F.tid + 512 * i, row = nn >> 4, ch = nn & 15; wt4[i] = *(const v4u*)(Wc + (size_t)h * 16384 + row * 128 + ch * 8); }
#pragma unroll
        for (int i = 0; i < 4; ++i) { const int nn = F.tid + 512 * i, row = nn >> 4, ch = nn & 15; *(LAS v4u*)(WT + row * RS + ch * 16) = wt4[i]; }
    }
    __syncthreads();
    f32x4 acc[8];
#pragma unroll
    for (int ct = 0; ct < 8; ++ct) acc[ct] = zero4();
    LAS unsigned char* vtr = VT + tr_base(lane); LAS unsigned char* wnb = WT + nat_base(lane) + w * 16 * RS;
#pragma unroll
    for (int ks = 0; ks < 4; ++ks) {
        const bf16x8v Bf = *(const LAS bf16x8v*)(wnb + nat_off(0, ks));
#pragma unroll
        for (int ct = 0; ct < 8; ++ct) { const bf16x8v Af = tr_frag(vtr, ct, ks); acc[ct] = mfma16(Af, Bf, acc[ct]); }
    }
    const int t = 16 * w + lr; const size_t row = row0 + t; const float bs = b_s[h * 128 + t];
    float ss = 0.f;
#pragma unroll
    for (int ct = 0; ct < 8; ++ct) { const v2u up = *(const v2u*)(Z + row * DIN + h * 128 + 16 * ct + 4 * g);
        const pg8::f32x2c ua = pg8::gelu_2((pg8::f32x2c){bflo(up.x), bfhi(up.x)}), ub = pg8::gelu_2((pg8::f32x2c){bflo(up.y), bfhi(up.y)});
        f32x4 y; y[0] = ua.x * (acc[ct][0] + bs); y[1] = ua.y * (acc[ct][1] + bs); y[2] = ub.x * (acc[ct][2] + bs); y[3] = ub.y * (acc[ct][3] + bs);
        acc[ct] = y; ss += (y[0] * y[0] + y[1] * y[1]) + (y[2] * y[2] + y[3] * y[3]); }
    f32x4 ow[8];
#pragma unroll
    for (int ct = 0; ct < 8; ++ct) ow[ct] = *(const f32x4*)(out_w + h * 128 + 16 * ct + 4 * g);
    ss += __shfl_xor(ss, 16); ss += __shfl_xor(ss, 32);
    const float rs = __builtin_amdgcn_rsqf(ss * (1.0f / 128.0f) + EPS);
#pragma unroll
    for (int ct = 0; ct < 8; ++ct) { v2u o;
        o.x = pk2(acc[ct][0] * rs * ow[ct][0], acc[ct][1] * rs * ow[ct][1]); o.y = pk2(acc[ct][2] * rs * ow[ct][2], acc[ct][3] * rs * ow[ct][3]);
        *(v2u*)(Y + row * D + h * 128 + 16 * ct + 4 * g) = o; }
    __syncthreads();
}

__device__ __forceinline__ void hgrn_item(Frame& F, const bf16* Z, bf16* Y, const float* out_w, int b, int h) {
    LAS unsigned char* Lb = F.lds;
    constexpr int QT = 0, KT = 64 * RS, IT = 128 * RS, PT = 192 * RS, EMo = PT + 64 * 144, ELo = EMo + 512, ELMo = ELo + 512, SEGo = ELMo + 512, NSo = SEGo + 4096, OTo = NSo + 2048, OWo = OTo + 64 * RS;
    static_assert(OWo + 512 <= RING_BYTES, "hgrn LDS map");
    const int lane = F.lane, w = F.wave, g = lane >> 4, lr = lane & 15, dp = lane, seg = w;
    f32x4 Sacc[8];
#pragma unroll
    for (int i = 0; i < 8; ++i) Sacc[i] = zero4();
    LAS unsigned char* q_nat = Lb + QT + nat_base(lane); LAS unsigned char* k_nat = Lb + KT + nat_base(lane);
    LAS unsigned char* k_tr = Lb + KT + tr_base(lane); LAS unsigned char* i_tr = Lb + IT + tr_base(lane);
    LAS unsigned char* p_rd = Lb + PT + lr * 144 + g * 16; LAS unsigned char* p_wr = Lb + PT + lr * 144 + g * 8;
    LAS unsigned char* q_in = Lb + QT + lr * RS + g * 8;
    unsigned rq[8], rg[8]; v4u ri[2];
    const __amdgpu_buffer_rsrc_t zrs = __builtin_amdgcn_make_buffer_rsrc((void*)Z, 0, (int)((size_t)M * DIN * 2), 0x00020000);
    const int vq = (2 * DG + h * 128 + 2 * dp) * 2;
    int vi[2];
#pragma unroll
    for (int i = 0; i < 2; ++i) { const int nn = F.tid + 512 * i, row = nn >> 4, ch = nn & 15; vi[i] = row * (DIN * 2) + (2 * DG + 2 * DH + h * 128 + ch * 8) * 2; }
#define HGRN_LOAD_G(cc) do { const int _s0 = __builtin_amdgcn_readfirstlane((int)(((size_t)b * SEQ + (size_t)(cc) * 64) * (DIN * 2))); \
        _Pragma("unroll") for (int r = 0; r < 8; ++r) rg[r] = (unsigned)__builtin_amdgcn_raw_buffer_load_b32(zrs, vq + DH * 2, _s0 + (8 * seg + r) * (DIN * 2), 0); } while (0)
#define HGRN_LOAD_Q(cc) do { const int _s0 = __builtin_amdgcn_readfirstlane((int)(((size_t)b * SEQ + (size_t)(cc) * 64) * (DIN * 2))); \
        _Pragma("unroll") for (int r = 0; r < 8; ++r) rq[r] = (unsigned)__builtin_amdgcn_raw_buffer_load_b32(zrs, vq, _s0 + (8 * seg + r) * (DIN * 2), 0); } while (0)
    if (F.tid < 32) *(LAS f32x4*)(Lb + OWo + F.tid * 16) = *(const f32x4*)(out_w + h * 128 + F.tid * 4);
    HGRN_LOAD_G(0); HGRN_LOAD_Q(0);
#define HGRN_OUTPUT(cc) do { const size_t _r0 = (size_t)b * SEQ + (size_t)(cc) * 64; \
        _Pragma("unroll") for (int i = 0; i < 2; ++i) { const int nn = F.tid + 512 * i, t = nn >> 4, ch = nn & 15; \
            const f32x4 n0 = *(const LAS f32x4*)(Lb + NSo + t * 32), n1 = *(const LAS f32x4*)(Lb + NSo + t * 32 + 16); \
            const float ssum = ((n0[0] + n0[1]) + (n0[2] + n0[3])) + ((n1[0] + n1[1]) + (n1[2] + n1[3])); \
            const float rs = __builtin_amdgcn_rsqf(ssum * (1.0f / 128.0f) + EPS); \
            const v4u ov = *(const LAS v4u*)(Lb + OTo + t * RS + ch * 16); \
            const v4u gv = gvc[i]; \
            const f32x4 w0 = *(const LAS f32x4*)(Lb + OWo + ch * 32), w1 = *(const LAS f32x4*)(Lb + OWo + ch * 32 + 16); \
            v4u yv; \
            yv.x = pk2(bflo(ov.x) * rs * w0[0] * bflo(gv.x), bfhi(ov.x) * rs * w0[1] * bfhi(gv.x)); yv.y = pk2(bflo(ov.y) * rs * w0[2] * bflo(gv.y), bfhi(ov.y) * rs * w0[3] * bfhi(gv.y)); \
            yv.z = pk2(bflo(ov.z) * rs * w1[0] * bflo(gv.z), bfhi(ov.z) * rs * w1[1] * bfhi(gv.z)); yv.w = pk2(bflo(ov.w) * rs * w1[2] * bflo(gv.w), bfhi(ov.w) * rs * w1[3] * bfhi(gv.w)); \
            *(v4u*)(Y + (_r0 + t) * D + DG + h * 128 + ch * 8) = yv; } } while (0)
    v4u gvc[2];
    for (int c = 0; c < SEQ / 64; ++c) {
        const size_t r0 = (size_t)b * SEQ + c * 64;
        float pre0 = 0.f, pre1 = 0.f, mid0 = 0.f, mid1 = 0.f, tot0 = 0.f, tot1 = 0.f;
        {
            const int s0c = __builtin_amdgcn_readfirstlane((int)(r0 * (DIN * 2)));
            float s0 = 0.f, s1 = 0.f;
#pragma unroll
            for (int r = 0; r < 8; ++r) { s0 += bflo(rg[r]); s1 += bfhi(rg[r]); }
            *(LAS f32x2*)(Lb + SEGo + (seg * 128 + 2 * dp) * 4) = (f32x2){s0, s1};
#pragma unroll
            for (int i = 0; i < 2; ++i) ri[i] = __builtin_bit_cast(v4u, __builtin_amdgcn_raw_buffer_load_b128(zrs, vi[i], s0c, 0));
            __syncthreads();
            if (c > 0) HGRN_OUTPUT(c - 1);
#pragma unroll
            for (int i = 0; i < 2; ++i) gvc[i] = __builtin_bit_cast(v4u, __builtin_amdgcn_raw_buffer_load_b128(zrs, vi[i] + DH * 2, s0c, 0));
#pragma unroll
            for (int sg = 0; sg < 8; ++sg) { const f32x2 t = *(const LAS f32x2*)(Lb + SEGo + (sg * 128 + 2 * dp) * 4);
                if (sg < seg) { pre0 += t.x; pre1 += t.y; } if (sg < 4) { mid0 += t.x; mid1 += t.y; } tot0 += t.x; tot1 += t.y; }
            float aa0 = pre0, aa1 = pre1;
#pragma unroll
            for (int r = 0; r < 8; ++r) {
                const float g0 = bflo(rg[r]), g1 = bfhi(rg[r]); aa0 += g0; aa1 += g1;
                const float k0 = 1.0f - __expf(g0), k1 = 1.0f - __expf(g1);
                const float q0 = bflo(rq[r]) * __expf(aa0 - mid0), q1 = bfhi(rq[r]) * __expf(aa1 - mid1);
                const float kk0 = k0 * __expf(mid0 - aa0), kk1 = k1 * __expf(mid1 - aa1);
                const unsigned o = (8 * seg + r) * RS + dp * 4;
                *(LAS unsigned*)(Lb + QT + o) = pk2(q0, q1); *(LAS unsigned*)(Lb + KT + o) = pk2(kk0, kk1);
                if (r & 1) __builtin_amdgcn_sched_barrier(0);
            }
#pragma unroll
            for (int i = 0; i < 2; ++i) { const int nn = F.tid + 512 * i, row = nn >> 4, ch = nn & 15; *(LAS v4u*)(Lb + IT + row * RS + ch * 16) = ri[i]; }
            if (seg == 0) { *(LAS f32x2*)(Lb + EMo + 8 * dp) = (f32x2){__expf(mid0), __expf(mid1)}; *(LAS f32x2*)(Lb + ELo + 8 * dp) = (f32x2){__expf(tot0), __expf(tot1)};
                *(LAS f32x2*)(Lb + ELMo + 8 * dp) = (f32x2){__expf(tot0 - mid0), __expf(tot1 - mid1)}; }
            if (c + 1 < SEQ / 64) { HGRN_LOAD_G(c + 1); HGRN_LOAD_Q(c + 1); }
        }
        __syncthreads();
#pragma unroll
        for (int it = 0; it < 2; ++it) { const int idx = w + 8 * it, tt = idx >> 2, st = idx & 3;
            f32x4 d = zero4();
#pragma unroll
            for (int ks = 0; ks < 4; ++ks) { const bf16x8v Af = *(const LAS bf16x8v*)(k_nat + st * 16 * RS + nat_off(0, ks)); const bf16x8v Bf = *(const LAS bf16x8v*)(q_nat + tt * 16 * RS + nat_off(0, ks));
                d = mfma16(Af, Bf, d); }
            const int sdiff = 16 * (st - tt) + 4 * g - lr;
#pragma unroll
            for (int r = 0; r < 4; ++r) d[r] = (sdiff + r > 0) ? 0.f : d[r];
            v2u pk; pk.x = pk2(d[0], d[1]); pk.y = pk2(d[2], d[3]);
            *(LAS v2u*)(p_wr + tt * 16 * 144 + st * 32) = pk;
        }
        __syncthreads();
        bf16x8v If[2];
#pragma unroll
        for (int ks = 0; ks < 2; ++ks) If[ks] = tr_frag(i_tr + w * 32, 0, ks);
        f32x4 acc[4];
#pragma unroll
        for (int tt = 0; tt < 4; ++tt) acc[tt] = zero4();
#pragma unroll
        for (int tt = 0; tt < 4; ++tt)
#pragma unroll
            for (int ks = 0; ks < 2; ++ks) if (32 * ks <= 16 * tt + 15) { const bf16x8v Af = *(const LAS bf16x8v*)(p_rd + tt * 16 * 144 + ks * 64);
                acc[tt] = mfma16(Af, If[ks], acc[tt]); }
        __builtin_amdgcn_sched_barrier(0);
#pragma unroll
        for (int kk = 0; kk < 4; ++kk) {
            const f32x4 em0 = *(const LAS f32x4*)(Lb + EMo + (32 * kk + 4 * g) * 4), em1 = *(const LAS f32x4*)(Lb + EMo + (32 * kk + 16 + 4 * g) * 4);
            const bf16x8v Bf = pack8(Sacc[2 * kk] * em0, Sacc[2 * kk + 1] * em1);
#pragma unroll
            for (int tt = 0; tt < 4; ++tt) {
                const v2u x0 = *(const LAS v2u*)(q_in + tt * 16 * RS + kk * 64), x1 = *(const LAS v2u*)(q_in + tt * 16 * RS + kk * 64 + 32);
                v4u xa; xa.x = x0.x; xa.y = x0.y; xa.z = x1.x; xa.w = x1.y;
                acc[tt] = mfma16(__builtin_bit_cast(bf16x8v, xa), Bf, acc[tt]); }
            __builtin_amdgcn_sched_barrier(0);
        }
#pragma unroll
        for (int dt = 0; dt < 8; ++dt) { f32x4 La = zero4();
#pragma unroll
            for (int ks = 0; ks < 2; ++ks) { const bf16x8v Af = tr_frag(k_tr, dt, ks); La = mfma16(Af, If[ks], La); }
            const f32x4 el = *(const LAS f32x4*)(Lb + ELo + (16 * dt + 4 * g) * 4), elm = *(const LAS f32x4*)(Lb + ELMo + (16 * dt + 4 * g) * 4);
            Sacc[dt] = el * Sacc[dt] + elm * La;
            __builtin_amdgcn_sched_barrier(0); }
#pragma unroll
        for (int tt = 0; tt < 4; ++tt)
#pragma unroll
            for (int r = 0; r < 4; ++r) { const float p = row16_sum(acc[tt][r] * acc[tt][r]);
                if (lr == 0) *(LAS float*)(Lb + NSo + ((16 * tt + 4 * g + r) * 8 + w) * 4) = p;
                *(LAS unsigned short*)(Lb + OTo + (16 * tt + 4 * g + r) * RS + (16 * w + lr) * 2) = (unsigned short)f2bf(acc[tt][r]); }
    }
    __syncthreads();
    HGRN_OUTPUT(SEQ / 64 - 1);
#undef HGRN_LOAD_G
#undef HGRN_LOAD_Q
#undef HGRN_OUTPUT
    __syncthreads();
}

struct Args { const float* in[20]; float* out; unsigned char* ws; int ph_lo, ph_hi; };
constexpr int NPHASE = 17;

#define IN(k) (lo <= (k) && (k) < hi)
#define SEAM(k) do { if (IN(k) && IN((k) + 1)) xcd_barrier(bar); } while (0)
#define ROWS8(LOAD, PROC) do { LOAD(0, 0); LOAD(1, 1); PROC(0, 0); LOAD(0, 2); PROC(1, 1); LOAD(1, 3); PROC(0, 2); LOAD(0, 4); PROC(1, 3); LOAD(1, 5); PROC(0, 4); LOAD(0, 6); PROC(1, 5); LOAD(1, 7); PROC(0, 6); PROC(1, 7); } while (0)
template <int l> __device__ __forceinline__ void layer_phases(Frame& F, const Args& args, const XcdBarrier& bar, const int lo, const int hi) {
    unsigned char* ws = F.ws; float* out = args.out;
    bf16* XN = (bf16*)(ws + WS_XN); bf16* Z = (bf16*)(ws + WS_Z); bf16* Y = (bf16*)(ws + WS_Y); float* O = (float*)(ws + WS_O); bf16* H = (bf16*)(ws + WS_H);
        const int pb = 1 + 7 * l;
        bf16* XR = (bf16*)(ws + WS_O);
        if (IN(pb + 0)) {
            f32x4 gn[8];
            if constexpr (l == 0) {
#pragma unroll
                for (int j = 0; j < 8; ++j) gn[j] = ((const f32x4*)args.in[1] + F.lane)[64 * j];
                if (F.NGW * 8 == M) {
                    f32x4 rf[2][8];
#define PN0_LOAD(slot, r) load_raw_f(args.in[0] + (size_t)(F.gw + (r) * F.NGW) * D, F.lane, rf[slot])
#define PN0_PROC(slot, r) do { f32x4 v[8]; norm_raw_f(rf[slot], gn, v); store_row_bf16(XN + (size_t)(F.gw + (r) * F.NGW) * D, F.lane, v); } while (0)
                    ROWS8(PN0_LOAD, PN0_PROC);
#undef PN0_LOAD
#undef PN0_PROC
                } else {
                f32x4 rc[8]; if (F.gw < M) load_raw_f(args.in[0] + (size_t)F.gw * D, F.lane, rc);
                for (int m = F.gw; m < M; m += F.NGW) { f32x4 rn[8], v[8];
#pragma unroll
                    for (int j = 0; j < 8; ++j) rn[j] = rc[j];
                    if (m + F.NGW < M) load_raw_f(args.in[0] + (size_t)(m + F.NGW) * D, F.lane, rn);
                    norm_raw_f(rc, gn, v); store_row_bf16(XN + (size_t)m * D, F.lane, v);
#pragma unroll
                    for (int j = 0; j < 8; ++j) rc[j] = rn[j]; }
                }
            } else {
                load_gain_b(args.in[1] + l * D, F.lane, gn);
                if (F.NGW * 8 == M) {
                    v4u rs[2][4];
#define PN1_LOAD(slot, r) load_raw_b(XR + (size_t)(F.gw + (r) * F.NGW) * D, F.lane, rs[slot])
#define PN1_PROC(slot, r) do { f32x4 v[8]; norm_raw_b(rs[slot], gn, v); store_row_bf16_b(XN + (size_t)(F.gw + (r) * F.NGW) * D, F.lane, v); } while (0)
                    ROWS8(PN1_LOAD, PN1_PROC);
#undef PN1_LOAD
#undef PN1_PROC
                } else {
                v4u rc[4]; if (F.gw < M) load_raw_b(XR + (size_t)F.gw * D, F.lane, rc);
                for (int m = F.gw; m < M; m += F.NGW) { v4u rn[4]; f32x4 v[8];
#pragma unroll
                    for (int j = 0; j < 4; ++j) rn[j] = rc[j];
                    if (m + F.NGW < M) load_raw_b(XR + (size_t)(m + F.NGW) * D, F.lane, rn);
                    norm_raw_b(rc, gn, v); store_row_bf16_b(XN + (size_t)m * D, F.lane, v);
#pragma unroll
                    for (int j = 0; j < 4; ++j) rc[j] = rn[j]; }
                }
            }
        }
        SEAM(pb + 0);
        if (IN(pb + 1)) {
            pg8::Gemm g{XN, (bf16*)(ws + WS_WIN) + (size_t)l * DIN * D, 2 * D}; pg8::StaticOrder S; S.init(M, DIN, F.G, (int)blockIdx.x);
            pg8::EpiZ E{Z, DIN, args.in[8], l};
            pg8::gemm_phase<pg8::EpiZ, pg8::StaticOrder, true, true>(F.lds + RING_OFF, g, S, E);
        }
        SEAM(pb + 1);
        if (IN(pb + 2)) for (int rep = 0; rep < REP_MIX; ++rep) {
            const int nh = (F.G >= 128) ? 64 : 0;
            if (nh == 0 || (int)blockIdx.x < nh) for (int it = blockIdx.x; it < NB * 8; it += (nh ? nh : F.G)) hgrn_item(F, Z, Y, args.in[9] + l * DH, it >> 3, it & 7);
        }
        auto gmlp_pull = [&]() {
            unsigned* gctr = (unsigned*)(ws + WS_CTL) + CW_GMLP + 64 * l; volatile LAS unsigned* gw = (volatile LAS unsigned*)(F.lds + MISC_OFF + 96);
            for (;;) {
                __syncthreads();
                if (F.tid == 0) *gw = __hip_atomic_fetch_add(gctr, 1u, __ATOMIC_RELAXED, __HIP_MEMORY_SCOPE_AGENT);
                __syncthreads();
                const int u = (int)*gw;
                if (u >= NB * 16 * 8) break;
                gmlp_unit(F, Z, Y, (const bf16*)(ws + WS_SMALL + SM_WC) + (size_t)l * 8 * 16384, args.in[5] + l * DG, args.in[6] + l * DG, args.in[4] + l * DG, args.in[7] + l * DG, u);
            }
        };
        if (IN(pb + 2)) { const int nh = (F.G >= 128) ? 64 : 0; if ((int)blockIdx.x >= nh && (int)blockIdx.x < nh + NGF) gmlp_pull(); }
        if (IN(pb + 2)) {
            bf16* WIN = (bf16*)(ws + WS_WIN); bf16* WO = (bf16*)(ws + WS_WO); bf16* WGU = (bf16*)(ws + WS_WGU); bf16* WD = (bf16*)(ws + WS_WD); bf16* EGU = (bf16*)(ws + WS_EGU); bf16* ED = (bf16*)(ws + WS_ED);
            if constexpr (l == 0) {
                conv_queue(F, 0, args.in[2] + (size_t)D * DIN, D, DIN, WIN + (size_t)DIN * D, 0); conv_queue(F, 1, args.in[10] + (size_t)D * D, D, D, WO + (size_t)D * D, 0);
                conv_queue(F, 2, args.in[12], D, FF, WGU, 1, (DENSE_F8 == 1 || DENSE_F8 == 3) ? pg8::F8_SW1 : 0.f); conv_queue(F, 3, args.in[13], D, FF, WGU, 2, (DENSE_F8 == 1 || DENSE_F8 == 3) ? pg8::F8_SW1 : 0.f); conv_queue(F, 4, args.in[14], FF, D, WD, 0, (DENSE_F8 == 1 || DENSE_F8 == 2) ? pg8::F8_SW2 : 0.f);
            }
            for (int e = (l == 0 ? 0 : 3); e < (l == 0 ? 3 : NE); ++e) {
                unsigned char* EGU8 = (unsigned char*)(ws + WS_EGU); unsigned char* ED8 = (unsigned char*)(ws + WS_ED);
                conv_queue(F, 8 + 3 * e, args.in[16] + (size_t)e * D * FF, D, FF, EGU8 + (size_t)e * GU * D, 1, pg8::F8_SW1); conv_queue(F, 9 + 3 * e, args.in[17] + (size_t)e * D * FF, D, FF, EGU8 + (size_t)e * GU * D, 2, pg8::F8_SW1);
                conv_queue(F, 10 + 3 * e, args.in[18] + (size_t)e * FF * D, FF, D, ED8 + (size_t)e * D * FF, 0, pg8::F8_SW2); }
            gmlp_pull();
        }
        SEAM(pb + 2);
        if (IN(pb + 3)) {
            pg8::Gemm g{Y, (bf16*)(ws + WS_WO) + (size_t)l * D * D, 2 * D}; pg8::StaticOrder S; S.init(M, D, F.G, (int)blockIdx.x);
            if constexpr (l == 0) { pg8::EpiResidB<true> E{args.in[0], XR, D, 1.0f}; pg8::gemm_phase<pg8::EpiResidB<true>, pg8::StaticOrder, true, true>(F.lds + RING_OFF, g, S, E); }
            else { pg8::EpiResidB<false> E{XR, XR, D, 1.0f}; pg8::gemm_phase<pg8::EpiResidB<false>, pg8::StaticOrder, true, true>(F.lds + RING_OFF, g, S, E); }
        }
        SEAM(pb + 3);
        if (IN(pb + 4)) {
            int hc[8];
#pragma unroll
            for (int e = 0; e < 8; ++e) hc[e] = 0;
            if constexpr (l == 1) {
                f32x4 rv8[8];
#pragma unroll
                for (int j = 0; j < 8; ++j) { const int c = F.tid + j * (NWAVES * 64), k = c >> 1, hh = c & 1; rv8[j] = *(const f32x4*)(args.in[15] + (size_t)k * 8 + 4 * hh); }
#pragma unroll
                for (int j = 0; j < 8; ++j) { const int c = F.tid + j * (NWAVES * 64), k = c >> 1, hh = c & 1;
                    *(LAS f32x4*)(F.lds + ((((k >> 9) * 8 + (k & 7)) * 2 + hh) << 10) + ((k >> 3) & 63) * 16) = rv8[j]; }
                __syncthreads();
            }
            f32x4 gn[8]; load_gain_b(args.in[11] + l * D, F.lane, gn);
            auto ffn_row = [&](const v4u (&raw)[4], const int m) {
                f32x4 v[8]; norm_raw_b(raw, gn, v);
                if constexpr (l == 0) {
                    if constexpr (DENSE_F8 == 3) { v2u* d8 = (v2u*)(ws + WS_XS8 + (size_t)m * D) + F.lane;
#pragma unroll
                        for (int j = 0; j < 4; ++j) { const f32x4 a0 = v[2 * j] * pg8::F8_SX, a1 = v[2 * j + 1] * pg8::F8_SX; v2u q; q.x = pg8::pk4_fp8(a0[0], a0[1], a0[2], a0[3]); q.y = pg8::pk4_fp8(a1[0], a1[1], a1[2], a1[3]); d8[64 * j] = q; } }
                    else store_row_bf16_b(XN + (size_t)m * D, F.lane, v); }
                if constexpr (l == 1) {
                    asm volatile("" ::: "memory");
                    float lg[8];
#pragma unroll
                    for (int e = 0; e < 8; ++e) lg[e] = 0.f;
#pragma unroll
                    for (int j = 0; j < 4; ++j)
#pragma unroll
                        for (int i = 0; i < 8; ++i) { const f32x4 r0 = *(const LAS f32x4*)(F.lds + (((j * 8 + i) * 2) << 10) + F.lane * 16), r1 = *(const LAS f32x4*)(F.lds + (((j * 8 + i) * 2 + 1) << 10) + F.lane * 16); const float hv = v[2 * j + (i >> 2)][i & 3];
                            lg[0] += hv * r0.x; lg[1] += hv * r0.y; lg[2] += hv * r0.z; lg[3] += hv * r0.w; lg[4] += hv * r1.x; lg[5] += hv * r1.y; lg[6] += hv * r1.z; lg[7] += hv * r1.w; }
#pragma unroll
                    for (int e = 0; e < 8; ++e) lg[e] = wave_sum(lg[e]);
                    int e0 = 0; float v0 = lg[0];
#pragma unroll
                    for (int e = 1; e < 8; ++e) if (lg[e] > v0) { v0 = lg[e]; e0 = e; }
                    int e1 = -1; float v1 = -3.0e38f;
#pragma unroll
                    for (int e = 0; e < 8; ++e) if (e != e0 && lg[e] > v1) { v1 = lg[e]; e1 = e; }
                    const float ex = __expf(v1 - v0), w0 = 1.0f / (1.0f + ex), w1 = ex / (1.0f + ex);
                    if (F.lane == 0) { *(i32x2*)(((int*)(ws + WS_SMALL + SM_TOKE)) + 2 * m) = (i32x2){e0, e1}; *(f32x2*)(((float*)(ws + WS_SMALL + SM_TOKW)) + 2 * m) = (f32x2){w0, w1}; }
#pragma unroll
                    for (int e = 0; e < 8; ++e) hc[e] += (e == e0 ? 1 : 0) + (e == e1 ? 1 : 0);
                }
                        };
            if (F.NGW * 8 == M) {
                v4u rs[2][4];
#define FN_LOAD(slot, r) load_raw_b(XR + (size_t)(F.gw + (r) * F.NGW) * D, F.lane, rs[slot])
#define FN_PROC(slot, r) ffn_row(rs[slot], F.gw + (r) * F.NGW)
                ROWS8(FN_LOAD, FN_PROC);
#undef FN_LOAD
#undef FN_PROC
            } else {
                v4u rc[4]; if (F.gw < M) load_raw_b(XR + (size_t)F.gw * D, F.lane, rc);
                for (int m = F.gw; m < M; m += F.NGW) {
                    v4u rn[4];
#pragma unroll
                    for (int j = 0; j < 4; ++j) rn[j] = rc[j];
                    if (m + F.NGW < M) load_raw_b(XR + (size_t)(m + F.NGW) * D, F.lane, rn);
                    ffn_row(rc, m);
#pragma unroll
                    for (int j = 0; j < 4; ++j) rc[j] = rn[j];
                }
            }
            if (l == 1 && F.lane == 0) { *(i32x4*)(((int*)(ws + WS_SMALL + SM_WHIST)) + 8 * F.gw) = (i32x4){hc[0], hc[1], hc[2], hc[3]}; *(i32x4*)(((int*)(ws + WS_SMALL + SM_WHIST)) + 8 * F.gw + 4) = (i32x4){hc[4], hc[5], hc[6], hc[7]}; }
        }
        SEAM(pb + 4);
        if constexpr (l == 0) {
            if (IN(6)) {
                pg8::StaticOrder S; S.init(M, GU, F.G, (int)blockIdx.x);
                if constexpr (DENSE_F8 == 1) { pg8::Gemm g{ws + WS_XS8, ws + WS_WGU, D}; pg8::EpiSwiglu8 E{(unsigned char*)H, FF, pg8::F8_INV1};
                    pg8::gemm_phase<pg8::EpiSwiglu8, pg8::StaticOrder, true, true, true>(F.lds + RING_OFF, g, S, E); }
                else if constexpr (DENSE_F8 == 2) { pg8::Gemm g{XN, (bf16*)(ws + WS_WGU), 2 * D}; pg8::EpiSwiglu8 E{(unsigned char*)H, FF, 1.0f};
                    pg8::gemm_phase<pg8::EpiSwiglu8, pg8::StaticOrder, true, true>(F.lds + RING_OFF, g, S, E); }
                else if constexpr (DENSE_F8 == 3) { pg8::Gemm g{ws + WS_XS8, ws + WS_WGU, D}; pg8::EpiSwiglu E{H, FF, pg8::F8_INV1};
                    pg8::gemm_phase<pg8::EpiSwiglu, pg8::StaticOrder, true, true, true>(F.lds + RING_OFF, g, S, E); }
                else { pg8::Gemm g{XN, (bf16*)(ws + WS_WGU), 2 * D}; pg8::EpiSwiglu E{H, FF, 1.0f};
                    pg8::gemm_phase<pg8::EpiSwiglu, pg8::StaticOrder, true, true>(F.lds + RING_OFF, g, S, E); }
            }
            SEAM(6);
            if (IN(7)) {
                pg8::StaticOrder S; S.init(M, D, F.G, (int)blockIdx.x);
                if constexpr (DENSE_F8 == 1 || DENSE_F8 == 2) { pg8::Gemm g{H, ws + WS_WD, FF}; pg8::EpiResidB<false> E{XR, XR, D, pg8::F8_INV2};
                    pg8::gemm_phase<pg8::EpiResidB<false>, pg8::StaticOrder, true, true, true>(F.lds + RING_OFF, g, S, E); }
                else { pg8::Gemm g{H, (bf16*)(ws + WS_WD), 2 * FF}; pg8::EpiResidB<false> E{XR, XR, D, 1.0f};
                    pg8::gemm_phase<pg8::EpiResidB<false>, pg8::StaticOrder, true, true>(F.lds + RING_OFF, g, S, E); }
            }
            SEAM(7);
        }
}

__global__ void __launch_bounds__(NWAVES * 64, 2) trunk_fwd(Args args) {
    extern __shared__ __attribute__((aligned(16))) unsigned char lds[];
    Frame F;
    F.lds = (LAS unsigned char*)lds;
    F.tid = threadIdx.x; F.lane = F.tid & 63; F.wave = __builtin_amdgcn_readfirstlane(F.tid >> 6);
    F.G = gridDim.x; F.gw = blockIdx.x * NWAVES + F.wave; F.NGW = F.G * NWAVES; F.ws = args.ws;
    unsigned char* ws = args.ws;
    for (int u = F.tid; u < (LDS_BYTES - LDSCTL_OFF) / 4; u += NWAVES * 64) ((LAS unsigned*)(F.lds + LDSCTL_OFF))[u] = 0u;
    __syncthreads();
    volatile LAS unsigned* MISC = (volatile LAS unsigned*)(F.lds + MISC_OFF);
    const int lo = args.ph_lo, hi = args.ph_hi;
    XcdBarrier bar; bar.bar = (unsigned*)(ws + WS_CTL) + CW_BAR; bar.x = 0; bar.st = nullptr;
    if (hi - lo > 1) bar = xcd_barrier_post((unsigned*)(ws + WS_CTL) + CW_BAR, MISC + 8);

    float* out = args.out;
    bf16* XN = (bf16*)(ws + WS_XN); bf16* H = (bf16*)(ws + WS_H); bf16* XS = (bf16*)(ws + WS_XS);
    int* TOKE = (int*)(ws + WS_SMALL + SM_TOKE); float* TOKW = (float*)(ws + WS_SMALL + SM_TOKW); int* TOKP = (int*)(ws + WS_SMALL + SM_TOKP);
    int* WHIST = (int*)(ws + WS_SMALL + SM_WHIST); int* MTS = (int*)(ws + WS_SMALL + SM_TS);

    if (IN(0)) for (int rep = 0; rep < REP_CONV; ++rep) {
        bf16* WIN = (bf16*)(ws + WS_WIN); bf16* WO = (bf16*)(ws + WS_WO); bf16* WGU = (bf16*)(ws + WS_WGU); bf16* WD = (bf16*)(ws + WS_WD);
        bf16* EGU = (bf16*)(ws + WS_EGU); bf16* ED = (bf16*)(ws + WS_ED);
        { bf16* WC = (bf16*)(ws + WS_SMALL + SM_WC); const float* wsp = args.in[3];
            for (int i = blockIdx.x * (NWAVES * 64) + F.tid; i < 8 * 16384; i += F.G * NWAVES * 64) { const int t = (i >> 6) & 127, sx = 2 * (i & 63); const f32x2 wv = *(const f32x2*)(wsp + 2 * i); ((unsigned*)WC)[i] = pk2(sx <= t ? wv.x : 0.f, sx + 1 <= t ? wv.y : 0.f); } }
        conv_matrix(F, args.in[2], D, DIN, WIN, 0); conv_matrix(F, args.in[10], D, D, WO, 0);
    }

    layer_phases<0>(F, args, bar, lo, hi);
    layer_phases<1>(F, args, bar, lo, hi);

    if (IN(13)) {
        int pre[8], tot[8];
#pragma unroll
        for (int e = 0; e < 8; ++e) { pre[e] = 0; tot[e] = 0; }
        for (int w = F.lane; w < F.NGW; w += 64) { const i32x4 a = *(const i32x4*)(WHIST + 8 * w), b = *(const i32x4*)(WHIST + 8 * w + 4); const int hv[8] = {a.x, a.y, a.z, a.w, b.x, b.y, b.z, b.w};
#pragma unroll
            for (int e = 0; e < 8; ++e) { tot[e] += hv[e]; pre[e] += (w < F.gw) ? hv[e] : 0; } }
        int base[8], ts[9]; ts[0] = 0;
#pragma unroll
        for (int e = 0; e < 8; ++e) { tot[e] = wave_sum_i(tot[e]); pre[e] = wave_sum_i(pre[e]); ts[e + 1] = ts[e] + ((tot[e] + 255) >> 8); base[e] = ts[e] * 256 + pre[e]; }
        if (F.gw == 0 && F.lane == 0) {
#pragma unroll
            for (int e = 0; e < 9; ++e) MTS[e] = ts[e]; }
        f32x4 gn[8]; load_gain_b(args.in[11] + D, F.lane, gn);
        v4u rc[4]; if (F.gw < M) load_raw_b((const bf16*)(ws + WS_O) + (size_t)F.gw * D, F.lane, rc);
        for (int m = F.gw; m < M; m += F.NGW) {
            v4u rn[4];
#pragma unroll
            for (int j = 0; j < 4; ++j) rn[j] = rc[j];
            if (m + F.NGW < M) load_raw_b((const bf16*)(ws + WS_O) + (size_t)(m + F.NGW) * D, F.lane, rn);
            const i32x2 ee = *(const i32x2*)(TOKE + 2 * m); int p0 = 0, p1 = 0;
#pragma unroll
            for (int e = 0; e < 8; ++e) { if (ee.x == e) { p0 = base[e]; base[e] += 1; } if (ee.y == e) { p1 = base[e]; base[e] += 1; } }
            if (F.lane == 0) *(i32x2*)(TOKP + 2 * m) = (i32x2){p0, p1};
            unsigned char* XS8 = (unsigned char*)(ws + WS_XS8);
            f32x4 v[8]; norm_raw_b(rc, gn, v);
#pragma unroll
            for (int j = 0; j < 4; ++j) rc[j] = rn[j];
            v2u* d0 = (v2u*)(XS8 + (size_t)p0 * D) + F.lane; v2u* d1 = (v2u*)(XS8 + (size_t)p1 * D) + F.lane;
#pragma unroll
            for (int j = 0; j < 4; ++j) { const f32x4 a0 = v[2 * j] * pg8::F8_SX, a1 = v[2 * j + 1] * pg8::F8_SX; v2u q;
                q.x = pg8::pk4_fp8(a0[0], a0[1], a0[2], a0[3]); q.y = pg8::pk4_fp8(a1[0], a1[1], a1[2], a1[3]);
                d0[64 * j] = q; d1[64 * j] = q; }
        }
    }
    SEAM(13);
    if (IN(14)) for (int rep = 0; rep < REP_G16; ++rep) {
        pg8::MoeOrder S; S.G = F.G; S.c = (int)blockIdx.x; S.nN = GU / 256;
#pragma unroll
        for (int e = 0; e < 9; ++e) S.ts[e] = __builtin_amdgcn_readfirstlane(MTS[e]);
        pg8::Gemm g{ws + WS_XS8, ws + WS_EGU, D}; pg8::EpiSwiglu8 E{(unsigned char*)H, FF, pg8::F8_INV1};
        pg8::gemm_phase<pg8::EpiSwiglu8, pg8::MoeOrder, false, true, true>(F.lds + RING_OFF, g, S, E);
    }
    SEAM(14);
    if (IN(15)) {
        pg8::MoeOrderT<true> S; S.G = F.G; S.c = (int)blockIdx.x; S.nN = D / 256;
#pragma unroll
        for (int e = 0; e < 9; ++e) S.ts[e] = __builtin_amdgcn_readfirstlane(MTS[e]);
        S.ntk = FF / 128; S.pbuf = (float*)(ws + WS_XN); S.pcnt = (unsigned*)(ws + WS_CTL) + CW_SK; S.lflag = (LAS unsigned*)(F.lds + MISC_OFF + 64);
        pg8::Gemm g{H, ws + WS_ED, FF}; pg8::EpiStoreBf16s E{XS, D, pg8::F8_INV2};
        pg8::gemm_phase<pg8::EpiStoreBf16s, pg8::MoeOrderT<true>, true, true, true>(F.lds + RING_OFF, g, S, E);
    }
    SEAM(15);
    if (IN(16)) {
        const bf16* XR = (const bf16*)(ws + WS_O);
        f32x4 gn[8]; load_gain_b(args.in[19], F.lane, gn);
#define COMB_LOAD(slot, r) do { load_raw_b(XR + (size_t)(F.gw + (r) * F.NGW) * D, F.lane, xs[slot]); load_raw_b(XS + (size_t)pp8[r].x * D, F.lane, as[slot]); load_raw_b(XS + (size_t)pp8[r].y * D, F.lane, bs[slot]); } while (0)
#define COMB_ROW(slot, r) do { const f32x2 ww = ww8[r]; f32x4 v[8]; float s = 0.f; \
            _Pragma("unroll") for (int j = 0; j < 4; ++j) { const v4u px = xs[slot][j], pa = as[slot][j], pb2 = bs[slot][j]; \
                v[2 * j] = (f32x4){bflo(px.x) + ww.x * bflo(pa.x) + ww.y * bflo(pb2.x), bfhi(px.x) + ww.x * bfhi(pa.x) + ww.y * bfhi(pb2.x), bflo(px.y) + ww.x * bflo(pa.y) + ww.y * bflo(pb2.y), bfhi(px.y) + ww.x * bfhi(pa.y) + ww.y * bfhi(pb2.y)}; \
                v[2 * j + 1] = (f32x4){bflo(px.z) + ww.x * bflo(pa.z) + ww.y * bflo(pb2.z), bfhi(px.z) + ww.x * bfhi(pa.z) + ww.y * bfhi(pb2.z), bflo(px.w) + ww.x * bflo(pa.w) + ww.y * bflo(pb2.w), bfhi(px.w) + ww.x * bfhi(pa.w) + ww.y * bfhi(pb2.w)}; } \
            _Pragma("unroll") for (int j = 0; j < 8; ++j) s += (v[j].x * v[j].x + v[j].y * v[j].y) + (v[j].z * v[j].z + v[j].w * v[j].w); \
            const float rstd = __builtin_amdgcn_rsqf(wave_sum(s) * (1.0f / D) + EPS); \
            f32x4* orow = (f32x4*)(out + (size_t)(F.gw + (r) * F.NGW) * D) + 2 * F.lane; \
            _Pragma("unroll") for (int j = 0; j < 4; ++j) { orow[128 * j] = v[2 * j] * rstd * gn[2 * j]; orow[128 * j + 1] = v[2 * j + 1] * rstd * gn[2 * j + 1]; } } while (0)
        if (F.NGW * 8 == M) {
            i32x2 pp8[8]; f32x2 ww8[8];
#pragma unroll
            for (int r = 0; r < 8; ++r) { pp8[r] = *(const i32x2*)(TOKP + 2 * (F.gw + r * F.NGW)); ww8[r] = *(const f32x2*)(TOKW + 2 * (F.gw + r * F.NGW)); }
            v4u xs[2][4], as[2][4], bs[2][4];
            COMB_LOAD(0, 0);
            COMB_LOAD(1, 1); COMB_ROW(0, 0); COMB_LOAD(0, 2); COMB_ROW(1, 1); COMB_LOAD(1, 3); COMB_ROW(0, 2); COMB_LOAD(0, 4); COMB_ROW(1, 3);
            COMB_LOAD(1, 5); COMB_ROW(0, 4); COMB_LOAD(0, 6); COMB_ROW(1, 5); COMB_LOAD(1, 7); COMB_ROW(0, 6); COMB_ROW(1, 7);
        } else {
#undef COMB_LOAD
#undef COMB_ROW
        v4u xc[4], ac[4], bc[4]; i32x2 ppn = (i32x2){0, 0}; f32x2 wwc = (f32x2){0.f, 0.f}, wwn = (f32x2){0.f, 0.f};
        if (F.gw < M) { const i32x2 pp = *(const i32x2*)(TOKP + 2 * F.gw); wwc = *(const f32x2*)(TOKW + 2 * F.gw);
            load_raw_b(XR + (size_t)F.gw * D, F.lane, xc); load_raw_b(XS + (size_t)pp.x * D, F.lane, ac); load_raw_b(XS + (size_t)pp.y * D, F.lane, bc); }
        if (F.gw + F.NGW < M) { ppn = *(const i32x2*)(TOKP + 2 * (F.gw + F.NGW)); wwn = *(const f32x2*)(TOKW + 2 * (F.gw + F.NGW)); }
        for (int m = F.gw; m < M; m += F.NGW) {
            v4u xn[4], an[4], bn[4]; i32x2 ppnn = ppn; f32x2 wwnn = wwn;
#pragma unroll
            for (int j = 0; j < 4; ++j) { xn[j] = xc[j]; an[j] = ac[j]; bn[j] = bc[j]; }
            if (m + F.NGW < M) { load_raw_b(XR + (size_t)(m + F.NGW) * D, F.lane, xn); load_raw_b(XS + (size_t)ppn.x * D, F.lane, an); load_raw_b(XS + (size_t)ppn.y * D, F.lane, bn); }
            if (m + 2 * F.NGW < M) { ppnn = *(const i32x2*)(TOKP + 2 * (m + 2 * F.NGW)); wwnn = *(const f32x2*)(TOKW + 2 * (m + 2 * F.NGW)); }
            const f32x2 ww = wwc;
            f32x4 v[8]; float s = 0.f;
#pragma unroll
            for (int j = 0; j < 4; ++j) { const v4u px = xc[j], pa = ac[j], pb2 = bc[j];
                v[2 * j] = (f32x4){bflo(px.x) + ww.x * bflo(pa.x) + ww.y * bflo(pb2.x), bfhi(px.x) + ww.x * bfhi(pa.x) + ww.y * bfhi(pb2.x), bflo(px.y) + ww.x * bflo(pa.y) + ww.y * bflo(pb2.y), bfhi(px.y) + ww.x * bfhi(pa.y) + ww.y * bfhi(pb2.y)};
                v[2 * j + 1] = (f32x4){bflo(px.z) + ww.x * bflo(pa.z) + ww.y * bflo(pb2.z), bfhi(px.z) + ww.x * bfhi(pa.z) + ww.y * bfhi(pb2.z), bflo(px.w) + ww.x * bflo(pa.w) + ww.y * bflo(pb2.w), bfhi(px.w) + ww.x * bfhi(pa.w) + ww.y * bfhi(pb2.w)}; }
#pragma unroll
            for (int j = 0; j < 8; ++j) s += (v[j].x * v[j].x + v[j].y * v[j].y) + (v[j].z * v[j].z + v[j].w * v[j].w);
            const float rstd = 1.0f / sqrtf(wave_sum(s) * (1.0f / D) + EPS);
            f32x4* orow = (f32x4*)(out + (size_t)m * D) + 2 * F.lane;
#pragma unroll
            for (int j = 0; j < 4; ++j) { orow[128 * j] = v[2 * j] * rstd * gn[2 * j]; orow[128 * j + 1] = v[2 * j + 1] * rstd * gn[2 * j + 1]; }
#pragma unroll
            for (int j = 0; j < 4; ++j) { xc[j] = xn[j]; ac[j] = an[j]; bc[j] = bn[j]; }
            wwc = wwn; ppn = ppnn; wwn = wwnn;
        }
        }
    }
}

extern "C" void kernel_launch(void* const* d_in, const int* in_sizes, int n_in, void* d_out, int out_size, void* d_ws, size_t ws_size, hipStream_t stream) {
    static int grid = 0;
    if (grid == 0) {
        if (n_in != 20 || in_sizes[0] != M * D || out_size != M * D || ws_size < WS_END) { fprintf(stderr, "kernel_launch: unexpected shapes / workspace (n_in %d, ws %zu, need %zu); nothing launched\n", n_in, ws_size, (size_t)WS_END); grid = -1; return; }
        int dev = 0, cus = 0, per_cu = 0;
        if (hipGetDevice(&dev) != hipSuccess || hipDeviceGetAttribute(&cus, hipDeviceAttributeMultiprocessorCount, dev) != hipSuccess) { grid = -1; return; }
        if (hipFuncSetAttribute((const void*)trunk_fwd, hipFuncAttributeMaxDynamicSharedMemorySize, LDS_BYTES) != hipSuccess) { fprintf(stderr, "kernel_launch: hipFuncSetAttribute failed\n"); grid = -1; return; }
        if (hipOccupancyMaxActiveBlocksPerMultiprocessor(&per_cu, (const void*)trunk_fwd, NWAVES * 64, LDS_BYTES) != hipSuccess || per_cu < 1) fprintf(stderr, "kernel_launch: occupancy query reports %d\n", per_cu);
        (void)hipGetLastError();
        grid = cus;
    }
    if (grid < 0) return;
    if (hipMemsetAsync((char*)d_ws + WS_CTL, 0, CTL_ZERO_BYTES, stream) != hipSuccess) return;
    Args a{};
    for (int i = 0; i < 20; ++i) a.in[i] = (const float*)d_in[i];
    a.out = (float*)d_out; a.ws = (unsigned char*)d_ws;
#if MK_ONE_LAUNCH
    a.ph_lo = 0; a.ph_hi = NPHASE;
    hipLaunchKernelGGL(trunk_fwd, dim3(grid), dim3(NWAVES * 64), LDS_BYTES, stream, a);
#else
    for (int p = 0; p < NPHASE; ++p) {
        a.ph_lo = p; a.ph_hi = p + 1;
        hipLaunchKernelGGL(trunk_fwd, dim3(grid), dim3(NWAVES * 64), LDS_BYTES, stream, a);
    }
#endif
}
```
